# Optimizing an MI355X kernel written in HIP

```python
import numpy as np
import jax
import jax.numpy as jnp
from jax import lax

D_MODEL = 4096
BATCH = 8
SEQ = 2048
DEPTH = 1
DEC_BATCH = 1
DEC_SEQ = 8192
PAST_LEN = 128

GRID_W = 64
N_MEM = 256
ATTN_WIDTH = D_MODEL // 2
ATTN_HEADS = 16
HEAD_DIM = ATTN_WIDTH // ATTN_HEADS
WIN_H_MAX = 8
WIN_W = 16
RPB_H = 2 * WIN_H_MAX - 1
RPB_W = 2 * WIN_W - 1
LRU_WIDTH = D_MODEL - ATTN_WIDTH
LRU_BLOCKS = 16
LRU_BLOCK = LRU_WIDTH // LRU_BLOCKS
CONV_WIDTH = 4
LRU_C = 8.0
IN_PROJ_WIDTH = 3 * ATTN_WIDTH + 2 * LRU_WIDTH
MIX_WIDTH = ATTN_WIDTH + LRU_WIDTH
XA_HEADS = 4
XA_HEAD_DIM = 128
XA_WIDTH = XA_HEADS * XA_HEAD_DIM
D_FF = 11008
EPS = 1e-6

kernel_name = 'hymba_na2d_rglru_macaron_encoder'


def rms_norm(x, g):
    xf = x.astype(jnp.float32)
    y = xf * lax.rsqrt(jnp.mean(xf * xf, axis=-1, keepdims=True) + EPS)
    return (y * g.astype(jnp.float32)).astype(x.dtype)


def swiglu(x, w1, w3, w2):
    return (jax.nn.silu(x @ w1) * (x @ w3)) @ w2


def neighbourhood_attention(q, k, v, rpb):
    B, T, H, dh = q.shape
    rows = T // GRID_W
    kh = min(WIN_H_MAX, rows)
    qg = q.reshape(B, rows, GRID_W, H, dh)
    kg = k.reshape(B, rows, GRID_W, H, dh)
    vg = v.reshape(B, rows, GRID_W, H, dh)
    col = np.arange(GRID_W)
    col_start = np.clip(col - WIN_W // 2, 0, GRID_W - WIN_W)
    col_idx = col_start[:, None] + np.arange(WIN_W)
    col_bias_idx = col_idx - col[:, None] + (WIN_W - 1)
    scale = dh ** -0.5

    def one_row(args):
        r, q_row = args
        row_start = jnp.clip(r - kh // 2, 0, rows - kh)
        k_rows = lax.dynamic_slice_in_dim(kg, row_start, kh, axis=1)
        v_rows = lax.dynamic_slice_in_dim(vg, row_start, kh, axis=1)
        k_nb = k_rows[:, :, col_idx]
        v_nb = v_rows[:, :, col_idx]
        s = jnp.einsum('bchd,bicjhd->bhcij', q_row, k_nb,
                       preferred_element_type=jnp.float32) * scale
        row_bias_idx = row_start + jnp.arange(kh) - r + (WIN_H_MAX - 1)
        bias = rpb[:, row_bias_idx[None, :, None], col_bias_idx[:, None, :]]
        s = s + bias[None].astype(jnp.float32)
        p = jax.nn.softmax(s.reshape(B, H, GRID_W, kh * WIN_W), axis=-1)
        p = p.reshape(s.shape).astype(v.dtype)
        return jnp.einsum('bhcij,bicjhd->bchd', p, v_nb)

    out = lax.map(one_row, (jnp.arange(rows), jnp.moveaxis(qg, 1, 0)))
    return jnp.moveaxis(out, 0, 1).reshape(B, T, H * dh)


def _linear_combine(c1, c2):
    a1, b1 = c1
    a2, b2 = c2
    return a1 * a2, a2 * b1 + b2


def rg_lru_bidirectional(u, conv_w, conv_b, lru_wa, lru_ba, lru_wx, lru_bx, lru_lam):
    B, T, _ = u.shape
    xc = lax.conv_general_dilated(
        u, conv_w.astype(u.dtype)[:, None, :], window_strides=(1,), padding=[(1, 2)],
        dimension_numbers=('NWC', 'WIO', 'NWC'), feature_group_count=LRU_WIDTH) + conv_b.astype(u.dtype)
    xb = xc.reshape(B, T, LRU_BLOCKS, LRU_BLOCK)
    r_pre = jnp.einsum('btnc,encd->ebtnd', xb, lru_wa).reshape(2, B, T, LRU_WIDTH)
    i_pre = jnp.einsum('btnc,encd->ebtnd', xb, lru_wx).reshape(2, B, T, LRU_WIDTH)
    r_gate = jax.nn.sigmoid(r_pre.astype(jnp.float32) + lru_ba.astype(jnp.float32)[:, None, None, :])
    i_gate = jax.nn.sigmoid(i_pre.astype(jnp.float32) + lru_bx.astype(jnp.float32)[:, None, None, :])
    log_a = -LRU_C * r_gate * jax.nn.softplus(-lru_lam.astype(jnp.float32))[:, None, None, :]
    a = jnp.exp(log_a)
    mult = jnp.sqrt(-jnp.expm1(2.0 * log_a))
    b = mult * i_gate * xc.astype(jnp.float32)[None]
    _, h_fwd = lax.associative_scan(_linear_combine, (a[0], b[0]), axis=1)
    _, h_bwd = lax.associative_scan(_linear_combine, (a[1], b[1]), axis=1, reverse=True)
    return (h_fwd + h_bwd).astype(u.dtype)


def parallel_mixer(x_n, w_in, rpb, conv_w, conv_b, lru_wa, lru_ba, lru_wx, lru_bx, lru_lam,
                   g_attn_out, g_lru_out, w_out):
    B, T, _ = x_n.shape
    proj = x_n @ w_in
    q, k, v, u, gate = jnp.split(
        proj, [ATTN_WIDTH, 2 * ATTN_WIDTH, 3 * ATTN_WIDTH, 3 * ATTN_WIDTH + LRU_WIDTH], axis=-1)
    heads = lambda t: t.reshape(B, T, ATTN_HEADS, HEAD_DIM)
    y_attn = neighbourhood_attention(heads(q), heads(k), heads(v), rpb)
    y_lru = rg_lru_bidirectional(u, conv_w, conv_b, lru_wa, lru_ba, lru_wx, lru_bx, lru_lam) * jax.nn.gelu(gate)
    y = jnp.concatenate([rms_norm(y_attn, g_attn_out), rms_norm(y_lru, g_lru_out)], axis=-1)
    return y @ w_out


def memory_cross_attention(x_n, mem_n, xa_wq, xa_wk, xa_wv, xa_wo):
    B, T, _ = x_n.shape
    M = mem_n.shape[1]
    q = (x_n @ xa_wq).reshape(B, T, XA_HEADS, XA_HEAD_DIM)
    k = (mem_n @ xa_wk).reshape(B, M, XA_HEADS, XA_HEAD_DIM)
    v = (mem_n @ xa_wv).reshape(B, M, XA_HEADS, XA_HEAD_DIM)
    s = jnp.einsum('bthd,bmhd->bhtm', q, k, preferred_element_type=jnp.float32) * (XA_HEAD_DIM ** -0.5)
    p = jax.nn.softmax(s, axis=-1).astype(v.dtype)
    o = jnp.einsum('bhtm,bmhd->bthd', p, v).reshape(B, T, XA_WIDTH)
    return o @ xa_wo


def trunk(x, mem, p):
    for l in range(DEPTH):
        x = x + 0.5 * swiglu(rms_norm(x, p['norm_ffn1_g'][l]), p['ffn1_w1'][l], p['ffn1_w3'][l], p['ffn1_w2'][l])
        x = x + parallel_mixer(rms_norm(x, p['norm_mix_g'][l]), p['w_in'][l], p['rpb'][l],
                               p['conv_w'][l], p['conv_b'][l], p['lru_wa'][l], p['lru_ba'][l],
                               p['lru_wx'][l], p['lru_bx'][l], p['lru_lam'][l],
                               p['g_attn_out'][l], p['g_lru_out'][l], p['w_out'][l])
        x = x + memory_cross_attention(rms_norm(x, p['norm_xa_g'][l]), rms_norm(mem, p['norm_mem_g'][l]),
                                       p['xa_wq'][l], p['xa_wk'][l], p['xa_wv'][l], p['xa_wo'][l])
        x = x + 0.5 * swiglu(rms_norm(x, p['norm_ffn2_g'][l]), p['ffn2_w1'][l], p['ffn2_w3'][l], p['ffn2_w2'][l])
    return rms_norm(x, p['final_norm_g'])


def _normal(k, shape, scale):
    return jax.random.normal(k, shape, jnp.float32) * scale


def _gain(k, shape):
    return 1.0 + 0.02 * jax.random.normal(k, shape, jnp.float32)


def setup_inputs(seed: int = 0) -> dict:
    key = jax.random.key(seed)
    ks = jax.random.split(key, 32)
    L = DEPTH
    a0 = jax.random.uniform(ks[17], (L, 2, LRU_WIDTH), jnp.float32, 0.9, 0.999)
    s0 = a0 ** (1.0 / LRU_C)
    lru_lam = jnp.log(s0) - jnp.log1p(-s0)
    return {
        'x_prompt': _normal(ks[0], (BATCH, SEQ, D_MODEL), 1.0),
        'x_sample': _normal(ks[1], (DEC_BATCH, DEC_SEQ, D_MODEL), 1.0),
        'mem_prompt': _normal(ks[2], (BATCH, N_MEM, D_MODEL), 1.0),
        'mem_sample': _normal(ks[3], (DEC_BATCH, N_MEM, D_MODEL), 1.0),
        'norm_ffn1_g': _gain(ks[4], (L, D_MODEL)),
        'ffn1_w1': _normal(ks[5], (L, D_MODEL, D_FF), D_MODEL ** -0.5),
        'ffn1_w3': _normal(ks[6], (L, D_MODEL, D_FF), D_MODEL ** -0.5),
        'ffn1_w2': _normal(ks[7], (L, D_FF, D_MODEL), D_FF ** -0.5),
        'norm_mix_g': _gain(ks[8], (L, D_MODEL)),
        'w_in': _normal(ks[9], (L, D_MODEL, IN_PROJ_WIDTH), D_MODEL ** -0.5),
        'rpb': _normal(ks[10], (L, ATTN_HEADS, RPB_H, RPB_W), 0.1),
        'conv_w': _normal(ks[11], (L, CONV_WIDTH, LRU_WIDTH), CONV_WIDTH ** -0.5),
        'conv_b': _normal(ks[12], (L, LRU_WIDTH), 0.01),
        'lru_wa': _normal(ks[13], (L, 2, LRU_BLOCKS, LRU_BLOCK, LRU_BLOCK), LRU_BLOCK ** -0.5),
        'lru_ba': _normal(ks[14], (L, 2, LRU_WIDTH), 0.01),
        'lru_wx': _normal(ks[15], (L, 2, LRU_BLOCKS, LRU_BLOCK, LRU_BLOCK), LRU_BLOCK ** -0.5),
        'lru_bx': _normal(ks[16], (L, 2, LRU_WIDTH), 0.01),
        'lru_lam': lru_lam,
        'g_attn_out': _gain(ks[18], (L, ATTN_WIDTH)),
        'g_lru_out': _gain(ks[19], (L, LRU_WIDTH)),
        'w_out': _normal(ks[20], (L, MIX_WIDTH, D_MODEL), MIX_WIDTH ** -0.5),
        'norm_xa_g': _gain(ks[21], (L, D_MODEL)),
        'norm_mem_g': _gain(ks[22], (L, D_MODEL)),
        'xa_wq': _normal(ks[23], (L, D_MODEL, XA_WIDTH), D_MODEL ** -0.5),
        'xa_wk': _normal(ks[24], (L, D_MODEL, XA_WIDTH), D_MODEL ** -0.5),
        'xa_wv': _normal(ks[25], (L, D_MODEL, XA_WIDTH), D_MODEL ** -0.5),
        'xa_wo': _normal(ks[26], (L, XA_WIDTH, D_MODEL), XA_WIDTH ** -0.5),
        'norm_ffn2_g': _gain(ks[27], (L, D_MODEL)),
        'ffn2_w1': _normal(ks[28], (L, D_MODEL, D_FF), D_MODEL ** -0.5),
        'ffn2_w3': _normal(ks[29], (L, D_MODEL, D_FF), D_MODEL ** -0.5),
        'ffn2_w2': _normal(ks[30], (L, D_FF, D_MODEL), D_FF ** -0.5),
        'final_norm_g': _gain(ks[31], (D_MODEL,)),
    }


def reference(x_prompt, x_sample, mem_prompt, mem_sample,
              norm_ffn1_g, ffn1_w1, ffn1_w3, ffn1_w2,
              norm_mix_g, w_in, rpb, conv_w, conv_b,
              lru_wa, lru_ba, lru_wx, lru_bx, lru_lam,
              g_attn_out, g_lru_out, w_out,
              norm_xa_g, norm_mem_g, xa_wq, xa_wk, xa_wv, xa_wo,
              norm_ffn2_g, ffn2_w1, ffn2_w3, ffn2_w2,
              final_norm_g):
    p = {
        'norm_ffn1_g': norm_ffn1_g, 'ffn1_w1': ffn1_w1, 'ffn1_w3': ffn1_w3, 'ffn1_w2': ffn1_w2,
        'norm_mix_g': norm_mix_g, 'w_in': w_in, 'rpb': rpb, 'conv_w': conv_w, 'conv_b': conv_b,
        'lru_wa': lru_wa, 'lru_ba': lru_ba, 'lru_wx': lru_wx, 'lru_bx': lru_bx, 'lru_lam': lru_lam,
        'g_attn_out': g_attn_out, 'g_lru_out': g_lru_out, 'w_out': w_out,
        'norm_xa_g': norm_xa_g, 'norm_mem_g': norm_mem_g,
        'xa_wq': xa_wq, 'xa_wk': xa_wk, 'xa_wv': xa_wv, 'xa_wo': xa_wo,
        'norm_ffn2_g': norm_ffn2_g, 'ffn2_w1': ffn2_w1, 'ffn2_w3': ffn2_w3, 'ffn2_w2': ffn2_w2,
        'final_norm_g': final_norm_g,
    }
    y_prompt = trunk(x_prompt, mem_prompt, p)
    y_sample = trunk(x_sample, mem_sample, p)
    return (y_prompt, y_sample)
```

```cpp
#include <hip/hip_runtime.h>
#include <cstdio>
#include <cstdint>
namespace pg8 {
#define PG8_LAS __attribute__((address_space(3)))
typedef unsigned short bf16_t;
typedef short bf16x8 __attribute__((ext_vector_type(8)));
typedef float f32x4 __attribute__((ext_vector_type(4)));
typedef unsigned u32x4 __attribute__((ext_vector_type(4)));
constexpr int BM = 256, BK = 64, HALF = 128, HTB = HALF * BK * 2  , STAGE_BYTES = 8 * HTB, NXCD = 8, WGM = 8;

__host__ __device__ __forceinline__ int lds_byte(int r, int c) { const int st = (r >> 4) * 2 + (c >> 5), rr = r & 15, cc = c & 31, ob = rr * 64 + cc * 2; return st * 1024 + (ob ^ (((ob >> 9) & 1) << 5)); }
__host__ __device__ __forceinline__ void stage_rc(int b, int& R, int& C) { const int st = b / 1024, sb = b % 1024, swz = sb ^ (((sb >> 9) & 1) << 5); R = (st >> 1) * 16 + swz / 64; C = (st & 1) * 32 + (swz % 64) / 2; }
__host__ __device__ __forceinline__ int perm32(int rho) { const int n = rho >> 4, i = rho & 15; return 8 * (i >> 2) + 4 * n + (i & 3); }

__host__ __device__ __forceinline__ int perm32inv(int v) { return 16 * ((v >> 2) & 1) + 4 * (v >> 3) + (v & 3); }
__host__ __device__ __forceinline__ size_t blk_off(int row, int col, int nkt) { const int p = row >> 8, h = (row >> 7) & 1, r = row & 127, kt = col >> 6, c = col & 63; return ((size_t)((p * nkt + kt) * 2 + h) << 14) + (size_t)lds_byte(r, c); }
typedef int i32x4v __attribute__((ext_vector_type(4)));
typedef int i32x8v __attribute__((ext_vector_type(8)));
typedef short bf16x16v __attribute__((ext_vector_type(16)));
__host__ __device__ __forceinline__ size_t blk8_off(int row, int col, int nkt8) { const int p = row >> 8, h = (row >> 7) & 1, r = row & 127, kt = col >> 7, cb = col & 127, c8 = cb >> 4;
    return ((size_t)((p * nkt8 + kt) * 2 + h) << 14) + (size_t)((r >> 4) * 2048 + (c8 & 1) * 1024 + ((c8 >> 1) * 16 + (r & 15)) * 16 + (cb & 15)); }
struct Unit { int pm, pn; };
struct Gemm { const bf16_t* A; const bf16_t* Bt; int M, N, K; int Ks = 0; };

#ifndef PG8_XCDROWS
#define PG8_XCDROWS 1
#endif
struct StaticOrder {
    int nM, nN, nwg, G, c, wgm, rev;
    __host__ __device__ void init(int M, int N, int G_, int c_, int wgm_ = WGM, int rev_ = 0) { nM = M / BM; nN = N / BM; nwg = nM * nN; G = G_; c = c_; wgm = wgm_; rev = rev_; }
    __host__ __device__ bool next(int i, Unit& u) const {
        const long L = (long)i * G + c; if (L >= nwg) return false;
        if (PG8_XCDROWS && nM % NXCD == 0 && G % NXCD == 0) {
            const int xcd = (int)(L % NXCD), off = (int)(L / NXCD), nMl = nM / NXCD, nig = wgm * nN, gid = off / nig, fm = gid * wgm, gsz = (nMl - fm) < wgm ? (nMl - fm) : wgm, w = off % nig;
            u.pm = xcd * nMl + fm + w % gsz; u.pn = w / gsz; if (rev) u.pm = nM - 1 - u.pm; return true; }
        int wgid = (int)L; { const int q = nwg / NXCD, r = nwg % NXCD, xcd = wgid % NXCD, off = wgid / NXCD; wgid = (xcd < r ? xcd * (q + 1) : r * (q + 1) + (xcd - r) * q) + off; }
        const int nig = wgm * nN, gid = wgid / nig, fm = gid * wgm, gsz = (nM - fm) < wgm ? (nM - fm) : wgm;
        u.pm = fm + ((wgid % nig) % gsz); u.pn = (wgid % nig) / gsz; if (rev) u.pm = nM - 1 - u.pm; return true;
    }
    __device__ __forceinline__ void a_ready(const Unit&) const {}
    __device__ __forceinline__ void done(const Unit&) const {}
};
__device__ __forceinline__ unsigned cvt_pk_bf16(float lo, float hi) { unsigned r; asm volatile("v_cvt_pk_bf16_f32 %0, %1, %2" : "=v"(r) : "v"(lo), "v"(hi)); return r; }
typedef float f32x2 __attribute__((ext_vector_type(2)));
template <class Epi, class Sched, bool ALIGN_EPI = false, bool SP2 = false, int VAR = 0, bool FP8 = false>
__device__ __forceinline__ void gemm_phase(PG8_LAS unsigned char* lds, const Gemm g, const Sched& S, const Epi& E, const int wid) {
    int lane_; asm volatile("v_mbcnt_lo_u32_b32 %0, -1, 0\n\tv_mbcnt_hi_u32_b32 %0, -1, %0" : "=&v"(lane_));
    const int lane = lane_, tid = wid * 64 + lane, wr = wid >> 2, wc = wid & 3, fr = lane & 15, fq = lane >> 4;
    const int K = g.K, nt = K / (FP8 ? 2 * BK : BK);
    unsigned voffA[2], voffB[2];
#pragma unroll
    for (int i = 0; i < 2; ++i) { voffA[i] = (unsigned)(tid * 16 + i * 8192); voffB[i] = voffA[i]; }
    const size_t kstep = 32768;
    const size_t hstep = 16384;
    const size_t tstep = (size_t)((g.Ks ? g.Ks : K) / (FP8 ? 2 * BK : BK)) * 32768;
    const unsigned ldsw = (unsigned)wid * 1024u; const unsigned ldsb_ = (unsigned)(uintptr_t)lds + ldsw;
    const int aoff = FP8 ? (wr * 8192 + lane * 16) : lds_byte(wr * 64 + fr, fq * 8), boff = FP8 ? (wc * 4096 + lane * 16) : lds_byte(wc * 32 + fr, fq * 8);
#define PG8_SA(b, h) (((b) * 2 + (h)) * HTB)
#define PG8_SB(b, h) ((4 + (b) * 2 + (h)) * HTB)
#define PG8_STAGE(bufoff, gbase, voff) do { _Pragma("unroll") for (int _i = 0; _i < 2; ++_i) { const char* gb_ = (const char*)(gbase) + _i * 8192;     \
        asm volatile("s_mov_b32 m0, %0\n\ts_nop 0\n\tglobal_load_lds_dwordx4 %1, %2" :: "s"(ldsb_ + (unsigned)((bufoff) + _i * 8192)), "v"((voff)[0]), "s"(gb_) : "memory", "m0"); } } while (0)
#define PG8_LDA(dst, b, h) do { if constexpr (FP8) { _Pragma("unroll") for (int m = 0; m < 4; ++m) { const bf16x8 lo_ = *(const PG8_LAS bf16x8*)(lds + PG8_SA(b, h) + aoff + m * 2048), hi_ = *(const PG8_LAS bf16x8*)(lds + PG8_SA(b, h) + aoff + m * 2048 + 1024); \
        dst##8[m] = __builtin_shufflevector(lo_, hi_, 0, 1, 2, 3, 4, 5, 6, 7, 8, 9, 10, 11, 12, 13, 14, 15); } } \
      else { _Pragma("unroll") for (int m = 0; m < 4; ++m) _Pragma("unroll") for (int k = 0; k < 2; ++k) dst[m][k] = *(const PG8_LAS bf16x8*)(lds + PG8_SA(b, h) + aoff + m * 2048 + k * 1024); } } while (0)
#define PG8_LDB(dst, b, h) do { if constexpr (FP8) { _Pragma("unroll") for (int n = 0; n < 2; ++n) { const bf16x8 lo_ = *(const PG8_LAS bf16x8*)(lds + PG8_SB(b, h) + boff + n * 2048), hi_ = *(const PG8_LAS bf16x8*)(lds + PG8_SB(b, h) + boff + n * 2048 + 1024); \
        dst##8[n] = __builtin_shufflevector(lo_, hi_, 0, 1, 2, 3, 4, 5, 6, 7, 8, 9, 10, 11, 12, 13, 14, 15); } } \
      else { _Pragma("unroll") for (int n = 0; n < 2; ++n) _Pragma("unroll") for (int k = 0; k < 2; ++k) dst[n][k] = *(const PG8_LAS bf16x8*)(lds + PG8_SB(b, h) + boff + n * 2048 + k * 1024); } } while (0)
#define PG8_CAT8(x0, x1) __builtin_shufflevector(__builtin_bit_cast(i32x4v, x0), __builtin_bit_cast(i32x4v, x1), 0, 1, 2, 3, 4, 5, 6, 7)
#define PG8_MMA(ai, bj, At, Bt) do { __builtin_amdgcn_s_setprio(1); if constexpr (FP8) { _Pragma("unroll") for (int m = 0; m < 4; ++m) _Pragma("unroll") for (int n = 0; n < 2; ++n) \
        acc[ai][bj][m][n] = __builtin_amdgcn_mfma_scale_f32_16x16x128_f8f6f4(__builtin_bit_cast(i32x8v, Bt##8[n]), __builtin_bit_cast(i32x8v, At##8[m]), acc[ai][bj][m][n], 0, 0, 0, 0x7f7f7f7f, 0, 0x7f7f7f7f); } \
      else { _Pragma("unroll") for (int m = 0; m < 4; ++m) _Pragma("unroll") for (int n = 0; n < 2; ++n) _Pragma("unroll") for (int k = 0; k < 2; ++k) \
        acc[ai][bj][m][n] = __builtin_amdgcn_mfma_f32_16x16x32_bf16(Bt[n][k], At[m][k], acc[ai][bj][m][n], 0, 0, 0); } __builtin_amdgcn_s_setprio(0); } while (0)
#define PG8_WAIT_V(n) asm volatile("s_waitcnt vmcnt(" #n ")" ::: "memory")
#define PG8_WAIT_L(n) asm volatile("s_waitcnt lgkmcnt(" #n ")" ::: "memory")
#define PG8_BAR __builtin_amdgcn_s_barrier()
#define PG8_SCHED __builtin_amdgcn_sched_barrier(0)
    Unit cur, nxt; int ui = 0;
    if (!S.next(0, cur)) return;
    f32x4 acc[2][2][4][2];
#pragma unroll
    for (int a = 0; a < 2; ++a)
#pragma unroll
        for (int b = 0; b < 2; ++b)
#pragma unroll
            for (int m = 0; m < 4; ++m)
#pragma unroll
                for (int n = 0; n < 2; ++n) acc[a][b][m][n] = (f32x4){0.f, 0.f, 0.f, 0.f};
    bf16x8 At[4][2], B0[2][2], B1[2][2];
    bf16x16v At8[4], B08[2], B18[2];
    u32x4 bx[8]; if constexpr (VAR == 2) { _Pragma("unroll") for (int j_ = 0; j_ < 8; ++j_) bx[j_] = (u32x4){0u, 0u, 0u, 0u}; }
    const char* cA = (const char*)g.A + (size_t)cur.pm * tstep; const char* cB = (const char*)g.Bt + (size_t)cur.pn * tstep;
    S.a_ready(cur);
    if constexpr (SP2) {
        PG8_STAGE(PG8_SB(0, 0), cB, voffB); PG8_STAGE(PG8_SB(0, 1), cB + hstep, voffB); PG8_STAGE(PG8_SA(0, 0), cA, voffA); PG8_STAGE(PG8_SA(0, 1), cA + hstep, voffA);
        if (wr == 1) PG8_BAR;
        PG8_WAIT_V(2); PG8_BAR;
        PG8_STAGE(PG8_SB(1, 0), cB + kstep, voffB); PG8_STAGE(PG8_SA(1, 0), cA + kstep, voffA); PG8_STAGE(PG8_SB(1, 1), cB + hstep + kstep, voffB);
        PG8_WAIT_V(6); PG8_BAR;
    } else {
        PG8_STAGE(PG8_SB(0, 0), cB, voffB); PG8_STAGE(PG8_SA(0, 0), cA, voffA); PG8_STAGE(PG8_SB(0, 1), cB + hstep, voffB); PG8_STAGE(PG8_SA(0, 1), cA + hstep, voffA);
        if (wr == 1) PG8_BAR;
        PG8_WAIT_V(4); PG8_BAR;
        PG8_STAGE(PG8_SB(1, 0), cB + kstep, voffB); PG8_STAGE(PG8_SA(1, 0), cA + kstep, voffA); PG8_STAGE(PG8_SB(1, 1), cB + hstep + kstep, voffB);
        PG8_WAIT_V(6); PG8_BAR;
    }
    for (;;) {
        const bool has_next = S.next(ui + 1, nxt);
        const char* nA = has_next ? (const char*)g.A + (size_t)nxt.pm * tstep : cA; const char* nB = has_next ? (const char*)g.Bt + (size_t)nxt.pn * tstep : cB;
        for (int t = 0; t < nt; t += 2) {
            const bool last = (t == nt - 2);
            const char* a1 = cA + (size_t)(t + 1) * kstep;
            const char* a2 = last ? nA : cA + (size_t)(t + 2) * kstep; const char* b2 = last ? nB : cB + (size_t)(t + 2) * kstep;
            const char* a3 = a2 + kstep; const char* b3 = b2 + kstep;
            if (last && has_next) S.a_ready(nxt);
            if constexpr (SP2) {
#define PG8_STB(bufoff, gbase) do { if constexpr (VAR == 0) { PG8_STAGE(bufoff, gbase, voffB); } } while (0)
#define PG8_WV() do { if constexpr (VAR == 0) { PG8_WAIT_V(8); } else if constexpr (VAR == 1) { PG8_WAIT_V(4); } else { PG8_WAIT_V(12); } } while (0)
#define PG8_WV0() do { if constexpr (FP8 && VAR == 0 && Epi::NVM_MIN == 8) {     \
        asm volatile("s_cmp_lg_u32 %0, 0\n\ts_cbranch_scc1 3f\n\ts_cmp_eq_u32 %1, 0\n\ts_cbranch_scc1 3f\n\ts_waitcnt vmcnt(16)\n\ts_branch 2f\n3:\n\ts_waitcnt vmcnt(8)\n2:" :: "s"(t), "s"(ui) : "memory", "scc"); } \
      else if constexpr (FP8) { PG8_WV(); } else if constexpr (VAR == 0 && Epi::NVM_MIN == 16) { if (t == 0 && ui > 0) { PG8_WAIT_V(24); } else { PG8_WAIT_V(8); } } else if constexpr (VAR == 0 && Epi::NVM_MIN == 8) { if (t == 0 && ui > 0) { PG8_WAIT_V(16); } else { PG8_WAIT_V(8); } } else { PG8_WV(); } } while (0)
#define PG8_BREG(gbase) do { if constexpr (VAR == 2) { _Pragma("unroll") for (int j_ = 0; j_ < 8; ++j_) asm volatile("" :: "v"(bx[j_])); \
        _Pragma("unroll") for (int j_ = 0; j_ < 8; ++j_) bx[j_] = *(const u32x4*)((gbase) + wc * 8192 + j_ * 1024 + lane * 16); } } while (0)
            PG8_LDB(B0, 0, 0); PG8_LDB(B1, 0, 1); PG8_SCHED; PG8_LDA(At, 0, 0); PG8_STAGE(PG8_SA(1, 1), a1 + hstep, voffA); PG8_BREG(b2);
            PG8_WV0(); PG8_WAIT_L(0); PG8_BAR; PG8_MMA(0, 0, At, B0); PG8_MMA(0, 1, At, B1); PG8_BAR; PG8_SCHED;
            PG8_LDA(At, 0, 1); PG8_STB(PG8_SB(0, 0), b2); PG8_STB(PG8_SB(0, 1), b2 + hstep); PG8_STAGE(PG8_SA(0, 0), a2, voffA);
            PG8_WV0(); PG8_WAIT_L(0); PG8_BAR; PG8_MMA(1, 0, At, B0); PG8_MMA(1, 1, At, B1); PG8_BAR; PG8_SCHED;
            PG8_LDB(B0, 1, 0); PG8_LDB(B1, 1, 1); PG8_SCHED; PG8_LDA(At, 1, 0); PG8_STAGE(PG8_SA(0, 1), a2 + hstep, voffA); PG8_BREG(b3);
            PG8_WV(); PG8_WAIT_L(0); PG8_BAR; PG8_MMA(0, 0, At, B0); PG8_MMA(0, 1, At, B1); PG8_BAR; PG8_SCHED;
            PG8_LDA(At, 1, 1); PG8_STB(PG8_SB(1, 0), b3); PG8_STB(PG8_SB(1, 1), b3 + hstep); PG8_STAGE(PG8_SA(1, 0), a3, voffA);
            PG8_WV(); PG8_WAIT_L(0); PG8_BAR; PG8_MMA(1, 0, At, B0); PG8_MMA(1, 1, At, B1); PG8_BAR; PG8_SCHED;
#undef PG8_STB
#undef PG8_WV
#undef PG8_WV0
#undef PG8_BREG
            } else {
            PG8_LDB(B0, 0, 0); PG8_SCHED; PG8_LDA(At, 0, 0); PG8_STAGE(PG8_SA(1, 1), a1 + hstep, voffA);
            PG8_WAIT_L(8); PG8_BAR; PG8_WAIT_L(0); PG8_MMA(0, 0, At, B0); PG8_BAR; PG8_SCHED;
            PG8_LDB(B1, 0, 1); PG8_STAGE(PG8_SB(0, 0), b2, voffB);
            PG8_BAR; PG8_WAIT_L(0); PG8_MMA(0, 1, At, B1); PG8_BAR;
            PG8_LDA(At, 0, 1); PG8_STAGE(PG8_SA(0, 0), a2, voffA);
            PG8_BAR; PG8_WAIT_L(0); PG8_MMA(1, 0, At, B0); PG8_BAR; PG8_SCHED;
            PG8_STAGE(PG8_SB(0, 1), b2 + hstep, voffB);
            PG8_WAIT_V(6); PG8_BAR; PG8_MMA(1, 1, At, B1); PG8_BAR;
            PG8_LDB(B0, 1, 0); PG8_SCHED; PG8_LDA(At, 1, 0); PG8_STAGE(PG8_SA(0, 1), a2 + hstep, voffA);
            PG8_WAIT_L(8); PG8_BAR; PG8_WAIT_L(0); PG8_MMA(0, 0, At, B0); PG8_BAR; PG8_SCHED;
            PG8_LDB(B1, 1, 1); PG8_STAGE(PG8_SB(1, 0), b3, voffB);
            PG8_BAR; PG8_WAIT_L(0); PG8_MMA(0, 1, At, B1); PG8_BAR;
            PG8_LDA(At, 1, 1); PG8_STAGE(PG8_SA(1, 0), a3, voffA);
            PG8_BAR; PG8_WAIT_L(0); PG8_MMA(1, 0, At, B0); PG8_BAR; PG8_SCHED;
            PG8_STAGE(PG8_SB(1, 1), b3 + hstep, voffB);
            PG8_WAIT_V(6); PG8_BAR; PG8_MMA(1, 1, At, B1); PG8_BAR;
            }
        }
        if constexpr (ALIGN_EPI) { if (wr == 0) PG8_BAR; }
        if constexpr (!Epi::AFTER_DRAIN) {
            { int ln_; asm volatile("v_mbcnt_lo_u32_b32 %0, -1, 0\n\tv_mbcnt_hi_u32_b32 %0, -1, %0" : "=&v"(ln_)); E(acc, cur, wr, wc, ln_ & 15, ln_ >> 4); }
            S.done(cur); }
        if (!has_next) break;
#pragma unroll
        for (int a = 0; a < 2; ++a)
#pragma unroll
            for (int b = 0; b < 2; ++b)
#pragma unroll
                for (int m = 0; m < 4; ++m)
#pragma unroll
                    for (int n = 0; n < 2; ++n) acc[a][b][m][n] = (f32x4){0.f, 0.f, 0.f, 0.f};
        cur = nxt; cA = nA; cB = nB; ++ui;
        if constexpr (ALIGN_EPI) { if (wr == 1) PG8_BAR; }
    }
    PG8_WAIT_V(0);
    if constexpr (!ALIGN_EPI) { if (wr == 0) PG8_BAR; }
    PG8_BAR;
    if constexpr (Epi::AFTER_DRAIN) { E.fused(acc, cur, wr, wc, fr, fq, lds, wid, lane); S.done(cur); }
#undef PG8_SA
#undef PG8_SB
#undef PG8_STAGE
#undef PG8_LDA
#undef PG8_LDB
#undef PG8_MMA
#undef PG8_CAT8
#undef PG8_WAIT_V
#undef PG8_WAIT_L
#undef PG8_BAR
#undef PG8_SCHED
}
struct Gemm2 { const bf16_t* A; const bf16_t* Bt; int M, N, K, Ks; const bf16_t* A8; const bf16_t* B8; int K8; };
template <class Epi, class Sched>
__device__ __forceinline__ void gemm_phase_tail8(PG8_LAS unsigned char* lds, const Gemm2 g, const Sched& S, const Epi& E, const int wid) {
    int lane_; asm volatile("v_mbcnt_lo_u32_b32 %0, -1, 0\n\tv_mbcnt_hi_u32_b32 %0, -1, %0" : "=&v"(lane_));
    const int tid = wid * 64 + lane_, wr = wid >> 2, wc = wid & 3;
    const int ntA = g.K / BK, ntB = g.K8 / (2 * BK);
    unsigned voff[1]; voff[0] = (unsigned)(tid * 16);
    const size_t kstep = 32768, hstep = 16384, tstepA = (size_t)(g.Ks / BK) * 32768, tstepB = (size_t)ntB * 32768;
    const unsigned ldsw = (unsigned)wid * 1024u; const unsigned ldsb_ = (unsigned)(uintptr_t)lds + ldsw;
#define PT_SA(b, h) (((b) * 2 + (h)) * HTB)
#define PT_SB(b, h) ((4 + (b) * 2 + (h)) * HTB)
#define PT_STAGE(bufoff, gbase) do { _Pragma("unroll") for (int _i = 0; _i < 2; ++_i) { const char* gb_ = (const char*)(gbase) + _i * 8192; \
        asm volatile("s_mov_b32 m0, %0\n\ts_nop 0\n\tglobal_load_lds_dwordx4 %1, %2" :: "s"(ldsb_ + (unsigned)((bufoff) + _i * 8192)), "v"(voff[0]), "s"(gb_) : "memory", "m0"); } } while (0)
#define PT_LDA(F8, b, h) do { if constexpr (F8) { _Pragma("unroll") for (int m = 0; m < 4; ++m) { const bf16x8 lo_ = *(const PG8_LAS bf16x8*)(lds + PT_SA(b, h) + aoff + m * 2048), hi_ = *(const PG8_LAS bf16x8*)(lds + PT_SA(b, h) + aoff + m * 2048 + 1024); \
        At8[m] = __builtin_shufflevector(lo_, hi_, 0, 1, 2, 3, 4, 5, 6, 7, 8, 9, 10, 11, 12, 13, 14, 15); } } \
      else { _Pragma("unroll") for (int m = 0; m < 4; ++m) _Pragma("unroll") for (int k = 0; k < 2; ++k) At[m][k] = *(const PG8_LAS bf16x8*)(lds + PT_SA(b, h) + aoff + m * 2048 + k * 1024); } } while (0)
#define PT_LDB(F8, dst, b, h) do { if constexpr (F8) { _Pragma("unroll") for (int n = 0; n < 2; ++n) { const bf16x8 lo_ = *(const PG8_LAS bf16x8*)(lds + PT_SB(b, h) + boff + n * 2048), hi_ = *(const PG8_LAS bf16x8*)(lds + PT_SB(b, h) + boff + n * 2048 + 1024); \
        dst##8[n] = __builtin_shufflevector(lo_, hi_, 0, 1, 2, 3, 4, 5, 6, 7, 8, 9, 10, 11, 12, 13, 14, 15); } } \
      else { _Pragma("unroll") for (int n = 0; n < 2; ++n) _Pragma("unroll") for (int k = 0; k < 2; ++k) dst[n][k] = *(const PG8_LAS bf16x8*)(lds + PT_SB(b, h) + boff + n * 2048 + k * 1024); } } while (0)
#define PT_MMA(F8, ai, bj, Bt) do { __builtin_amdgcn_s_setprio(1); if constexpr (F8) { _Pragma("unroll") for (int m = 0; m < 4; ++m) _Pragma("unroll") for (int n = 0; n < 2; ++n) \
        acc[ai][bj][m][n] = __builtin_amdgcn_mfma_scale_f32_16x16x128_f8f6f4(__builtin_bit_cast(i32x8v, Bt##8[n]), __builtin_bit_cast(i32x8v, At8[m]), acc[ai][bj][m][n], 0, 0, 0, 0x78787878, 0, 0x7f7f7f7f); } \
      else { _Pragma("unroll") for (int m = 0; m < 4; ++m) _Pragma("unroll") for (int n = 0; n < 2; ++n) _Pragma("unroll") for (int k = 0; k < 2; ++k) \
        acc[ai][bj][m][n] = __builtin_amdgcn_mfma_f32_16x16x32_bf16(Bt[n][k], At[m][k], acc[ai][bj][m][n], 0, 0, 0); } __builtin_amdgcn_s_setprio(0); } while (0)
#define PT_WV asm volatile("s_waitcnt vmcnt(8)" ::: "memory")
#define PT_WL asm volatile("s_waitcnt lgkmcnt(0)" ::: "memory")
#define PT_BAR __builtin_amdgcn_s_barrier()
#define PT_SCHED __builtin_amdgcn_sched_barrier(0)
#define PT_BODY(F8) do { \
            PT_LDB(F8, B0, 0, 0); PT_LDB(F8, B1, 0, 1); PT_SCHED; PT_LDA(F8, 0, 0); PT_STAGE(PT_SA(1, 1), a1 + hstep); \
            PT_WV; PT_WL; PT_BAR; PT_MMA(F8, 0, 0, B0); PT_MMA(F8, 0, 1, B1); PT_BAR; PT_SCHED; \
            PT_LDA(F8, 0, 1); PT_STAGE(PT_SB(0, 0), b2); PT_STAGE(PT_SB(0, 1), b2 + hstep); PT_STAGE(PT_SA(0, 0), a2); \
            PT_WV; PT_WL; PT_BAR; PT_MMA(F8, 1, 0, B0); PT_MMA(F8, 1, 1, B1); PT_BAR; PT_SCHED; \
            PT_LDB(F8, B0, 1, 0); PT_LDB(F8, B1, 1, 1); PT_SCHED; PT_LDA(F8, 1, 0); PT_STAGE(PT_SA(0, 1), a2 + hstep); \
            PT_WV; PT_WL; PT_BAR; PT_MMA(F8, 0, 0, B0); PT_MMA(F8, 0, 1, B1); PT_BAR; PT_SCHED; \
            PT_LDA(F8, 1, 1); PT_STAGE(PT_SB(1, 0), b3); PT_STAGE(PT_SB(1, 1), b3 + hstep); PT_STAGE(PT_SA(1, 0), a3); \
            PT_WV; PT_WL; PT_BAR; PT_MMA(F8, 1, 0, B0); PT_MMA(F8, 1, 1, B1); PT_BAR; PT_SCHED; } while (0)
    Unit cur, nxt; int ui = 0;
    if (!S.next(0, cur)) return;
    f32x4 acc[2][2][4][2];
#pragma unroll
    for (int a = 0; a < 2; ++a)
#pragma unroll
        for (int b = 0; b < 2; ++b)
#pragma unroll
            for (int m = 0; m < 4; ++m)
#pragma unroll
                for (int n = 0; n < 2; ++n) acc[a][b][m][n] = (f32x4){0.f, 0.f, 0.f, 0.f};
    bf16x8 At[4][2], B0[2][2], B1[2][2];
    bf16x16v At8[4], B08[2], B18[2];
    const char* cA = (const char*)g.A + (size_t)cur.pm * tstepA; const char* cB = (const char*)g.Bt + (size_t)cur.pn * tstepA;
    const char* cA8 = (const char*)g.A8 + (size_t)cur.pm * tstepB; const char* cB8 = (const char*)g.B8 + (size_t)cur.pn * tstepB;
    PT_STAGE(PT_SB(0, 0), cB); PT_STAGE(PT_SB(0, 1), cB + hstep); PT_STAGE(PT_SA(0, 0), cA); PT_STAGE(PT_SA(0, 1), cA + hstep);
    if (wr == 1) PT_BAR;
    asm volatile("s_waitcnt vmcnt(2)" ::: "memory"); PT_BAR;
    PT_STAGE(PT_SB(1, 0), cB + kstep); PT_STAGE(PT_SA(1, 0), cA + kstep); PT_STAGE(PT_SB(1, 1), cB + hstep + kstep);
    asm volatile("s_waitcnt vmcnt(6)" ::: "memory"); PT_BAR;
    for (;;) {
        const bool has_next = S.next(ui + 1, nxt);
        const char* nA = has_next ? (const char*)g.A + (size_t)nxt.pm * tstepA : cA; const char* nB = has_next ? (const char*)g.Bt + (size_t)nxt.pn * tstepA : cB;
        {
            int ln_; asm volatile("v_mbcnt_lo_u32_b32 %0, -1, 0\n\tv_mbcnt_hi_u32_b32 %0, -1, %0" : "=&v"(ln_));
            const int aoff = lds_byte(wr * 64 + (ln_ & 15), (ln_ >> 4) * 8), boff = lds_byte(wc * 32 + (ln_ & 15), (ln_ >> 4) * 8);
            for (int t = 0; t < ntA; t += 2) { const bool last = (t == ntA - 2);
                const char* a1 = cA + (size_t)(t + 1) * kstep;
                const char* a2 = last ? cA8 : cA + (size_t)(t + 2) * kstep; const char* b2 = last ? cB8 : cB + (size_t)(t + 2) * kstep;
                const char* a3 = a2 + kstep; const char* b3 = b2 + kstep;
                PT_BODY(false); } }
        {
            int ln_; asm volatile("v_mbcnt_lo_u32_b32 %0, -1, 0\n\tv_mbcnt_hi_u32_b32 %0, -1, %0" : "=&v"(ln_));
            const int aoff = wr * 8192 + ln_ * 16, boff = wc * 4096 + ln_ * 16;
            for (int t = 0; t < ntB; t += 2) { const bool last = (t == ntB - 2);
                const char* a1 = cA8 + (size_t)(t + 1) * kstep;
                const char* a2 = last ? nA : cA8 + (size_t)(t + 2) * kstep; const char* b2 = last ? nB : cB8 + (size_t)(t + 2) * kstep;
                const char* a3 = a2 + kstep; const char* b3 = b2 + kstep;
                PT_BODY(true); } }
        if (wr == 0) PT_BAR;
        { int ln_; asm volatile("v_mbcnt_lo_u32_b32 %0, -1, 0\n\tv_mbcnt_hi_u32_b32 %0, -1, %0" : "=&v"(ln_)); E(acc, cur, wr, wc, ln_ & 15, ln_ >> 4); }
        if (!has_next) break;
#pragma unroll
        for (int a = 0; a < 2; ++a)
#pragma unroll
            for (int b = 0; b < 2; ++b)
#pragma unroll
                for (int m = 0; m < 4; ++m)
#pragma unroll
                    for (int n = 0; n < 2; ++n) acc[a][b][m][n] = (f32x4){0.f, 0.f, 0.f, 0.f};
        cur = nxt; cA = nA; cB = nB; cA8 = (const char*)g.A8 + (size_t)cur.pm * tstepB; cB8 = (const char*)g.B8 + (size_t)cur.pn * tstepB; ++ui;
        if (wr == 1) PT_BAR;
    }
    asm volatile("s_waitcnt vmcnt(0)" ::: "memory");
    PT_BAR;
#undef PT_SA
#undef PT_SB
#undef PT_STAGE
#undef PT_LDA
#undef PT_LDB
#undef PT_MMA
#undef PT_WV
#undef PT_WL
#undef PT_BAR
#undef PT_SCHED
#undef PT_BODY
}
}

#ifndef PG8_SP2
#define PG8_SP2 true
#endif
#ifndef PG8_ALIGN
#define PG8_ALIGN true
#endif
#ifndef PROBE_MASK
#define PROBE_MASK 0
#endif
#ifndef WGM_DOWN
#define WGM_DOWN 4
#endif
#ifndef PROBE_VAR
#define PROBE_VAR 0
#endif
constexpr int DN8_PN = 24;
constexpr int DN8_KT = 86 - DN8_PN;
#ifndef MK_N_LAUNCHES
#define MK_N_LAUNCHES 1
#endif

constexpr int D = 4096, DFF = 11008, NUP = 2 * DFF, NIN = 10240, AW = 2048, LW = 2048;
constexpr int MP = 16384, MS = 8192, MTOK = MP + MS;
constexpr int NMEM = 9 * 256;
constexpr int XAW = 512;
constexpr float EPS = 1e-6f;
constexpr int NWAVES = 8;
constexpr int N_PHASES = 13;

constexpr size_t MiB = 1u << 20;
constexpr size_t WS_CTL = 0, CTL_ZERO_BYTES = 2 * MiB;
constexpr size_t WS_WG = 2 * MiB, WS_WQ = 4 * MiB, WS_WKV = 8 * MiB, WS_WO = 16 * MiB, WS_MEMN = 20 * MiB;
constexpr size_t WS_WOUT = 38 * MiB, WS_WIN = 70 * MiB, WS_WUP1 = 150 * MiB, WS_WDN1 = 322 * MiB, WS_WUP2 = 408 * MiB, WS_WDN2 = 580 * MiB;
constexpr size_t WS_XN = 666 * MiB, WS_YA = WS_XN, WS_HF = WS_XN + 96 * MiB;
constexpr size_t WS_Y = 858 * MiB, WS_HB = 1050 * MiB, WS_PROJ = WS_HB, WS_XQ = WS_HB, WS_XO = WS_HB + 24 * MiB, WS_KVM = WS_HB + 48 * MiB;
constexpr size_t WS_HBK = 1566 * MiB, WS_END = 1662 * MiB;
static_assert(WS_WUP1 + (size_t)NUP * D * 2 <= WS_WDN1 && WS_WDN1 + (size_t)D * DFF * 2 <= WS_WUP2 && WS_WUP2 + (size_t)NUP * D * 2 <= WS_WDN2 && WS_WDN2 + (size_t)D * DFF * 2 <= WS_XN, "ws map (ffn weights)");
static_assert(WS_XN + (size_t)MTOK * D * 2 <= WS_Y && WS_Y + (size_t)MTOK * D * 2 <= WS_HB && WS_HB + (size_t)MTOK * DFF * 2 <= WS_HBK && WS_HBK + (size_t)MTOK * LW * 2 <= WS_END, "ws map (activations)");
static_assert(WS_MEMN + (size_t)NMEM * D * 2 <= WS_WOUT && WS_WOUT + (size_t)D * D * 2 <= WS_WIN && WS_WIN + (size_t)NIN * D * 2 <= WS_WUP1, "ws map (small)");
constexpr int CW_NACTR = 64;
constexpr int CW_CONVCTR = 256;
constexpr int CW_BAR = 4096;
constexpr int CW_SS = 16384;
static_assert((CW_SS + 6 * MTOK * 2) * 4 <= (int)CTL_ZERO_BYTES, "CTL words inside the memset region");

constexpr int RING_OFF = 0, RING_BYTES = 131072;
constexpr int LDSCTL_OFF = RING_BYTES, MISC_OFF = LDSCTL_OFF + 320;
constexpr int LDS_BYTES = 147456;
constexpr int XBPTR_LDS_OFF = RING_BYTES + 320 + 80;
constexpr int NA_BIAS_OFF = RING_BYTES + 1024;

#define GAS __attribute__((address_space(1)))
#define LAS __attribute__((address_space(3)))
typedef unsigned short bf16;
typedef unsigned v4u __attribute__((ext_vector_type(4)));
typedef unsigned v2u __attribute__((ext_vector_type(2)));
typedef float f32x4 __attribute__((ext_vector_type(4)));
typedef GAS unsigned gu32;
#define LDS_WAIT() asm volatile("s_waitcnt lgkmcnt(0)" ::: "memory")
#define VM_WAIT() asm volatile("s_waitcnt vmcnt(0)" ::: "memory")
__device__ __forceinline__ unsigned f2bf(float f) { unsigned u = __builtin_bit_cast(unsigned, f); return (u + 0x7fffu + ((u >> 16) & 1u)) >> 16; }
__device__ __forceinline__ unsigned pk2(float lo, float hi) { return f2bf(lo) | (f2bf(hi) << 16); }
__device__ __forceinline__ float bflo(unsigned w) { return __uint_as_float(w << 16); }
__device__ __forceinline__ float bfhi(unsigned w) { return __uint_as_float(w & 0xffff0000u); }
__device__ __forceinline__ float bf2f(bf16 b) { return __uint_as_float(((unsigned)b) << 16); }
__device__ __forceinline__ float wave_sum(float v) {
#pragma unroll
    for (int o = 1; o < 64; o <<= 1) v += __shfl_xor(v, o);
    return v;
}
__device__ __forceinline__ void unpack8(const v4u w, float (&f)[8]) { f[0] = bflo(w.x); f[1] = bfhi(w.x); f[2] = bflo(w.y); f[3] = bfhi(w.y); f[4] = bflo(w.z); f[5] = bfhi(w.z); f[6] = bflo(w.w); f[7] = bfhi(w.w); }

namespace pg8 {
typedef unsigned long long ssq_t;
__device__ __forceinline__ float ss_get(const ssq_t* p) { const ssq_t v = *p; return ((float)(unsigned)(v >> 32) * 4294967296.0f + (float)(unsigned)v) * (1.0f / 65536.0f); }
__device__ __forceinline__ ssq_t ss_fix(float s) { return (ssq_t)(s * 65536.0f); }
__device__ __forceinline__ float ss_val(ssq_t v) { return ((float)(unsigned)(v >> 32) * 4294967296.0f + (float)(unsigned)v) * (1.0f / 65536.0f); }
struct EpiSwiGLU {
    static constexpr bool PERM = true, AFTER_DRAIN = false; static constexpr int NVM_MIN = 8;
    bf16_t* H; const ssq_t* ss; int pn8; float rsc; char* H8;
    __device__ __forceinline__ void operator()(const f32x4 (&acc)[2][2][4][2], const Unit& u, int wr, int wc, int fr, int fq) const {
        const int row0 = u.pm * BM + wr * 64 + fr, col0 = u.pn * HALF + wc * 32 + 8 * fq;
        ssq_t sv[2][4];
#pragma unroll
        for (int ai = 0; ai < 2; ++ai)
#pragma unroll
            for (int m = 0; m < 4; ++m) sv[ai][m] = ss[row0 + ai * HALF + m * 16];
#pragma unroll
        for (int ai = 0; ai < 2; ++ai)
#pragma unroll
            for (int m = 0; m < 4; ++m) { const int row = row0 + ai * HALF + m * 16; const float rs = rsqrtf(ss_val(sv[ai][m]) * (1.0f / 4096.0f) + 1e-6f) * rsc;
                float hv[8]; const float nlr = -1.4426950408889634f * rs, rs2 = rs * rs;
#pragma unroll
                for (int n = 0; n < 2; ++n)
#pragma unroll
                    for (int j = 0; j < 4; j += 2) { const f32x2 a2 = {acc[ai][0][m][n][j], acc[ai][0][m][n][j + 1]}, b2 = {acc[ai][1][m][n][j], acc[ai][1][m][n][j + 1]};
                        const f32x2 t = a2 * nlr; f32x2 e; e.x = __builtin_amdgcn_exp2f(t.x); e.y = __builtin_amdgcn_exp2f(t.y);
                        const f32x2 d = e + 1.0f; f32x2 s; s.x = __builtin_amdgcn_rcpf(d.x); s.y = __builtin_amdgcn_rcpf(d.y);
                        const f32x2 r = (a2 * b2) * (s * rs2); hv[4 * n + j] = r.x; hv[4 * n + j + 1] = r.y; }
                if (u.pn >= pn8) { int w0 = 0, w1 = 0; w0 = __builtin_amdgcn_cvt_pk_fp8_f32(hv[0], hv[1], w0, false); w0 = __builtin_amdgcn_cvt_pk_fp8_f32(hv[2], hv[3], w0, true);
                    w1 = __builtin_amdgcn_cvt_pk_fp8_f32(hv[4], hv[5], w1, false); w1 = __builtin_amdgcn_cvt_pk_fp8_f32(hv[6], hv[7], w1, true);
                    typedef int i32x2v __attribute__((ext_vector_type(2))); *(i32x2v*)(H8 + blk8_off(row, col0 - pn8 * HALF, 86 - pn8)) = (i32x2v){w0, w1}; }
                else { u32x4 w; w.x = cvt_pk_bf16(hv[0], hv[1]); w.y = cvt_pk_bf16(hv[2], hv[3]); w.z = cvt_pk_bf16(hv[4], hv[5]); w.w = cvt_pk_bf16(hv[6], hv[7]);
                    *(u32x4*)((char*)H + blk_off(row, col0, 172)) = w; } }
    }
};
struct EpiNull {
    static constexpr bool PERM = true, AFTER_DRAIN = false; static constexpr int NVM_MIN = 0;
    __device__ __forceinline__ void operator()(const f32x4 (&acc)[2][2][4][2], const Unit&, int, int, int, int) const {
#pragma unroll
        for (int a = 0; a < 2; ++a)
#pragma unroll
            for (int b = 0; b < 2; ++b)
#pragma unroll
                for (int m = 0; m < 4; ++m)
#pragma unroll
                    for (int n = 0; n < 2; ++n) asm volatile("" :: "v"(acc[a][b][m][n])); }
};
template <class E_> struct EpiTwice {
    static constexpr bool PERM = E_::PERM, AFTER_DRAIN = false; static constexpr int NVM_MIN = E_::NVM_MIN; E_ e;
    __device__ __forceinline__ void operator()(const f32x4 (&acc)[2][2][4][2], const Unit& u, int wr, int wc, int fr, int fq) const { e(acc, u, wr, wc, fr, fq); asm volatile("" ::: "memory"); e(acc, u, wr, wc, fr, fq); }
};
struct EpiResid {
    static constexpr bool PERM = true, AFTER_DRAIN = false; static constexpr int NVM_MIN = 16;
    bf16_t* xb; ssq_t* ssout; char* x8; float alpha;
    __device__ __forceinline__ void operator()(const f32x4 (&acc)[2][2][4][2], const Unit& u, int wr, int wc, int fr, int fq) const {
        const int row0 = u.pm * BM + wr * 64 + fr, col0 = u.pn * BM + wc * 32 + 8 * fq;
        bf16_t* xb = this->xb;
        if (!xb) {
            const unsigned lo_ = __builtin_amdgcn_readfirstlane(*(volatile PG8_LAS unsigned*)(PG8_LAS unsigned char*)(uintptr_t)XBPTR_LDS_OFF), hi_ = __builtin_amdgcn_readfirstlane(*(volatile PG8_LAS unsigned*)(PG8_LAS unsigned char*)(uintptr_t)(XBPTR_LDS_OFF + 4));
            xb = (bf16_t*)(((unsigned long long)hi_ << 32) | lo_); }
        u32x4 xv[2][4][2];
#pragma unroll
        for (int ai = 0; ai < 2; ++ai)
#pragma unroll
            for (int m = 0; m < 4; ++m)
#pragma unroll
                for (int bj = 0; bj < 2; ++bj) { unsigned long long o_ = blk_off(row0 + ai * HALF + m * 16, col0 + bj * HALF, 64); asm volatile("" : "+v"(o_)); xv[ai][m][bj] = *(const u32x4*)((const char*)xb + o_); }
#pragma unroll
        for (int ai = 0; ai < 2; ++ai)
#pragma unroll
            for (int m = 0; m < 4; ++m) { const int row = row0 + ai * HALF + m * 16; float sq = 0.f;
#pragma unroll
                for (int bj = 0; bj < 2; ++bj) { unsigned long long o_ = blk_off(row, col0 + bj * HALF, 64); asm volatile("" : "+v"(o_));
                    u32x4* p = (u32x4*)((char*)xb + o_); const u32x4 xi = xv[ai][m][bj];
                    const f32x4 a0 = acc[ai][bj][m][0] * alpha, a1 = acc[ai][bj][m][1] * alpha;
                    const float v0 = __uint_as_float(xi.x << 16) + a0[0], v1 = __uint_as_float(xi.x & 0xffff0000u) + a0[1], v2 = __uint_as_float(xi.y << 16) + a0[2], v3 = __uint_as_float(xi.y & 0xffff0000u) + a0[3];
                    const float v4 = __uint_as_float(xi.z << 16) + a1[0], v5 = __uint_as_float(xi.z & 0xffff0000u) + a1[1], v6 = __uint_as_float(xi.w << 16) + a1[2], v7 = __uint_as_float(xi.w & 0xffff0000u) + a1[3];
                    sq += ((v0 * v0 + v1 * v1) + (v2 * v2 + v3 * v3)) + ((v4 * v4 + v5 * v5) + (v6 * v6 + v7 * v7));
                    u32x4 w; w.x = cvt_pk_bf16(v0, v1); w.y = cvt_pk_bf16(v2, v3); w.z = cvt_pk_bf16(v4, v5); w.w = cvt_pk_bf16(v6, v7); *p = w;
                    if (x8) { int w0 = 0, w1 = 0; w0 = __builtin_amdgcn_cvt_pk_fp8_f32(v0, v1, w0, false); w0 = __builtin_amdgcn_cvt_pk_fp8_f32(v2, v3, w0, true); w1 = __builtin_amdgcn_cvt_pk_fp8_f32(v4, v5, w1, false); w1 = __builtin_amdgcn_cvt_pk_fp8_f32(v6, v7, w1, true);
                        typedef int i32x2v __attribute__((ext_vector_type(2))); *(i32x2v*)(x8 + blk8_off(row, col0 + bj * HALF, 32)) = (i32x2v){w0, w1}; } }
                { const int la_ = (fq * 16 + fr) << 2;
                  sq += __builtin_bit_cast(float, __builtin_amdgcn_ds_bpermute(la_ ^ 64, __builtin_bit_cast(int, sq))); sq += __builtin_bit_cast(float, __builtin_amdgcn_ds_bpermute(la_ ^ 128, __builtin_bit_cast(int, sq))); }
                if (fq == 0 && ssout) atomicAdd(ssout + row, ss_fix(sq)); }
    }
};
struct EpiScaleBf16 {
    static constexpr bool PERM = true, AFTER_DRAIN = false; static constexpr int NVM_MIN = 16;
    bf16_t* O; int ldc; const ssq_t* ss; float qscale; int qcols;
    __device__ __forceinline__ void operator()(const f32x4 (&acc)[2][2][4][2], const Unit& u, int wr, int wc, int fr, int fq) const {
        const int row0 = u.pm * BM + wr * 64 + fr, col0 = u.pn * BM + wc * 32 + 8 * fq;
        const float sc = (u.pn * BM < qcols) ? qscale : 1.0f;
        ssq_t sv[2][4];
#pragma unroll
        for (int ai = 0; ai < 2; ++ai)
#pragma unroll
            for (int m = 0; m < 4; ++m) sv[ai][m] = ss ? ss[row0 + ai * HALF + m * 16] : 0ull;
#pragma unroll
        for (int ai = 0; ai < 2; ++ai)
#pragma unroll
            for (int m = 0; m < 4; ++m) { const int row = row0 + ai * HALF + m * 16; const float rs = (ss ? rsqrtf(ss_val(sv[ai][m]) * (1.0f / 4096.0f) + 1e-6f) : 1.0f) * sc;
                bf16_t* rowp = O + (size_t)row * ldc + col0;
#pragma unroll
                for (int bj = 0; bj < 2; ++bj) { const f32x4 v0 = acc[ai][bj][m][0] * rs, v1 = acc[ai][bj][m][1] * rs;
                    u32x4 w; w.x = cvt_pk_bf16(v0[0], v0[1]); w.y = cvt_pk_bf16(v0[2], v0[3]); w.z = cvt_pk_bf16(v1[0], v1[1]); w.w = cvt_pk_bf16(v1[2], v1[3]);
                    *(u32x4*)(rowp + bj * HALF) = w; } }
    }
};
struct EpiProj {
    static constexpr bool PERM = true, AFTER_DRAIN = false; static constexpr int NVM_MIN = 16;
    bf16_t* QKVH; bf16_t* UG; const ssq_t* ss; float qscale;
    __device__ __forceinline__ void operator()(const f32x4 (&acc)[2][2][4][2], const Unit& u, int wr, int wc, int fr, int fq) const {
        const int row0 = u.pm * BM + wr * 64 + fr, dimoff = wc * 32 + 8 * fq;
        const int kind = u.pn >> 3; const float sc = (kind == 0) ? qscale : 1.0f;
        ssq_t sv[2][4];
#pragma unroll
        for (int ai = 0; ai < 2; ++ai)
#pragma unroll
            for (int m = 0; m < 4; ++m) sv[ai][m] = ss[row0 + ai * HALF + m * 16];
#pragma unroll
        for (int ai = 0; ai < 2; ++ai)
#pragma unroll
            for (int m = 0; m < 4; ++m) { const int row = row0 + ai * HALF + m * 16; const float rs = rsqrtf(ss_val(sv[ai][m]) * (1.0f / 4096.0f) + 1e-6f) * sc;
#pragma unroll
                for (int bj = 0; bj < 2; ++bj) { const f32x4 v0 = acc[ai][bj][m][0] * rs, v1 = acc[ai][bj][m][1] * rs;
                    u32x4 w; w.x = cvt_pk_bf16(v0[0], v0[1]); w.y = cvt_pk_bf16(v0[2], v0[3]); w.z = cvt_pk_bf16(v1[0], v1[1]); w.w = cvt_pk_bf16(v1[2], v1[3]);
                    bf16_t* p = (u.pn < 24) ? QKVH + ((size_t)(kind * 16 + 2 * (u.pn & 7) + bj) * 24576 + row) * 128 + dimoff
                                            : UG + (size_t)row * 4096 + (u.pn - 24) * 256 + bj * HALF + dimoff;
                    *(u32x4*)p = w; } }
    }
};
}

__device__ __forceinline__ void transpose_item(const float* W, int K, int N, bf16* WTd, int k0, int n0, LAS float* scr, int lane) {
#pragma unroll 8
    for (int i = 0; i < 32; ++i) { const int kk = 2 * i + (lane >> 5); scr[kk * 33 + (lane & 31)] = W[(size_t)(k0 + kk) * N + n0 + (lane & 31)]; }
    LDS_WAIT(); asm volatile("" ::: "memory");
    const int c = lane & 7;
#pragma unroll
    for (int j = 0; j < 4; ++j) { const int n = (lane >> 3) + 8 * j; const LAS float* s = scr + (8 * c) * 33 + n;
        v4u o; o.x = pk2(s[0 * 33], s[1 * 33]); o.y = pk2(s[2 * 33], s[3 * 33]); o.z = pk2(s[4 * 33], s[5 * 33]); o.w = pk2(s[6 * 33], s[7 * 33]);
        *(GAS v4u*)(WTd + (size_t)n * K + k0 + 8 * c) = o; }
    LDS_WAIT(); asm volatile("" ::: "memory");
}
__device__ __forceinline__ void transpose_item_blk(const float* W, int K, int N, char* tkb, int k0, int n0, int r0, bool perm, const float* gk, LAS float* scr, int lane) {
    f32x4 v[8];
#pragma unroll
    for (int i = 0; i < 8; ++i) v[i] = *(const f32x4*)(W + (size_t)(k0 + (lane >> 3) + 8 * i) * N + n0 + (lane & 7) * 4);
#pragma unroll
    for (int i = 0; i < 8; ++i) { LAS float* d = scr + ((lane >> 3) + 8 * i) * 33 + (lane & 7) * 4; d[0] = v[i][0]; d[1] = v[i][1]; d[2] = v[i][2]; d[3] = v[i][3]; }
    const int c = lane & 7;
    f32x4 g0 = {1.f, 1.f, 1.f, 1.f}, g1 = {1.f, 1.f, 1.f, 1.f};
    if (gk) { g0 = *(const f32x4*)(gk + k0 + 8 * c); g1 = *(const f32x4*)(gk + k0 + 8 * c + 4); }
    LDS_WAIT(); asm volatile("" ::: "memory");
#pragma unroll
    for (int j = 0; j < 4; ++j) { const int n = (lane >> 3) + 8 * j; const LAS float* s = scr + (8 * c) * 33 + n;
        v4u o; o.x = pk2(s[0 * 33] * g0[0], s[1 * 33] * g0[1]); o.y = pk2(s[2 * 33] * g0[2], s[3 * 33] * g0[3]); o.z = pk2(s[4 * 33] * g1[0], s[5 * 33] * g1[1]); o.w = pk2(s[6 * 33] * g1[2], s[7 * 33] * g1[3]);
        const int rt = r0 + (perm ? pg8::perm32inv(n) : n);
        *(GAS v4u*)(tkb + ((rt >> 7) << 14) + pg8::lds_byte(rt & 127, 8 * c)) = o; }
    LDS_WAIT(); asm volatile("" ::: "memory");
}
__device__ __forceinline__ void transpose_item_f8(const float* W, int K, int N, char* tkb, int k0, int n0, int r0, bool perm, float scale, const float* gk, LAS float* scr, int lane) {
    f32x4 v[8];
#pragma unroll
    for (int i = 0; i < 8; ++i) v[i] = *(const f32x4*)(W + (size_t)(k0 + (lane >> 3) + 8 * i) * N + n0 + (lane & 7) * 4);
#pragma unroll
    for (int i = 0; i < 8; ++i) { LAS float* d = scr + ((lane >> 3) + 8 * i) * 33 + (lane & 7) * 4; d[0] = v[i][0]; d[1] = v[i][1]; d[2] = v[i][2]; d[3] = v[i][3]; }
    LDS_WAIT(); asm volatile("" ::: "memory");
    const int n = lane & 31, rt = r0 + (perm ? pg8::perm32inv(n) : n), r = rt & 127;
#pragma unroll
    for (int e = 0; e < 2; ++e) { const int c = (lane >> 5) + 2 * e; const LAS float* s = scr + (16 * c) * 33 + n; int w[4];
#pragma unroll
        for (int q = 0; q < 4; ++q) { f32x4 gq = {scale, scale, scale, scale}; if (gk) gq = *(const f32x4*)(gk + k0 + 16 * c + 4 * q) * scale;
            int t = 0; t = __builtin_amdgcn_cvt_pk_fp8_f32(s[(4 * q) * 33] * gq[0], s[(4 * q + 1) * 33] * gq[1], t, false); t = __builtin_amdgcn_cvt_pk_fp8_f32(s[(4 * q + 2) * 33] * gq[2], s[(4 * q + 3) * 33] * gq[3], t, true); w[q] = t; }
        const int c8 = ((k0 & 127) >> 4) + c;
        *(GAS v4u*)(tkb + ((rt >> 7) << 14) + (r >> 4) * 2048 + (c8 & 1) * 1024 + ((c8 >> 1) * 16 + (r & 15)) * 16) = (v4u){(unsigned)w[0], (unsigned)w[1], (unsigned)w[2], (unsigned)w[3]}; }
    LDS_WAIT(); asm volatile("" ::: "memory");
}
__device__ __forceinline__ void transpose_matrix(const float* W, int K, int N, bf16* WT, int row_off, bool perm, const float* gk, LAS float* scr, int lane, int gw, int NGW) {
    const int nblk = N / 32, nkt = K / 64, nitems = nkt * nblk;
    for (int it = gw; it < nitems; it += NGW) { const int kb = it / nblk, nb = it % nblk, drow = row_off + 32 * nb;
        transpose_item_blk(W, K, N, (char*)WT + ((size_t)((drow >> 8) * nkt + kb) << 15), 64 * kb, 32 * nb, drow & 255, perm, gk, scr, lane); }
}
__device__ __forceinline__ void transpose_up(const float* W1, const float* W3, bf16* WT, const float* gk, LAS float* scr, int lane, int gw, int NGW) {
    const int nblk = DFF / 32, nkt = D / 64, per = nkt * nblk;
    for (int it = gw; it < 2 * per; it += NGW) { const int which = it >= per, r = which ? it - per : it; const int kb = r / nblk, nb = r % nblk, n0 = 32 * nb;
        transpose_item_blk(which ? W3 : W1, D, DFF, (char*)WT + ((size_t)((n0 >> 7) * nkt + kb) << 15), 64 * kb, n0, (n0 & 127) + (which ? 128 : 0), true, gk, scr, lane); }
}

__device__ __forceinline__ float gelu_tanh(float x) { return 0.5f * x * (1.0f + tanhf(0.7978845608028654f * (x + 0.044715f * x * x * x))); }


typedef short bf16x8s __attribute__((ext_vector_type(8)));
typedef short s16x4 __attribute__((ext_vector_type(4)));
__device__ __forceinline__ s16x4 tr_read16(unsigned addr) { s16x4 r; asm volatile("ds_read_b64_tr_b16 %0, %1" : "=&v"(r) : "v"(addr) : "memory"); return r; }
template <bool IS_NA>
__device__ __forceinline__ void attn_task(const bf16* qp, const bf16* kbase, const bf16* vbase, size_t stride, int irows, const float* brow0, int c, int cs, int c0,
                                          bf16* op, int orow, int ocol, LAS unsigned char* wl, int lane) {
    const int fr = lane & 15, fq = lane >> 4;
    bf16x8s qf[4];
#pragma unroll
    for (int ks = 0; ks < 4; ++ks) qf[ks] = *(const bf16x8s*)(qp + 32 * ks);
    f32x4 S[8][2];
    bf16x8s kr[3][2][4];
#define AT_LOADK(slot, i) do { _Pragma("unroll") for (int hh = 0; hh < 2; ++hh) _Pragma("unroll") for (int ks = 0; ks < 4; ++ks) \
        kr[slot][hh][ks] = *(const bf16x8s*)(kbase + (size_t)((i) * irows + 4 * hh) * stride + 32 * ks); } while (0)
#define AT_SCORE(slot, i) do { _Pragma("unroll") for (int hh = 0; hh < 2; ++hh) { f32x4 a_ = {0.f, 0.f, 0.f, 0.f}; \
        _Pragma("unroll") for (int ks = 0; ks < 4; ++ks) a_ = __builtin_amdgcn_mfma_f32_16x16x32_bf16(kr[slot][hh][ks], qf[ks], a_, 0, 0, 0); S[i][hh] = a_; } } while (0)
    v4u vr[3][8];
#define AT_LOADV(slot, i) do { _Pragma("unroll") for (int inst = 0; inst < 8; ++inst) vr[slot][inst] = *(const v4u*)(vbase + (size_t)((i) * irows + 4 * inst) * stride); } while (0)
    AT_LOADK(0, 0); AT_LOADK(1, 1); AT_LOADK(2, 2);
    __builtin_amdgcn_sched_barrier(0);
#pragma unroll
    for (int i = 0; i < 8; ++i) {
        AT_SCORE(i % 3, i); __builtin_amdgcn_sched_barrier(0);
        if (i + 3 < 8) { AT_LOADK(i % 3, i + 3); } else { AT_LOADV(i - 5, i - 5); }
        __builtin_amdgcn_sched_barrier(0);
    }
#undef AT_LOADK
#undef AT_SCORE
    float mx = -1e30f;
#pragma unroll
    for (int hh = 0; hh < 2; ++hh)
#pragma unroll
        for (int j = 0; j < 4; ++j) {
            bool ok = true; int bi = 0;
            if (IS_NA) { const int kc = c0 + 8 * fq + 4 * hh + j; ok = (kc >= cs) && (kc < cs + 16); bi = min(max(kc - c + 15, 0), 30); }
#pragma unroll
            for (int i = 0; i < 8; ++i) { float s = S[i][hh][j]; if (IS_NA) { s = ok ? s + brow0[i * 31 + bi] : -1e30f; S[i][hh][j] = s; } mx = fmaxf(mx, s); } }
    mx = fmaxf(mx, __shfl_xor(mx, 16)); mx = fmaxf(mx, __shfl_xor(mx, 32));
    float l = 0.f;
    v4u pw[8];
#pragma unroll
    for (int i = 0; i < 8; ++i) {
#pragma unroll
        for (int hh = 0; hh < 2; ++hh)
#pragma unroll
            for (int j = 0; j < 4; ++j) { const float p = __builtin_amdgcn_exp2f((S[i][hh][j] - mx) * 1.4426950408889634f); S[i][hh][j] = p; l += p; }
        pw[i].x = pg8::cvt_pk_bf16(S[i][0][0], S[i][0][1]); pw[i].y = pg8::cvt_pk_bf16(S[i][0][2], S[i][0][3]); pw[i].z = pg8::cvt_pk_bf16(S[i][1][0], S[i][1][1]); pw[i].w = pg8::cvt_pk_bf16(S[i][1][2], S[i][1][3]); }
    l += __shfl_xor(l, 16); l += __shfl_xor(l, 32);
    const int rho0 = lane >> 4, ch = lane & 15, q_ = (lane & 15) >> 2, p_ = lane & 3;
    const unsigned wbase = (unsigned)(uintptr_t)wl;
    unsigned rrow[2], rf[2];
#pragma unroll
    for (int h2 = 0; h2 < 2; ++h2) { const int row = 8 * fq + 4 * h2 + q_; rrow[h2] = wbase + 256u * row + 8u * (p_ & 1); rf[h2] = (unsigned)((q_ << 2) | ((2 * fq + h2) & 3)); }
    f32x4 O[8];
#pragma unroll
    for (int dt = 0; dt < 8; ++dt) O[dt] = (f32x4){0.f, 0.f, 0.f, 0.f};
#pragma unroll
    for (int i = 0; i < 8; ++i) {
#pragma unroll
        for (int inst = 0; inst < 8; ++inst) { const int rho = rho0 + 4 * inst; const int f = (rho0 << 2) | (inst & 3); *(LAS v4u*)(wl + 256 * rho + 16 * (ch ^ f)) = vr[i % 3][inst]; }
        if (i + 3 < 8) { AT_LOADV(i % 3, i + 3); }
        const bf16x8s pf = __builtin_bit_cast(bf16x8s, pw[i]);
        s16x4 lo[8], hi[8];
#pragma unroll
        for (int dt = 0; dt < 8; ++dt) { lo[dt] = tr_read16(rrow[0] + 16u * ((unsigned)(2 * dt + (p_ >> 1)) ^ rf[0])); hi[dt] = tr_read16(rrow[1] + 16u * ((unsigned)(2 * dt + (p_ >> 1)) ^ rf[1])); }
        asm volatile("s_waitcnt lgkmcnt(0)" ::: "memory"); __builtin_amdgcn_sched_barrier(0);
#pragma unroll
        for (int dt = 0; dt < 8; ++dt) { const bf16x8s vf = (bf16x8s){lo[dt][0], lo[dt][1], lo[dt][2], lo[dt][3], hi[dt][0], hi[dt][1], hi[dt][2], hi[dt][3]};
            O[dt] = __builtin_amdgcn_mfma_f32_16x16x32_bf16(vf, pf, O[dt], 0, 0, 0); }
    }
#undef AT_LOADV
    const float inv = 1.0f / l;
#pragma unroll
    for (int dt = 0; dt < 8; ++dt) { const f32x4 v = O[dt] * inv; v2u o; o.x = pg8::cvt_pk_bf16(v[0], v[1]); o.y = pg8::cvt_pk_bf16(v[2], v[3]);
        if (IS_NA) *(v2u*)(op + dt * 16) = o; else *(v2u*)((char*)op + pg8::blk_off(orow, ocol + dt * 16, 8)) = o; }
}
__device__ __forceinline__ void na_block_task(int t, const bf16* PROJ, const float* rpb, bf16* YA, LAS unsigned char* lds, int wave, int lane, int dup = 0) {
    const int hp = t / 384, R = t % 384, g = wave & 3, h = 2 * hp + (dup ? 0 : (wave >> 2));
    int r, rows, seq0; if (R < 256) { seq0 = (R >> 5) * 2048; r = R & 31; rows = 32; } else { seq0 = MP; r = R - 256; rows = 128; }
    const int fr = lane & 15, fq = lane >> 4;
    const int rst = min(max(r - 4, 0), rows - 8), c0 = min(max(16 * g - 8, 0), 32), c = 16 * g + fr, cs = min(max(c - 8, 0), 48);
    const size_t m = (size_t)R * 64 + c;
    const bf16* qp = PROJ + ((size_t)h * MTOK + m) * 128 + 8 * fq;
    const bf16* kbase = PROJ + ((size_t)(16 + h) * MTOK + seq0 + rst * 64 + c0 + 8 * (fr >> 2) + (fr & 3)) * 128 + 8 * fq;
    const bf16* vbase = PROJ + ((size_t)(32 + h) * MTOK + seq0 + rst * 64 + c0 + (lane >> 4)) * 128 + (lane & 15) * 8;
    const float* brow0 = rpb + (h * 15 + (rst - r + 7)) * 31;
    attn_task<true>(qp, kbase, vbase, (size_t)128, 64, brow0, c, cs, c0, YA + m * AW + h * 128 + 4 * fq, 0, 0, lds + RING_OFF + wave * 8192, lane);
}
__device__ __forceinline__ void wait_vmcnt_n(int n) {
    switch (n) { case 0: asm volatile("s_waitcnt vmcnt(0)" ::: "memory"); break; case 2: asm volatile("s_waitcnt vmcnt(2)" ::: "memory"); break; case 4: asm volatile("s_waitcnt vmcnt(4)" ::: "memory"); break;
                 case 6: asm volatile("s_waitcnt vmcnt(6)" ::: "memory"); break; case 8: asm volatile("s_waitcnt vmcnt(8)" ::: "memory"); break; case 10: asm volatile("s_waitcnt vmcnt(10)" ::: "memory"); break;
                 case 12: asm volatile("s_waitcnt vmcnt(12)" ::: "memory"); break; default: asm volatile("s_waitcnt vmcnt(0)" ::: "memory"); break; } }
template <int OFF>
__device__ __forceinline__ void na_coop_body(const bf16* kg, const bf16* vg, int nU, const bf16* qp, const LAS float* brow0, int c, int cs, int c0, bf16* op, LAS unsigned char* lds, int wave, int lane) {
    constexpr int NR = 8;
    const int fr = lane & 15, fq = lane >> 4;
    bf16x8s qf[4];
#pragma unroll
    for (int ks = 0; ks < 4; ++ks) qf[ks] = *(const bf16x8s*)(qp + 32 * ks);
    unsigned goff[2];
#pragma unroll
    for (int e = 0; e < 2; ++e) { const int key = wave * 8 + e * 4 + (lane >> 4), chp = lane & 15, f = ((key & 3) << 2) | ((key >> 2) & 3); goff[e] = (unsigned)((key * 128 + (chp ^ f) * 8) * 2); }
#define NC_ISSUE(it) do { const int j_ = ((it) % 9) < nU ? ((it) % 9) : nU - 1; const bf16* b_ = ((it) < 9 ? kg : vg) + (size_t)j_ * 64 * 128; \
        _Pragma("unroll") for (int e_ = 0; e_ < 2; ++e_) __builtin_amdgcn_global_load_lds((const unsigned*)((const char*)b_ + goff[e_]), (LAS unsigned*)(lds + ((it) % NR) * 16384 + wave * 2048 + e_ * 1024), 16, 0, 0); } while (0)
#define NC_NWAIT(it) (2 * (((it) + NR - 2 < 17 ? (it) + NR - 2 : 17) - (it)))
#pragma unroll
    for (int s_ = 0; s_ < NR - 1; ++s_) { NC_ISSUE(s_); }
    unsigned kro[2], krf[2];
#pragma unroll
    for (int hh = 0; hh < 2; ++hh) { const int key = c0 + 8 * (fr >> 2) + 4 * hh + (fr & 3); kro[hh] = (unsigned)(256 * key); krf[hh] = (unsigned)(((key & 3) << 2) | ((key >> 2) & 3)); }
    f32x4 S[8][2];
#pragma unroll
    for (int it = 0; it < 9; ++it) {
        unsigned rb_ = (unsigned)((it % NR) * 16384); asm volatile("" : "+s"(rb_));
        LAS unsigned char* buf = lds + rb_;
        wait_vmcnt_n(NC_NWAIT(it)); __builtin_amdgcn_s_barrier(); asm volatile("" ::: "memory");
        NC_ISSUE(it + NR - 1);
        if (it - OFF >= 0 && it - OFF < 8) {
#pragma unroll
            for (int hh = 0; hh < 2; ++hh) { f32x4 a_ = {0.f, 0.f, 0.f, 0.f};
#pragma unroll
                for (int ks = 0; ks < 4; ++ks) { const bf16x8s kf = *(const LAS bf16x8s*)(buf + kro[hh] + 16u * ((unsigned)(4 * ks + fq) ^ krf[hh]));
                    a_ = __builtin_amdgcn_mfma_f32_16x16x32_bf16(kf, qf[ks], a_, 0, 0, 0); }
                S[it - OFF][hh] = a_; } }
    }
    float mx = -1e30f;
#pragma unroll
    for (int hh = 0; hh < 2; ++hh)
#pragma unroll
        for (int j = 0; j < 4; ++j) { const int kc = c0 + 8 * fq + 4 * hh + j; const bool ok = (kc >= cs) && (kc < cs + 16); const int bi = min(max(kc - c + 15, 0), 30);
#pragma unroll
            for (int i = 0; i < 8; ++i) { float s = S[i][hh][j]; s = ok ? s + brow0[i * 31 + bi] : -1e30f; S[i][hh][j] = s; mx = fmaxf(mx, s); } }
    mx = fmaxf(mx, __shfl_xor(mx, 16)); mx = fmaxf(mx, __shfl_xor(mx, 32));
    float l = 0.f; v4u pw[8];
#pragma unroll
    for (int i = 0; i < 8; ++i) {
#pragma unroll
        for (int hh = 0; hh < 2; ++hh)
#pragma unroll
            for (int j = 0; j < 4; ++j) { const float p = __builtin_amdgcn_exp2f((S[i][hh][j] - mx) * 1.4426950408889634f); S[i][hh][j] = p; l += p; }
        pw[i].x = pg8::cvt_pk_bf16(S[i][0][0], S[i][0][1]); pw[i].y = pg8::cvt_pk_bf16(S[i][0][2], S[i][0][3]); pw[i].z = pg8::cvt_pk_bf16(S[i][1][0], S[i][1][1]); pw[i].w = pg8::cvt_pk_bf16(S[i][1][2], S[i][1][3]); }
    l += __shfl_xor(l, 16); l += __shfl_xor(l, 32);
    const int q_ = (lane & 15) >> 2, p_ = lane & 3;
    unsigned vro[2], vrf[2];
#pragma unroll
    for (int h2 = 0; h2 < 2; ++h2) { const int key = c0 + 8 * fq + 4 * h2 + q_; vro[h2] = (unsigned)(256 * key + 8 * (p_ & 1)); vrf[h2] = (unsigned)(((key & 3) << 2) | ((key >> 2) & 3)); }
    f32x4 O[8];
#pragma unroll
    for (int dt = 0; dt < 8; ++dt) O[dt] = (f32x4){0.f, 0.f, 0.f, 0.f};
#pragma unroll
    for (int it = 9; it < 18; ++it) {
        unsigned rb_ = (unsigned)((it % NR) * 16384); asm volatile("" : "+s"(rb_));
        LAS unsigned char* buf = lds + rb_; const unsigned bufa = (unsigned)(uintptr_t)buf;
        wait_vmcnt_n(NC_NWAIT(it)); __builtin_amdgcn_s_barrier(); asm volatile("" ::: "memory");
        if (it + NR - 1 < 18) { NC_ISSUE(it + NR - 1); }
        if (it - 9 - OFF >= 0 && it - 9 - OFF < 8) {
            const bf16x8s pf = __builtin_bit_cast(bf16x8s, pw[it - 9 - OFF]);
            s16x4 lo[8], hi[8];
#pragma unroll
            for (int dt = 0; dt < 8; ++dt) { lo[dt] = tr_read16(bufa + vro[0] + 16u * ((unsigned)(2 * dt + (p_ >> 1)) ^ vrf[0])); hi[dt] = tr_read16(bufa + vro[1] + 16u * ((unsigned)(2 * dt + (p_ >> 1)) ^ vrf[1])); }
            asm volatile("s_waitcnt lgkmcnt(0)" ::: "memory"); __builtin_amdgcn_sched_barrier(0);
#pragma unroll
            for (int dt = 0; dt < 8; ++dt) { const bf16x8s vf = (bf16x8s){lo[dt][0], lo[dt][1], lo[dt][2], lo[dt][3], hi[dt][0], hi[dt][1], hi[dt][2], hi[dt][3]};
                O[dt] = __builtin_amdgcn_mfma_f32_16x16x32_bf16(vf, pf, O[dt], 0, 0, 0); } }
    }
#undef NC_ISSUE
#undef NC_NWAIT
    const float inv = 1.0f / l;
#pragma unroll
    for (int dt = 0; dt < 8; ++dt) { const f32x4 v = O[dt] * inv; v2u o; o.x = pg8::cvt_pk_bf16(v[0], v[1]); o.y = pg8::cvt_pk_bf16(v[2], v[3]); *(v2u*)(op + dt * 16) = o; }
}
__device__ __forceinline__ void na_coop_task(int t, const bf16* PROJ, const float* rpb, bf16* YA, LAS unsigned char* lds, int tid, int wave, int lane) {
    const int h = t / 192, rp = t % 192, R0 = 2 * rp, q = wave >> 2, g = wave & 3, R = R0 + q;
    int r0, rows, seq0; if (R0 < 256) { seq0 = (R0 >> 5) * 2048; r0 = R0 & 31; rows = 32; } else { seq0 = MP; r0 = R0 - 256; rows = 128; }
    const int fr = lane & 15, fq = lane >> 4;
    const int rstA = min(max(r0 - 4, 0), rows - 8), rstB = min(max(r0 + 1 - 4, 0), rows - 8), d = rstB - rstA, nU = 8 + d;
    const int r = r0 + q, rst = q ? rstB : rstA, off = q ? d : 0;
    const int c0 = min(max(16 * g - 8, 0), 32), c = 16 * g + fr, cs = min(max(c - 8, 0), 48);
    const size_t m = (size_t)R * 64 + c;
    const bf16* qp = PROJ + ((size_t)h * MTOK + m) * 128 + 8 * fq;
    const bf16* kg = PROJ + ((size_t)(16 + h) * MTOK + seq0 + rstA * 64) * 128;
    const bf16* vg = PROJ + ((size_t)(32 + h) * MTOK + seq0 + rstA * 64) * 128;
    LAS float* btab = (LAS float*)(lds + NA_BIAS_OFF);
    if (tid < 465) btab[tid] = rpb[h * 465 + tid];
    asm volatile("s_waitcnt lgkmcnt(0)" ::: "memory");
    const LAS float* brow0 = btab + (rst - r + 7) * 31;
    bf16* op = YA + m * AW + h * 128 + 4 * fq;
    if (off) na_coop_body<1>(kg, vg, nU, qp, brow0, c, cs, c0, op, lds + RING_OFF, wave, lane);
    else     na_coop_body<0>(kg, vg, nU, qp, brow0, c, cs, c0, op, lds + RING_OFF, wave, lane);
}
__device__ __forceinline__ void xa_coop_task(int t, const bf16* XQ, const bf16* KVM, bf16* XO, LAS unsigned char* lds, int tid, int wave, int lane) {
    const int h = t & 3, qb = t >> 2;
    const int s = (qb < 128) ? (qb >> 4) : 8;
    const int fr = lane & 15, fq = lane >> 4;
    const size_t m = (size_t)qb * 128 + wave * 16 + fr;
    const bf16* qp = XQ + m * XAW + h * 128 + 8 * fq;
    bf16x8s qf[4];
#pragma unroll
    for (int ks = 0; ks < 4; ++ks) qf[ks] = *(const bf16x8s*)(qp + 32 * ks);
    LAS unsigned char* kbuf = lds + RING_OFF; LAS unsigned char* vbuf = lds + RING_OFF + 65536;
    const bf16* kg = KVM + (size_t)(s * 256) * 1024 + h * 128;
    {
        v4u rg[8];
#pragma unroll
        for (int e = 0; e < 8; ++e) { const int cidx = tid + 512 * e, key = cidx >> 4, ch = cidx & 15; rg[e] = *(const v4u*)(kg + (size_t)key * 1024 + ch * 8); }
#pragma unroll
        for (int e = 0; e < 8; ++e) { const int cidx = tid + 512 * e, key = cidx >> 4, ch = cidx & 15, f = ((key & 3) << 2) | ((key >> 2) & 3); *(LAS v4u*)(kbuf + 256 * key + 16 * (ch ^ f)) = rg[e]; }
#pragma unroll
        for (int e = 0; e < 8; ++e) { const int cidx = tid + 512 * e, key = cidx >> 4, ch = cidx & 15; rg[e] = *(const v4u*)(kg + 512 + (size_t)key * 1024 + ch * 8); }
#pragma unroll
        for (int e = 0; e < 8; ++e) { const int cidx = tid + 512 * e, key = cidx >> 4, ch = cidx & 15, f = ((key & 3) << 2) | ((key >> 2) & 3); *(LAS v4u*)(vbuf + 256 * key + 16 * (ch ^ f)) = rg[e]; }
    }
    asm volatile("s_waitcnt lgkmcnt(0)" ::: "memory"); __builtin_amdgcn_s_barrier(); asm volatile("" ::: "memory");
    unsigned kro[2], krf[2];
#pragma unroll
    for (int hh = 0; hh < 2; ++hh) { const int key = 8 * (fr >> 2) + 4 * hh + (fr & 3); kro[hh] = (unsigned)(256 * key); krf[hh] = (unsigned)(((key & 3) << 2) | ((key >> 2) & 3)); }
    f32x4 S[8][2];
#pragma unroll
    for (int i = 0; i < 8; ++i) { unsigned ib = (unsigned)(i * 8192); asm volatile("" : "+s"(ib));
#pragma unroll
        for (int hh = 0; hh < 2; ++hh) { f32x4 a_ = {0.f, 0.f, 0.f, 0.f};
#pragma unroll
            for (int ks = 0; ks < 4; ++ks) { const bf16x8s kf = *(const LAS bf16x8s*)(kbuf + ib + kro[hh] + 16u * ((unsigned)(4 * ks + fq) ^ krf[hh]));
                a_ = __builtin_amdgcn_mfma_f32_16x16x32_bf16(kf, qf[ks], a_, 0, 0, 0); }
            S[i][hh] = a_; } }
    float mx = -1e30f;
#pragma unroll
    for (int i = 0; i < 8; ++i)
#pragma unroll
        for (int hh = 0; hh < 2; ++hh)
#pragma unroll
            for (int j = 0; j < 4; ++j) mx = fmaxf(mx, S[i][hh][j]);
    mx = fmaxf(mx, __shfl_xor(mx, 16)); mx = fmaxf(mx, __shfl_xor(mx, 32));
    float l = 0.f; v4u pw[8];
#pragma unroll
    for (int i = 0; i < 8; ++i) {
#pragma unroll
        for (int hh = 0; hh < 2; ++hh)
#pragma unroll
            for (int j = 0; j < 4; ++j) { const float p = __builtin_amdgcn_exp2f((S[i][hh][j] - mx) * 1.4426950408889634f); S[i][hh][j] = p; l += p; }
        pw[i].x = pg8::cvt_pk_bf16(S[i][0][0], S[i][0][1]); pw[i].y = pg8::cvt_pk_bf16(S[i][0][2], S[i][0][3]); pw[i].z = pg8::cvt_pk_bf16(S[i][1][0], S[i][1][1]); pw[i].w = pg8::cvt_pk_bf16(S[i][1][2], S[i][1][3]); }
    l += __shfl_xor(l, 16); l += __shfl_xor(l, 32);
    const int q_ = (lane & 15) >> 2, p_ = lane & 3;
    const unsigned vba = (unsigned)(uintptr_t)vbuf;
    unsigned vro[2], vrf[2];
#pragma unroll
    for (int h2 = 0; h2 < 2; ++h2) { const int key = 8 * fq + 4 * h2 + q_; vro[h2] = (unsigned)(256 * key + 8 * (p_ & 1)); vrf[h2] = (unsigned)(((key & 3) << 2) | ((key >> 2) & 3)); }
    f32x4 O[8];
#pragma unroll
    for (int dt = 0; dt < 8; ++dt) O[dt] = (f32x4){0.f, 0.f, 0.f, 0.f};
#pragma unroll
    for (int i = 0; i < 8; ++i) { unsigned ib = (unsigned)(i * 8192); asm volatile("" : "+s"(ib));
        const bf16x8s pf = __builtin_bit_cast(bf16x8s, pw[i]);
        s16x4 lo[8], hi[8];
#pragma unroll
        for (int dt = 0; dt < 8; ++dt) { lo[dt] = tr_read16(vba + ib + vro[0] + 16u * ((unsigned)(2 * dt + (p_ >> 1)) ^ vrf[0])); hi[dt] = tr_read16(vba + ib + vro[1] + 16u * ((unsigned)(2 * dt + (p_ >> 1)) ^ vrf[1])); }
        asm volatile("s_waitcnt lgkmcnt(0)" ::: "memory"); __builtin_amdgcn_sched_barrier(0);
#pragma unroll
        for (int dt = 0; dt < 8; ++dt) { const bf16x8s vf = (bf16x8s){lo[dt][0], lo[dt][1], lo[dt][2], lo[dt][3], hi[dt][0], hi[dt][1], hi[dt][2], hi[dt][3]};
            O[dt] = __builtin_amdgcn_mfma_f32_16x16x32_bf16(vf, pf, O[dt], 0, 0, 0); } }
    const float inv = 1.0f / l;
#pragma unroll
    for (int dt = 0; dt < 8; ++dt) { const f32x4 v = O[dt] * inv; v2u o; o.x = pg8::cvt_pk_bf16(v[0], v[1]); o.y = pg8::cvt_pk_bf16(v[2], v[3]);
        *(v2u*)((char*)XO + pg8::blk_off((int)m, h * 128 + 4 * fq + dt * 16, 8)) = o; }
}
__device__ __forceinline__ void xa_wave_task(int wt, const bf16* XQ, const bf16* KVM, bf16* XO, LAS unsigned char* lds, int wave, int lane) {
    const int qg = wt >> 2, h = wt & 3;
    const int fr = lane & 15, fq = lane >> 4;
    const size_t m = (size_t)qg * 16 + fr;
    const int s = (qg < 1024) ? (qg >> 7) : 8;
    const bf16* qp = XQ + m * XAW + h * 128 + 8 * fq;
    const bf16* kbase = KVM + (size_t)(s * 256 + 8 * (fr >> 2) + (fr & 3)) * 1024 + h * 128 + 8 * fq;
    const bf16* vbase = KVM + (size_t)(s * 256 + (lane >> 4)) * 1024 + 512 + h * 128 + (lane & 15) * 8;
    attn_task<false>(qp, kbase, vbase, (size_t)1024, 32, nullptr, 0, 0, 0, XO, (int)m, h * 128 + 4 * fq, lds + RING_OFF + wave * 8192, lane);
}

template <int DIR, int PC>
__device__ __forceinline__ void lru_unit(int s, int n, int tbeg, int ntile, const bf16* PROJ, const bf16* WG, const float* conv_w, const float* conv_b, const float* ba, const float* bx, const float* lam,
                                         bf16* Hout, bf16* Pout, LAS unsigned char* lds, int tid, int wave, int lane) {
    constexpr int RS = 272;
    const int seq0 = s < 8 ? s * 2048 : MP, T = s < 8 ? 2048 : 8192;
    const int fr = lane & 15, fq = lane >> 4;
    bf16x8s wf[2][4];
    { const bf16* wp = WG + ((size_t)(n * 2 + DIR) * 256 + 16 * wave + fr) * 128 + 8 * fq;
#pragma unroll
      for (int gi = 0; gi < 2; ++gi)
#pragma unroll
          for (int ks = 0; ks < 4; ++ks) wf[gi][ks] = *(const bf16x8s*)(wp + gi * 128 * 128 + 32 * ks); }
    const int chw = n * 128 + 16 * wave + fr;
    const float bra = -1.4426950408889634f * ba[DIR * 2048 + chw], bxi = -1.4426950408889634f * bx[DIR * 2048 + chw], sp8 = -8.0f * 1.4426950408889634f * log1pf(expf(-lam[DIR * 2048 + chw]));
    const int cp = lane, tg = wave, chc = n * 128 + 2 * cp;
    const float cw00 = conv_w[chc], cw01 = conv_w[chc + 1], cw10 = conv_w[2048 + chc], cw11 = conv_w[2048 + chc + 1], cw20 = conv_w[4096 + chc], cw21 = conv_w[4096 + chc + 1],
                cw30 = conv_w[6144 + chc], cw31 = conv_w[6144 + chc + 1], cb0 = conv_b[chc], cb1 = conv_b[chc + 1];
    const bf16* ub = PROJ + (size_t)seq0 * 4096 + chc;
    unsigned ur[11];
    { const int t0 = (tbeg + (DIR ? ntile - 1 : 0)) * 64 + 8 * tg - 1;
#pragma unroll
      for (int k = 0; k < 11; ++k) { const int t = t0 + k; ur[k] = (t >= 0 && t < T) ? *(const unsigned*)(ub + (size_t)t * 4096) : 0u; } }
    float carry = 0.f, pcar = 1.0f;
    for (int ti = 0; ti < ntile; ++ti) {
        const int tb = (tbeg + (DIR ? ntile - 1 - ti : ti)) * 64;
        LAS unsigned char* xt = lds + (ti & 1) * (64 * RS);
#pragma unroll
        for (int tt = 0; tt < 8; ++tt) {
            const float x0 = cw00 * bflo(ur[tt]) + cw10 * bflo(ur[tt + 1]) + cw20 * bflo(ur[tt + 2]) + cw30 * bflo(ur[tt + 3]) + cb0;
            const float x1 = cw01 * bfhi(ur[tt]) + cw11 * bfhi(ur[tt + 1]) + cw21 * bfhi(ur[tt + 2]) + cw31 * bfhi(ur[tt + 3]) + cb1;
            *(LAS unsigned*)(xt + (8 * tg + tt) * RS + 4 * cp) = pg8::cvt_pk_bf16(x0, x1); }
        if (ti + 1 < ntile) { const int t0 = (tbeg + (DIR ? ntile - 2 - ti : ti + 1)) * 64 + 8 * tg - 1;
#pragma unroll
            for (int k = 0; k < 11; ++k) { const int t = t0 + k; ur[k] = (t >= 0 && t < T) ? *(const unsigned*)(ub + (size_t)t * 4096) : 0u; } }
        asm volatile("s_waitcnt lgkmcnt(0)" ::: "memory"); __builtin_amdgcn_s_barrier(); asm volatile("" ::: "memory");
        f32x4 accr[4], acci[4];
#pragma unroll
        for (int m = 0; m < 4; ++m) { accr[m] = (f32x4){0.f, 0.f, 0.f, 0.f}; acci[m] = (f32x4){0.f, 0.f, 0.f, 0.f};
#pragma unroll
            for (int ks = 0; ks < 4; ++ks) { const bf16x8s af = *(const LAS bf16x8s*)(xt + (16 * m + fr) * RS + (32 * ks + 8 * fq) * 2);
                accr[m] = __builtin_amdgcn_mfma_f32_16x16x32_bf16(af, wf[0][ks], accr[m], 0, 0, 0);
                acci[m] = __builtin_amdgcn_mfma_f32_16x16x32_bf16(af, wf[1][ks], acci[m], 0, 0, 0); } }
        float av[4][4], bv[4][4];
#pragma unroll
        for (int m = 0; m < 4; ++m)
#pragma unroll
            for (int j = 0; j < 4; ++j) { const float xc = bf2f(*(const LAS bf16*)(xt + (16 * m + 4 * fq + j) * RS + (16 * wave + fr) * 2));
                const float rg = __builtin_amdgcn_rcpf(1.0f + __builtin_amdgcn_exp2f(fmaf(accr[m][j], -1.4426950408889634f, bra)));
                const float ig = __builtin_amdgcn_rcpf(1.0f + __builtin_amdgcn_exp2f(fmaf(acci[m][j], -1.4426950408889634f, bxi)));
                const float a = __builtin_amdgcn_exp2f(rg * sp8); av[m][j] = a; bv[m][j] = __builtin_amdgcn_sqrtf(fmaxf(1.0f - a * a, 0.f)) * ig * xc; }
        float Ai[4], Bi[4], Ae[4], Be[4], At[4], Bt[4];
#pragma unroll
        for (int m = 0; m < 4; ++m) {
            float A, B;
            if (DIR == 0) { A = av[m][0]; B = bv[m][0];
#pragma unroll
                for (int j = 1; j < 4; ++j) { B = B * av[m][j] + bv[m][j]; A *= av[m][j]; } }
            else { A = av[m][3]; B = bv[m][3];
#pragma unroll
                for (int j = 2; j >= 0; --j) { B = B * av[m][j] + bv[m][j]; A *= av[m][j]; } }
            Ai[m] = A; Bi[m] = B; }
        { float A1[4], B1[4];
#pragma unroll
          for (int m = 0; m < 4; ++m) { A1[m] = DIR ? __shfl_down(Ai[m], 16) : __shfl_up(Ai[m], 16); B1[m] = DIR ? __shfl_down(Bi[m], 16) : __shfl_up(Bi[m], 16); }
          const bool has = DIR ? (fq < 3) : (fq > 0);
#pragma unroll
          for (int m = 0; m < 4; ++m) if (has) { Bi[m] = Ai[m] * B1[m] + Bi[m]; Ai[m] = A1[m] * Ai[m]; } }
        { float A2[4], B2[4];
#pragma unroll
          for (int m = 0; m < 4; ++m) { A2[m] = DIR ? __shfl_down(Ai[m], 32) : __shfl_up(Ai[m], 32); B2[m] = DIR ? __shfl_down(Bi[m], 32) : __shfl_up(Bi[m], 32); }
          const bool has = DIR ? (fq < 2) : (fq > 1);
#pragma unroll
          for (int m = 0; m < 4; ++m) if (has) { Bi[m] = Ai[m] * B2[m] + Bi[m]; Ai[m] = A2[m] * Ai[m]; } }
#pragma unroll
        for (int m = 0; m < 4; ++m) {
            Ae[m] = DIR ? __shfl_down(Ai[m], 16) : __shfl_up(Ai[m], 16); Be[m] = DIR ? __shfl_down(Bi[m], 16) : __shfl_up(Bi[m], 16);
            At[m] = __shfl(Ai[m], (DIR ? 0 : 48) + fr); Bt[m] = __shfl(Bi[m], (DIR ? 0 : 48) + fr); }
        bf16* hp = Hout + (size_t)(seq0 + tb) * LW + chw; bf16* pp = Pout + (size_t)tb * LW + chw;
#pragma unroll
        for (int mm = 0; mm < 4; ++mm) { const int m = DIR ? 3 - mm : mm;
            const bool first = DIR ? (fq == 3) : (fq == 0);
            float h = first ? carry : Ae[m] * carry + Be[m]; float pv = first ? pcar : Ae[m] * pcar;
            if (DIR == 0) {
#pragma unroll
                for (int j = 0; j < 4; ++j) { h = av[m][j] * h + bv[m][j]; hp[(size_t)(16 * m + 4 * fq + j) * LW] = (bf16)pg8::cvt_pk_bf16(h, h);
                    if (PC) { pv *= av[m][j]; pp[(size_t)(16 * m + 4 * fq + j) * LW] = (bf16)pg8::cvt_pk_bf16(pv, pv); } } }
            else {
#pragma unroll
                for (int j = 3; j >= 0; --j) { h = av[m][j] * h + bv[m][j]; hp[(size_t)(16 * m + 4 * fq + j) * LW] = (bf16)pg8::cvt_pk_bf16(h, h);
                    if (PC) { pv *= av[m][j]; pp[(size_t)(16 * m + 4 * fq + j) * LW] = (bf16)pg8::cvt_pk_bf16(pv, pv); } } }
            carry = At[m] * carry + Bt[m]; if (PC) pcar *= At[m]; }
    }
    __syncthreads();
}
__device__ __forceinline__ void lru_dispatch(int u, const bf16* PROJ, const bf16* WG, const float* const* in, bf16* HF, bf16* HBk, bf16* PCA, LAS unsigned char* lds, int tid, int wave, int lane) {
    if (u < 64) { const int n = (u >> 2) & 15, e = (u >> 1) & 1, half = u & 1;
        if (e == 0) { if (half == 0) lru_unit<0, 0>(8, n, 0, 64, PROJ, WG, in[11], in[12], in[14], in[16], in[17], HF, PCA, lds, tid, wave, lane);
                      else           lru_unit<0, 1>(8, n, 64, 64, PROJ, WG, in[11], in[12], in[14], in[16], in[17], HF, PCA, lds, tid, wave, lane); }
        else        { if (half == 0) lru_unit<1, 0>(8, n, 64, 64, PROJ, WG, in[11], in[12], in[14], in[16], in[17], HBk, PCA, lds, tid, wave, lane);
                      else           lru_unit<1, 1>(8, n, 0, 64, PROJ, WG, in[11], in[12], in[14], in[16], in[17], HBk, PCA, lds, tid, wave, lane); } }
    else { const int v = u - 64, s = v >> 5, n = (v >> 1) & 15, e = v & 1;
        if (e == 0) lru_unit<0, 0>(s, n, 0, 32, PROJ, WG, in[11], in[12], in[14], in[16], in[17], HF, PCA, lds, tid, wave, lane);
        else        lru_unit<1, 0>(s, n, 0, 32, PROJ, WG, in[11], in[12], in[14], in[16], in[17], HBk, PCA, lds, tid, wave, lane); }
}

#define XB_TMO      128
#define XB_XCNT(j)  (256  + 64 * (j))
#define XB_XSUB(j)  (1280 + 64 * (j))
#define XB_XGEN(j)  (2304 + 64 * (j))
#define XB_TOP      3328
#define XB_TOPGEN   3392
#define XCD_BAR_WORDS 3456
#define XB_SPIN_CAP (1u << 18)

__device__ __forceinline__ unsigned xb_ld(unsigned* p)              { return __hip_atomic_load(p, __ATOMIC_RELAXED, __HIP_MEMORY_SCOPE_AGENT); }
__device__ __forceinline__ unsigned xb_add(unsigned* p, unsigned v) { return __hip_atomic_fetch_add(p, v, __ATOMIC_RELAXED, __HIP_MEMORY_SCOPE_AGENT); }
__device__ __forceinline__ unsigned xb_xcc_id() { return (unsigned)__builtin_amdgcn_s_getreg((3 << 11) | 20) & 0xFu; }
#define XB_SPIN(cond, bar) do { unsigned _sp = 0; while (cond) { __builtin_amdgcn_s_sleep(1); \
    if ((++_sp & 255u) == 0u) { if (xb_ld(&(bar)[XB_TMO])) break; if (_sp > XB_SPIN_CAP) { atomicAdd(&(bar)[XB_TMO], 1u); break; } } } } while (0)

struct XcdBarrier {
    unsigned* bar; unsigned x;
    volatile LAS unsigned* st;
};

__device__ __forceinline__ XcdBarrier xcd_barrier_post(unsigned* bar, volatile LAS unsigned* st) {
    XcdBarrier b; b.bar = bar; b.x = xb_xcc_id(); b.st = st;
    if (threadIdx.x == 0) (void)xb_add(&bar[XB_XCNT(b.x)], 1u);
    return b;
}
__device__ __forceinline__ void xcd_barrier_complete(unsigned* bar, unsigned x, unsigned& nloc, unsigned& nx) {
    const unsigned G = gridDim.x * gridDim.y * gridDim.z;
    unsigned sum, cnt, mine, sp = 0u;
    for (;;) {
        sum = 0u; cnt = 0u; mine = 0u;
#pragma unroll
        for (unsigned j = 0; j < 16; ++j) { const unsigned c = xb_ld(&bar[XB_XCNT(j)]); sum += c; cnt += (c > 0u) ? 1u : 0u; mine = (j == x) ? c : mine; }
        if (sum == G) break;
        __builtin_amdgcn_s_sleep(1);
        if ((++sp & 255u) == 0u) { if (xb_ld(&bar[XB_TMO])) break; if (sp > XB_SPIN_CAP) { atomicAdd(&bar[XB_TMO], 1u); break; } }
    }
    nloc = mine > 0u ? mine : 1u; nx = cnt > 0u ? cnt : 1u;
}

__device__ __forceinline__ void xcd_barrier(const XcdBarrier& b, bool wave0 = true) {
    asm volatile("s_waitcnt vmcnt(0)" ::: "memory");
    __syncthreads();
    unsigned bl_; asm volatile("v_mbcnt_lo_u32_b32 %0, -1, 0\n\tv_mbcnt_hi_u32_b32 %0, -1, %0" : "=&v"(bl_));
    if (wave0 && bl_ == 0u) {
        unsigned* bar = b.bar;
        __builtin_amdgcn_s_waitcnt(0);
        unsigned nloc = b.st[0], nx = b.st[1];
        if (nloc == 0u) { xcd_barrier_complete(bar, b.x, nloc, nx); b.st[0] = nloc; b.st[1] = nx; }
        const unsigned old = xb_add(&bar[XB_XSUB(b.x)], 1u);
        const unsigned gen = old / nloc;
        if (old + 1u == (gen + 1u) * nloc) {
            __builtin_amdgcn_fence(__ATOMIC_RELEASE, "agent");
            asm volatile("s_waitcnt vmcnt(0)" ::: "memory");
            const unsigned og = xb_add(&bar[XB_TOP], 1u);
            const unsigned tg = og / nx;
            if (og + 1u == (tg + 1u) * nx) xb_add(&bar[XB_TOPGEN], 1u);
            else XB_SPIN(xb_ld(&bar[XB_TOPGEN]) == tg, bar);
            __builtin_amdgcn_fence(__ATOMIC_ACQUIRE, "agent");
            xb_add(&bar[XB_XGEN(b.x)], 1u);
            asm volatile("s_waitcnt vmcnt(0)" ::: "memory");
        } else {
            XB_SPIN(xb_ld(&bar[XB_XGEN(b.x)]) == gen, bar);
            __builtin_amdgcn_fence(__ATOMIC_ACQUIRE, "agent");
            asm volatile("s_waitcnt vmcnt(0)" ::: "memory");
        }
    }
    __syncthreads();
}


constexpr int CI_UP = 2 * (D / 64) * (DFF / 32), CI_DN = (DFF / 64) * (D / 32), CI_IN = (D / 64) * (NIN / 32), CI_OUT = (D / 64) * (D / 32), CI_Q = (D / 64) * (XAW / 32), CI_O = (XAW / 64) * (D / 32), CI_G = 512;
constexpr int CI_TOTAL = CI_DN + CI_IN + CI_OUT + 3 * CI_Q + CI_O + CI_G + CI_UP + CI_DN;
constexpr int CI_P1 = CI_TOTAL - CI_DN, CI_P10 = CI_TOTAL;
constexpr int CONV_CHUNK = 128;
__device__ __forceinline__ void deferred_item(int g, const float* const* in, unsigned char* ws, LAS float* scr, int lane) {
    const float* W; int K, N, row_off = 0, up = 0; bf16* WT; const float* gk = nullptr;
    if (g < CI_DN) { W = in[7]; K = DFF; N = D; WT = (bf16*)(ws + WS_WDN1); }
    else if ((g -= CI_DN) < CI_OUT) { W = in[20]; K = D; N = D; WT = (bf16*)(ws + WS_WOUT); }
    else if ((g -= CI_OUT) < CI_IN) { W = in[9]; K = D; N = NIN; WT = (bf16*)(ws + WS_WIN); gk = in[8]; }
    else if ((g -= CI_IN) < CI_Q) { W = in[23]; K = D; N = XAW; WT = (bf16*)(ws + WS_WQ); gk = in[21]; }
    else if ((g -= CI_Q) < CI_Q) { W = in[24]; K = D; N = XAW; WT = (bf16*)(ws + WS_WKV); }
    else if ((g -= CI_Q) < CI_Q) { W = in[25]; K = D; N = XAW; WT = (bf16*)(ws + WS_WKV); row_off = XAW; }
    else if ((g -= CI_Q) < CI_O) { W = in[26]; K = XAW; N = D; WT = (bf16*)(ws + WS_WO); }
    else if ((g -= CI_O) < CI_G) { const int mat = g >> 3, sub = g & 7, gi = mat & 1, e = (mat >> 1) & 1, nn = mat >> 2;
        const float* Wsrc = (gi ? in[15] : in[13]) + ((size_t)(e * 16 + nn) << 14); const int k0 = (sub >> 2) * 64, n0 = (sub & 3) * 32;
        transpose_item(Wsrc, 128, 128, (bf16*)(ws + WS_WG) + ((size_t)(nn * 2 + e) * 256 + gi * 128 + n0) * 128, k0, n0, scr, lane); return; }
    else if ((g -= CI_G) < CI_UP) { const int which = g >= CI_UP / 2; if (which) g -= CI_UP / 2;
        const int nblk = DFF / 32, kb = g / nblk, nb = g % nblk, n0 = 32 * nb, k0 = 64 * kb, drow = 256 * (n0 >> 7) + (n0 & 127) + (which ? 128 : 0);
        transpose_item_f8(which ? in[29] : in[28], D, DFF, (char*)(ws + WS_WUP2) + ((size_t)((drow >> 8) * (D / 128) + (k0 >> 7)) << 15), k0, n0, drow & 255, true, 128.0f, in[27], scr, lane); return; }
    else { g -= CI_UP; W = in[30]; K = DFF; N = D; WT = (bf16*)(ws + WS_WDN2);
        const int nblk_ = D / 32, kb_ = g / nblk_, nb_ = g % nblk_, n0_ = 32 * nb_, k0_ = 64 * kb_;
        if (k0_ >= DN8_PN * 128) {
            transpose_item_f8(W, DFF, D, (char*)(ws + WS_WUP1) + ((size_t)((n0_ >> 8) * DN8_KT + ((k0_ - DN8_PN * 128) >> 7)) << 15), k0_, n0_, n0_ & 255, true, 128.0f, nullptr, scr, lane); return; } }
    const int nblk = N / 32, nkt = K / 64, kb = g / nblk, nb = g % nblk, n0 = 32 * nb;
    const int drow = up ? 256 * (n0 >> 7) + (n0 & 127) + (up == 2 ? 128 : 0) : row_off + n0;
    transpose_item_blk(W, K, N, (char*)WT + ((size_t)((drow >> 8) * nkt + kb) << 15), 64 * kb, n0, drow & 255, true, gk, scr, lane);
}
__device__ __forceinline__ void phase_prologue(const float* const* in, unsigned char* ws, LAS unsigned char* lds, pg8::ssq_t* ss0, int lane, int wave, int gw, int NGW) {
    bf16* W_G = (bf16*)(ws + WS_WG); bf16* W_Q = (bf16*)(ws + WS_WQ); bf16* W_KV = (bf16*)(ws + WS_WKV); bf16* W_O = (bf16*)(ws + WS_WO); bf16* MEMN = (bf16*)(ws + WS_MEMN);
    bf16* W_OUT = (bf16*)(ws + WS_WOUT); bf16* W_IN = (bf16*)(ws + WS_WIN); bf16* W_UP1 = (bf16*)(ws + WS_WUP1); bf16* W_DN1 = (bf16*)(ws + WS_WDN1);
    bf16* W_UP2 = (bf16*)(ws + WS_WUP2); bf16* W_DN2 = (bf16*)(ws + WS_WDN2); bf16* XN = (bf16*)(ws + WS_XN);
            for (int m = gw; m < MTOK; m += NGW) {
            const float* xr = (m < MP) ? in[0] + (size_t)m * D : in[1] + (size_t)(m - MP) * D;
            float s = 0.f;
#pragma unroll 4
            for (int j = 0; j < 16; ++j) { const f32x4 v = *(const f32x4*)(xr + (j * 64 + lane) * 4);
                s += (v[0] * v[0] + v[1] * v[1]) + (v[2] * v[2] + v[3] * v[3]);
                v2u o; o.x = pk2(v[0], v[1]); o.y = pk2(v[2], v[3]); *(v2u*)((char*)XN + pg8::blk_off(m, (j * 64 + lane) * 4, 64)) = o; }
            s = wave_sum(s); if (lane == 0) ss0[m] = pg8::ss_fix(s);
        }
        const float* gm = in[22];
        for (int m = gw; m < NMEM; m += NGW) {
            const float* xr = (m < 2048) ? in[2] + (size_t)m * D : in[3] + (size_t)(m - 2048) * D;
            f32x4 v[16]; float s = 0.f;
#pragma unroll
            for (int j = 0; j < 16; ++j) { v[j] = *(const f32x4*)(xr + (j * 64 + lane) * 4); s += (v[j][0] * v[j][0] + v[j][1] * v[j][1]) + (v[j][2] * v[j][2] + v[j][3] * v[j][3]); }
            s = wave_sum(s); const float rs = rsqrtf(s * (1.0f / D) + EPS);
#pragma unroll
            for (int j = 0; j < 16; ++j) { const f32x4 g = *(const f32x4*)(gm + (j * 64 + lane) * 4);
                v2u o; o.x = pk2(v[j][0] * rs * g[0], v[j][1] * rs * g[1]); o.y = pk2(v[j][2] * rs * g[2], v[j][3] * rs * g[3]); *(v2u*)((char*)MEMN + pg8::blk_off(m, (j * 64 + lane) * 4, 64)) = o; }
        }
        LAS float* scr = (LAS float*)(lds + RING_OFF + wave * 16384);
        transpose_up(in[5], in[6], W_UP1, in[4], scr, lane, gw, NGW);
        for (int g = CI_P10 + gw; g < CI_TOTAL; g += NGW) deferred_item(g, in, ws, scr, lane);
}
__device__ __forceinline__ void phase_mixer(const float* const* in, const bf16* PROJ, const bf16* UG, const bf16* W_G, bf16* HF, bf16* HBK, bf16* PCA, bf16* YA, unsigned* ctr, volatile LAS unsigned* MISC, LAS unsigned char* lds, int G, int bx, int tid, int wave, int lane, int mode = 3) {
        if (mode & 1) {
        for (int u = bx; u < 320; u += (u < 256 ? (bx >= 64 && bx < 128 ? 256 - 64 : 1024) : 1024)) lru_dispatch(u, UG, W_G, in, HF, HBK, PCA, lds, tid, wave, lane);
        }
        if (mode & 6)
        for (;;) {
            __syncthreads();
            if (tid == 0) MISC[0] = atomicAdd(ctr, 1u);
            __syncthreads();
            const int it = __builtin_amdgcn_readfirstlane((int)MISC[0]);
            if (it >= 3072) break;
            na_coop_task(it, PROJ, in[10], YA, lds, tid, wave, lane);
        }
}
__device__ __forceinline__ void phase_finalize(const float* const* in, const bf16* PROJ, const bf16* HF, const bf16* HBK, const bf16* PCA, const bf16* YA, bf16* Y, int lane, int gw, int NGW) {
        const float* ga = in[18]; const float* gl = in[19];
        for (int m = gw; m < MTOK; m += NGW) {
            float y[32]; float s = 0.f;
#pragma unroll
            for (int j = 0; j < 4; ++j) { const int c0 = (j * 64 + lane) * 8; float a[8], b[8], gt[8];
                unpack8(*(const v4u*)(HF + (size_t)m * LW + c0), a); unpack8(*(const v4u*)(HBK + (size_t)m * LW + c0), b); unpack8(*(const v4u*)(PROJ + (size_t)m * 4096 + 2048 + c0), gt);
                if (m >= MP) { const int t = m - MP; float pc[8], bd[8]; unpack8(*(const v4u*)(PCA + (size_t)t * LW + c0), pc);
                    if (t >= 4096) { unpack8(*(const v4u*)(HF + (size_t)(MP + 4095) * LW + c0), bd);
#pragma unroll
                        for (int k = 0; k < 8; ++k) a[k] += pc[k] * bd[k]; }
                    else { unpack8(*(const v4u*)(HBK + (size_t)(MP + 4096) * LW + c0), bd);
#pragma unroll
                        for (int k = 0; k < 8; ++k) b[k] += pc[k] * bd[k]; } }
#pragma unroll
                for (int k = 0; k < 8; ++k) { const float v = (a[k] + b[k]) * gelu_tanh(gt[k]); y[8 * j + k] = v; s += v * v; } }
            s = wave_sum(s); float rs = rsqrtf(s * (1.0f / LW) + EPS);
#pragma unroll
            for (int j = 0; j < 4; ++j) { const int c0 = (j * 64 + lane) * 8; const f32x4 g0 = *(const f32x4*)(gl + c0), g1 = *(const f32x4*)(gl + c0 + 4);
                v4u o; o.x = pk2(y[8 * j] * rs * g0[0], y[8 * j + 1] * rs * g0[1]); o.y = pk2(y[8 * j + 2] * rs * g0[2], y[8 * j + 3] * rs * g0[3]);
                o.z = pk2(y[8 * j + 4] * rs * g1[0], y[8 * j + 5] * rs * g1[1]); o.w = pk2(y[8 * j + 6] * rs * g1[2], y[8 * j + 7] * rs * g1[3]);
                *(v4u*)((char*)Y + pg8::blk_off(m, AW + c0, 64)) = o; }
            s = 0.f;
#pragma unroll
            for (int j = 0; j < 4; ++j) { const int c0 = (j * 64 + lane) * 8; float a[8]; unpack8(*(const v4u*)(YA + (size_t)m * AW + c0), a);
#pragma unroll
                for (int k = 0; k < 8; ++k) { y[8 * j + k] = a[k]; s += a[k] * a[k]; } }
            s = wave_sum(s); rs = rsqrtf(s * (1.0f / AW) + EPS);
#pragma unroll
            for (int j = 0; j < 4; ++j) { const int c0 = (j * 64 + lane) * 8; const f32x4 g0 = *(const f32x4*)(ga + c0), g1 = *(const f32x4*)(ga + c0 + 4);
                v4u o; o.x = pk2(y[8 * j] * rs * g0[0], y[8 * j + 1] * rs * g0[1]); o.y = pk2(y[8 * j + 2] * rs * g0[2], y[8 * j + 3] * rs * g0[3]);
                o.z = pk2(y[8 * j + 4] * rs * g1[0], y[8 * j + 5] * rs * g1[1]); o.w = pk2(y[8 * j + 6] * rs * g1[2], y[8 * j + 7] * rs * g1[3]);
                *(v4u*)((char*)Y + pg8::blk_off(m, c0, 64)) = o; }
        }
}
__device__ __forceinline__ void phase_xattn(const bf16* XQ, const bf16* KVM, bf16* XO, LAS unsigned char* lds, int wave, int lane, int gw, int NGW) {
        for (int t = blockIdx.x; t < (MTOK / 128) * 4; t += gridDim.x) { __syncthreads(); xa_coop_task(t, XQ, KVM, XO, lds, wave * 64 + lane, wave, lane); }
}

struct Args { const float* in[32]; float* out; unsigned char* ws; int ph_lo, ph_hi; };
static_assert(sizeof(Args) == 32 * 8 + 8 + 8 + 8, "Args has no padding");

__global__ void __launch_bounds__(NWAVES * 64, 2) mk_fwd(Args args) {
    extern __shared__ __attribute__((aligned(16))) unsigned char lds_raw[];
    LAS unsigned char* lds = (LAS unsigned char*)lds_raw;
    volatile LAS unsigned* MISC = (volatile LAS unsigned*)(lds + MISC_OFF);
    const int tid = threadIdx.x, lane = tid & 63, wave = __builtin_amdgcn_readfirstlane(tid >> 6);
    const int G = gridDim.x, bx = blockIdx.x;
    const int gw = bx * NWAVES + wave, NGW = G * NWAVES;
    unsigned char* ws = args.ws;
    unsigned* ctl = (unsigned*)(ws + WS_CTL);
    pg8::ssq_t* ss0 = (pg8::ssq_t*)(ctl + CW_SS); pg8::ssq_t* ss1 = ss0 + MTOK; pg8::ssq_t* ss2 = ss1 + MTOK; pg8::ssq_t* ss3 = ss2 + MTOK; pg8::ssq_t* ss4 = ss3 + MTOK;
    bf16* W_G = (bf16*)(ws + WS_WG); bf16* W_Q = (bf16*)(ws + WS_WQ); bf16* W_KV = (bf16*)(ws + WS_WKV); bf16* W_O = (bf16*)(ws + WS_WO); bf16* MEMN = (bf16*)(ws + WS_MEMN);
    bf16* W_OUT = (bf16*)(ws + WS_WOUT); bf16* W_IN = (bf16*)(ws + WS_WIN); bf16* W_UP1 = (bf16*)(ws + WS_WUP1); bf16* W_DN1 = (bf16*)(ws + WS_WDN1);
    bf16* W_UP2 = (bf16*)(ws + WS_WUP2); bf16* W_DN2 = (bf16*)(ws + WS_WDN2);
    bf16* XN = (bf16*)(ws + WS_XN); bf16* HBK = (bf16*)(ws + WS_HBK);
    bf16* PCA = (bf16*)args.out + (size_t)2 * MTOK * AW;
    bf16* YA = (bf16*)args.out; bf16* HF = (bf16*)args.out + (size_t)MTOK * AW;
    bf16* Y = (bf16*)(ws + WS_Y); bf16* HB = (bf16*)(ws + WS_HB); bf16* PROJ = (bf16*)(ws + WS_PROJ); bf16* UG = PROJ + (size_t)48 * MTOK * 128;
    bf16* XQ = (bf16*)(ws + WS_XQ); bf16* XO = (bf16*)(ws + WS_XO); bf16* KVM = (bf16*)(ws + WS_KVM);
    float* out = args.out;

    for (int i = tid; i < (LDS_BYTES - LDSCTL_OFF) / 4; i += NWAVES * 64) ((LAS unsigned*)(lds + LDSCTL_OFF))[i] = 0u;
    __syncthreads();
    if (tid == 0) { const unsigned long long xp_ = (unsigned long long)XN; MISC[20] = (unsigned)xp_; MISC[21] = (unsigned)(xp_ >> 32); }
    __syncthreads();
    const int lo = args.ph_lo, hi = args.ph_hi;
    XcdBarrier bar; bar.bar = ctl + CW_BAR; bar.x = 0; bar.st = nullptr;
    if (hi - lo > 1) bar = xcd_barrier_post(ctl + CW_BAR, MISC + 8);
#define IN(k) (lo <= (k) && (k) < hi)
#define LANE_NOW() ({ int l_; asm volatile("v_mbcnt_lo_u32_b32 %0, -1, 0\n\tv_mbcnt_hi_u32_b32 %0, -1, %0" : "=&v"(l_)); l_; })
#define SEAM(k) do { if (IN(k) && IN((k) + 1)) { xcd_barrier(bar, wave == 0); if (PROBE_MASK & 32768) xcd_barrier(bar, wave == 0); } } while (0)

    if (IN(0)) { phase_prologue(args.in, ws, lds, ss0, lane, wave, gw, NGW);
        if (PROBE_MASK & 1) { xcd_barrier(bar); phase_prologue(args.in, ws, lds, ss0, lane, wave, gw, NGW); } }
    SEAM(0);
    if (IN(1)) {
        pg8::Gemm g{XN, W_UP1, MTOK, NUP, D}; pg8::StaticOrder S; S.init(MTOK, NUP, G, bx);
        pg8::EpiSwiGLU E{HB, ss0, 1 << 30, 1.0f, nullptr};
        if (PROBE_MASK & 4096) { pg8::EpiTwice<pg8::EpiSwiGLU> ET{E}; pg8::gemm_phase<pg8::EpiTwice<pg8::EpiSwiGLU>, pg8::StaticOrder, PG8_ALIGN, PG8_SP2>(lds + RING_OFF, g, S, ET, wave); } else
        pg8::gemm_phase<pg8::EpiSwiGLU, pg8::StaticOrder, PG8_ALIGN, PG8_SP2>(lds + RING_OFF, g, S, E, wave);
        if (PROBE_MASK & 2) { xcd_barrier(bar); pg8::gemm_phase<pg8::EpiSwiGLU, pg8::StaticOrder, PG8_ALIGN, PG8_SP2>(lds + RING_OFF, g, S, E, wave); }
        const int lane = LANE_NOW(), tid = wave * 64 + lane;
        for (;;) {
            __syncthreads();
            if (tid == 0) MISC[0] = atomicAdd(ctl + CW_CONVCTR, 1u);
            __syncthreads();
            const int chunk = (int)MISC[0];
            if (chunk * CONV_CHUNK >= CI_P1) break;
            LAS float* scr = (LAS float*)(lds + RING_OFF + wave * 16384);
            for (int j = 0; j < CONV_CHUNK / NWAVES; ++j) { const int gi = chunk * CONV_CHUNK + wave * (CONV_CHUNK / NWAVES) + j; if (gi < CI_P1) deferred_item(gi, args.in, ws, scr, lane); }
        }
        if (PROBE_MASK & 65536) { xcd_barrier(bar);
            for (;;) {
                __syncthreads();
                if (tid == 0) MISC[0] = atomicAdd(ctl + CW_CONVCTR + 128, 1u);
                __syncthreads();
                const int chunk = (int)MISC[0];
                if (chunk * CONV_CHUNK >= CI_P1) break;
                LAS float* scr = (LAS float*)(lds + RING_OFF + wave * 16384);
                for (int j = 0; j < CONV_CHUNK / NWAVES; ++j) { const int gi = chunk * CONV_CHUNK + wave * (CONV_CHUNK / NWAVES) + j; if (gi < CI_P1) deferred_item(gi, args.in, ws, scr, lane); }
            } }
    }
    SEAM(1);
    if (IN(2)) {
        pg8::Gemm g{HB, W_DN1, MTOK, D, DFF}; pg8::StaticOrder S; S.init(MTOK, D, G, bx, WGM_DOWN, 1);
        pg8::EpiResid E{XN, ss1, nullptr, 0.5f};
        pg8::gemm_phase<pg8::EpiResid, pg8::StaticOrder, PG8_ALIGN, PG8_SP2>(lds + RING_OFF, g, S, E, wave);
        if (PROBE_MASK & 8192) { xcd_barrier(bar); pg8::Gemm gl{XN, W_UP1, MTOK, NUP, D}; pg8::StaticOrder Sl; Sl.init(MTOK, NUP, G, bx); pg8::EpiNull EN;
            pg8::gemm_phase<pg8::EpiNull, pg8::StaticOrder, PG8_ALIGN, PG8_SP2, PROBE_VAR>(lds + RING_OFF, gl, Sl, EN, wave); }
        if (PROBE_MASK & 4) { xcd_barrier(bar); pg8::EpiResid E2{XN, ss4 + MTOK, nullptr, 0.0f}; pg8::gemm_phase<pg8::EpiResid, pg8::StaticOrder, PG8_ALIGN, PG8_SP2>(lds + RING_OFF, g, S, E2, wave); }
    }
    SEAM(2);
    if (IN(3)) {
        pg8::Gemm g{XN, W_IN, MTOK, NIN, D}; pg8::StaticOrder S; S.init(MTOK, NIN, G, bx);
        pg8::EpiProj E{PROJ, UG, ss1, 0.08838834764831845f};
        pg8::gemm_phase<pg8::EpiProj, pg8::StaticOrder, PG8_ALIGN, PG8_SP2>(lds + RING_OFF, g, S, E, wave);
        if (PROBE_MASK & 8) { xcd_barrier(bar); pg8::gemm_phase<pg8::EpiProj, pg8::StaticOrder, PG8_ALIGN, PG8_SP2>(lds + RING_OFF, g, S, E, wave); }
    }
    SEAM(3);
    if (IN(4)) { const int lane = LANE_NOW(), tid = wave * 64 + lane; phase_mixer(args.in, PROJ, UG, W_G, HF, HBK, PCA, YA, ctl + CW_NACTR, MISC, lds, G, bx, tid, wave, lane);
        if (PROBE_MASK & 16) { xcd_barrier(bar); phase_mixer(args.in, PROJ, UG, W_G, HF, HBK, PCA, YA, ctl + CW_NACTR + 64, MISC, lds, G, bx, tid, wave, lane); }
        if (PROBE_MASK & 1024) { xcd_barrier(bar); phase_mixer(args.in, PROJ, UG, W_G, HF, HBK, PCA, YA, ctl + CW_NACTR + 64, MISC, lds, G, bx, tid, wave, lane, 1); }
        if (PROBE_MASK & 16384) { xcd_barrier(bar); phase_mixer(args.in, PROJ, UG, W_G, HF, HBK, PCA, YA, ctl + CW_NACTR + 64, MISC, lds, G, bx, tid, wave, lane, 4); }
        if (PROBE_MASK & 2048) { xcd_barrier(bar); phase_mixer(args.in, PROJ, UG, W_G, HF, HBK, PCA, YA, ctl + CW_NACTR + 64, MISC, lds, G, bx, tid, wave, lane, 2); } }
    SEAM(4);
    if (IN(5)) { const int lane = LANE_NOW(); phase_finalize(args.in, UG, HF, HBK, PCA, YA, Y, lane, gw, NGW);
        if (PROBE_MASK & 32) { xcd_barrier(bar); phase_finalize(args.in, UG, HF, HBK, PCA, YA, Y, lane, gw, NGW); } }
    SEAM(5);
    if (IN(6)) {
        pg8::Gemm g{Y, W_OUT, MTOK, D, D}; pg8::StaticOrder S; S.init(MTOK, D, G, bx);
        pg8::EpiResid E{XN, ss2, nullptr, 1.0f};
        pg8::gemm_phase<pg8::EpiResid, pg8::StaticOrder, PG8_ALIGN, PG8_SP2>(lds + RING_OFF, g, S, E, wave);
        if (PROBE_MASK & 64) { xcd_barrier(bar); pg8::EpiResid E2{XN, ss4 + MTOK, nullptr, 0.0f}; pg8::gemm_phase<pg8::EpiResid, pg8::StaticOrder, PG8_ALIGN, PG8_SP2>(lds + RING_OFF, g, S, E2, wave); }
    }
    SEAM(6);
    if (IN(7)) {
        if (bx < 192 || G < 228) {
            pg8::Gemm g{XN, W_Q, MTOK, XAW, D}; pg8::StaticOrder S; S.init(MTOK, XAW, G < 228 ? G : 192, bx);
            pg8::EpiScaleBf16 E{XQ, XAW, ss2, 0.08838834764831845f, XAW};
            pg8::gemm_phase<pg8::EpiScaleBf16, pg8::StaticOrder, PG8_ALIGN, PG8_SP2>(lds + RING_OFF, g, S, E, wave);
        }
        if ((bx >= 192 && bx < 228) || G < 228) {
            pg8::Gemm g{MEMN, W_KV, NMEM, 2 * XAW, D}; pg8::StaticOrder S; S.init(NMEM, 2 * XAW, G < 228 ? G : 36, G < 228 ? bx : bx - 192);
            pg8::EpiScaleBf16 E{KVM, 2 * XAW, nullptr, 1.0f, 0};
            pg8::gemm_phase<pg8::EpiScaleBf16, pg8::StaticOrder, PG8_ALIGN, PG8_SP2>(lds + RING_OFF, g, S, E, wave);
        }
    }
    SEAM(7);
    if (IN(8)) { const int lane = LANE_NOW(); phase_xattn(XQ, KVM, XO, lds, wave, lane, gw, NGW);
        if (PROBE_MASK & 256) { xcd_barrier(bar); phase_xattn(XQ, KVM, XO, lds, wave, lane, gw, NGW); } }
    SEAM(8);
    if (IN(9)) {
        pg8::Gemm g{XO, W_O, MTOK, D, XAW}; pg8::StaticOrder S; S.init(MTOK, D, G, bx);
        pg8::EpiResid E{XN, ss3, (char*)(ws + WS_Y), 1.0f};
        pg8::gemm_phase<pg8::EpiResid, pg8::StaticOrder, PG8_ALIGN, PG8_SP2>(lds + RING_OFF, g, S, E, wave);
        if (PROBE_MASK & 512) { xcd_barrier(bar); pg8::EpiResid E2{XN, ss4 + MTOK, nullptr, 0.0f}; pg8::gemm_phase<pg8::EpiResid, pg8::StaticOrder, PG8_ALIGN, PG8_SP2>(lds + RING_OFF, g, S, E2, wave); }
    }
    SEAM(9);
    if (IN(10)) {
        pg8::Gemm g{(const pg8::bf16_t*)(ws + WS_Y), W_UP2, MTOK, NUP, D}; pg8::StaticOrder S; S.init(MTOK, NUP, G, bx);
        pg8::EpiSwiGLU E{HB, ss3, DN8_PN, 1.0f / 128.0f, (char*)out};
        pg8::gemm_phase<pg8::EpiSwiGLU, pg8::StaticOrder, PG8_ALIGN, PG8_SP2, 0, true>(lds + RING_OFF, g, S, E, wave);
        const int lane = LANE_NOW(), tid = wave * 64 + lane;
        for (;;) {
            __syncthreads();
            if (tid == 0) MISC[0] = atomicAdd(ctl + CW_CONVCTR + 64, 1u);
            __syncthreads();
            const int chunk = (int)MISC[0];
            if (CI_P1 + chunk * CONV_CHUNK >= CI_P10) break;
            LAS float* scr = (LAS float*)(lds + RING_OFF + wave * 16384);
            for (int j = 0; j < CONV_CHUNK / NWAVES; ++j) { const int gi = CI_P1 + chunk * CONV_CHUNK + wave * (CONV_CHUNK / NWAVES) + j; if (gi < CI_P10) deferred_item(gi, args.in, ws, scr, lane); }
        }
    }
    SEAM(10);
    if (IN(11)) {
        pg8::StaticOrder S; S.init(MTOK, D, G, bx, 8, 1);
        pg8::Gemm2 g{HB, W_DN2, MTOK, D, DN8_PN * 128, DFF, (const pg8::bf16_t*)out, (const pg8::bf16_t*)(ws + WS_WUP1), DFF - DN8_PN * 128};
        pg8::EpiResid E{XN, ss4, nullptr, 0.5f};
        pg8::gemm_phase_tail8<pg8::EpiResid, pg8::StaticOrder>(lds + RING_OFF, g, S, E, wave);
    }
    SEAM(11);
    if (IN(12)) {
        const float* gf = args.in[31];
        int ln12; asm volatile("v_mbcnt_lo_u32_b32 %0, -1, 0\n\tv_mbcnt_hi_u32_b32 %0, -1, %0" : "=&v"(ln12));
        const int lane = ln12;
        const int gq = lane >> 3, rb = (lane >> 2) & 1, chk = lane & 3;
        for (int p = gw; p < MTOK / 2; p += NGW) {
            const int m = 2 * p + rb; const float rs = rsqrtf(pg8::ss_get(ss4 + m) * (1.0f / D) + EPS); float* orow = out + (size_t)m * D;
#pragma unroll 4
            for (int j = 0; j < 16; ++j) { const int c0 = (j * 8 + gq) * 32 + chk * 8; float a[8]; unpack8(*(const v4u*)((const char*)XN + pg8::blk_off(m, c0, 64)), a);
                const f32x4 g0 = *(const f32x4*)(gf + c0), g1 = *(const f32x4*)(gf + c0 + 4);
                *(f32x4*)(orow + c0) = (f32x4){a[0] * rs * g0[0], a[1] * rs * g0[1], a[2] * rs * g0[2], a[3] * rs * g0[3]};
                *(f32x4*)(orow + c0 + 4) = (f32x4){a[4] * rs * g1[0], a[5] * rs * g1[1], a[6] * rs * g1[2], a[7] * rs * g1[3]}; }
        }
    }
#undef IN
#undef LANE_NOW
#undef SEAM
}

extern "C" void kernel_launch(void* const* d_in, const int* in_sizes, int n_in, void* d_out, int out_size, void* d_ws, size_t ws_size, hipStream_t stream) {
    static int grid = 0;
    if (grid == 0) {
        if (n_in != 32 || in_sizes[0] != MP * D || in_sizes[1] != MS * D || out_size != MTOK * D || ws_size < WS_END) {
            fprintf(stderr, "kernel_launch: shape/workspace mismatch: n_in %d in0 %d in1 %d out %d ws %zu (need %zu); nothing launched\n", n_in, n_in > 0 ? in_sizes[0] : -1, n_in > 1 ? in_sizes[1] : -1, out_size, ws_size, (size_t)WS_END);
            grid = -1; return; }
        int dev = 0, cus = 0, per_cu = 0;
        if (hipGetDevice(&dev) != hipSuccess || hipDeviceGetAttribute(&cus, hipDeviceAttributeMultiprocessorCount, dev) != hipSuccess) { grid = -1; return; }
        if (hipFuncSetAttribute((const void*)mk_fwd, hipFuncAttributeMaxDynamicSharedMemorySize, LDS_BYTES) != hipSuccess) { fprintf(stderr, "kernel_launch: hipFuncSetAttribute failed\n"); grid = -1; return; }
        if (hipOccupancyMaxActiveBlocksPerMultiprocessor(&per_cu, (const void*)mk_fwd, NWAVES * 64, LDS_BYTES) != hipSuccess || per_cu < 1)
            fprintf(stderr, "kernel_launch: note: occupancy query reports %d workgroups per CU\n", per_cu);
        (void)hipGetLastError();
        grid = cus;
    }
    if (grid < 0) return;
    if (hipMemsetAsync((char*)d_ws + WS_CTL, 0, CTL_ZERO_BYTES, stream) != hipSuccess) return;
    Args a{};
    for (int i = 0; i < 32; ++i) a.in[i] = (const float*)d_in[i];
    a.out = (float*)d_out; a.ws = (unsigned char*)d_ws;
#if MK_N_LAUNCHES == 1
    a.ph_lo = 0; a.ph_hi = N_PHASES;
    hipLaunchKernelGGL(mk_fwd, dim3(grid), dim3(NWAVES * 64), LDS_BYTES, stream, a);
#else
    for (int p = 0; p < N_PHASES; ++p) { a.ph_lo = p; a.ph_hi = p + 1; hipLaunchKernelGGL(mk_fwd, dim3(grid), dim3(NWAVES * 64), LDS_BYTES, stream, a); }
#endif
    const hipError_t le = hipPeekAtLastError();
    if (le != hipSuccess) fprintf(stderr, "kernel_launch: launch failed: %s\n", hipGetErrorName(le));
}
```

```cpp
#include <hip/hip_runtime.h>
#include <cstdio>
#include <cstdint>
namespace pg8 {
#define PG8_LAS __attribute__((address_space(3)))
typedef unsigned short bf16_t;
typedef short bf16x8 __attribute__((ext_vector_type(8)));
typedef float f32x4 __attribute__((ext_vector_type(4)));
typedef unsigned u32x4 __attribute__((ext_vector_type(4)));
constexpr int BM = 256, BK = 64, HALF = 128, HTB = HALF * BK * 2  , STAGE_BYTES = 8 * HTB, NXCD = 8, WGM = 8;

__host__ __device__ __forceinline__ int lds_byte(int r, int c) { const int st = (r >> 4) * 2 + (c >> 5), rr = r & 15, cc = c & 31, ob = rr * 64 + cc * 2; return st * 1024 + (ob ^ (((ob >> 9) & 1) << 5)); }
__host__ __device__ __forceinline__ void stage_rc(int b, int& R, int& C) { const int st = b / 1024, sb = b % 1024, swz = sb ^ (((sb >> 9) & 1) << 5); R = (st >> 1) * 16 + swz / 64; C = (st & 1) * 32 + (swz % 64) / 2; }
__host__ __device__ __forceinline__ int perm32(int rho) { const int n = rho >> 4, i = rho & 15; return 8 * (i >> 2) + 4 * n + (i & 3); }

__host__ __device__ __forceinline__ int perm32inv(int v) { return 16 * ((v >> 2) & 1) + 4 * (v >> 3) + (v & 3); }
__host__ __device__ __forceinline__ size_t blk_off(int row, int col, int nkt) { const int p = row >> 8, h = (row >> 7) & 1, r = row & 127, kt = col >> 6, c = col & 63; return ((size_t)((p * nkt + kt) * 2 + h) << 14) + (size_t)lds_byte(r, c); }
typedef int i32x4v __attribute__((ext_vector_type(4)));
typedef int i32x8v __attribute__((ext_vector_type(8)));
typedef short bf16x16v __attribute__((ext_vector_type(16)));
__host__ __device__ __forceinline__ size_t blk8_off(int row, int col, int nkt8) { const int p = row >> 8, h = (row >> 7) & 1, r = row & 127, kt = col >> 7, cb = col & 127, c8 = cb >> 4;
    return ((size_t)((p * nkt8 + kt) * 2 + h) << 14) + (size_t)((r >> 4) * 2048 + (c8 & 1) * 1024 + ((c8 >> 1) * 16 + (r & 15)) * 16 + (cb & 15)); }
struct Unit { int pm, pn; };
struct Gemm { const bf16_t* A; const bf16_t* Bt; int M, N, K; int Ks = 0; };

#ifndef PG8_XCDROWS
#define PG8_XCDROWS 1
#endif
struct StaticOrder {
    int nM, nN, nwg, G, c, wgm, rev;
    __host__ __device__ void init(int M, int N, int G_, int c_, int wgm_ = WGM, int rev_ = 0) { nM = M / BM; nN = N / BM; nwg = nM * nN; G = G_; c = c_; wgm = wgm_; rev = rev_; }
    __host__ __device__ bool next(int i, Unit& u) const {
        const long L = (long)i * G + c; if (L >= nwg) return false;
        if (PG8_XCDROWS && nM % NXCD == 0 && G % NXCD == 0) {
            const int xcd = (int)(L % NXCD), off = (int)(L / NXCD), nMl = nM / NXCD, nig = wgm * nN, gid = off / nig, fm = gid * wgm, gsz = (nMl - fm) < wgm ? (nMl - fm) : wgm, w = off % nig;
            u.pm = xcd * nMl + fm + w % gsz; u.pn = w / gsz; if (rev) u.pm = nM - 1 - u.pm; return true; }
        int wgid = (int)L; { const int q = nwg / NXCD, r = nwg % NXCD, xcd = wgid % NXCD, off = wgid / NXCD; wgid = (xcd < r ? xcd * (q + 1) : r * (q + 1) + (xcd - r) * q) + off; }
        const int nig = wgm * nN, gid = wgid / nig, fm = gid * wgm, gsz = (nM - fm) < wgm ? (nM - fm) : wgm;
        u.pm = fm + ((wgid % nig) % gsz); u.pn = (wgid % nig) / gsz; if (rev) u.pm = nM - 1 - u.pm; return true;
    }
    __device__ __forceinline__ void a_ready(const Unit&) const {}
    __device__ __forceinline__ void done(const Unit&) const {}
};
__device__ __forceinline__ unsigned cvt_pk_bf16(float lo, float hi) { unsigned r; asm volatile("v_cvt_pk_bf16_f32 %0, %1, %2" : "=v"(r) : "v"(lo), "v"(hi)); return r; }
typedef float f32x2 __attribute__((ext_vector_type(2)));
template <class Epi, class Sched, bool ALIGN_EPI = false, bool SP2 = false, int VAR = 0, bool FP8 = false>
__device__ __forceinline__ void gemm_phase(PG8_LAS unsigned char* lds, const Gemm g, const Sched& S, const Epi& E, const int wid) {
    int lane_; asm volatile("v_mbcnt_lo_u32_b32 %0, -1, 0\n\tv_mbcnt_hi_u32_b32 %0, -1, %0" : "=&v"(lane_));
    const int lane = lane_, tid = wid * 64 + lane, wr = wid >> 2, wc = wid & 3, fr = lane & 15, fq = lane >> 4;
    const int K = g.K, nt = K / (FP8 ? 2 * BK : BK);
    unsigned voffA[2], voffB[2];
#pragma unroll
    for (int i = 0; i < 2; ++i) { voffA[i] = (unsigned)(tid * 16 + i * 8192); voffB[i] = voffA[i]; }
    const size_t kstep = 32768;
    const size_t hstep = 16384;
    const size_t tstep = (size_t)((g.Ks ? g.Ks : K) / (FP8 ? 2 * BK : BK)) * 32768;
    const unsigned ldsw = (unsigned)wid * 1024u; const unsigned ldsb_ = (unsigned)(uintptr_t)lds + ldsw;
    const int aoff = FP8 ? (wr * 8192 + lane * 16) : lds_byte(wr * 64 + fr, fq * 8), boff = FP8 ? (wc * 4096 + lane * 16) : lds_byte(wc * 32 + fr, fq * 8);
#define PG8_SA(b, h) (((b) * 2 + (h)) * HTB)
#define PG8_SB(b, h) ((4 + (b) * 2 + (h)) * HTB)
#define PG8_STAGE(bufoff, gbase, voff) do { _Pragma("unroll") for (int _i = 0; _i < 2; ++_i) { const char* gb_ = (const char*)(gbase) + _i * 8192;     \
        asm volatile("s_mov_b32 m0, %0\n\ts_nop 0\n\tglobal_load_lds_dwordx4 %1, %2" :: "s"(ldsb_ + (unsigned)((bufoff) + _i * 8192)), "v"((voff)[0]), "s"(gb_) : "memory", "m0"); } } while (0)
#define PG8_LDA(dst, b, h) do { if constexpr (FP8) { _Pragma("unroll") for (int m = 0; m < 4; ++m) { const bf16x8 lo_ = *(const PG8_LAS bf16x8*)(lds + PG8_SA(b, h) + aoff + m * 2048), hi_ = *(const PG8_LAS bf16x8*)(lds + PG8_SA(b, h) + aoff + m * 2048 + 1024); \
        dst##8[m] = __builtin_shufflevector(lo_, hi_, 0, 1, 2, 3, 4, 5, 6, 7, 8, 9, 10, 11, 12, 13, 14, 15); } } \
      else { _Pragma("unroll") for (int m = 0; m < 4; ++m) _Pragma("unroll") for (int k = 0; k < 2; ++k) dst[m][k] = *(const PG8_LAS bf16x8*)(lds + PG8_SA(b, h) + aoff + m * 2048 + k * 1024); } } while (0)
#define PG8_LDB(dst, b, h) do { if constexpr (FP8) { _Pragma("unroll") for (int n = 0; n < 2; ++n) { const bf16x8 lo_ = *(const PG8_LAS bf16x8*)(lds + PG8_SB(b, h) + boff + n * 2048), hi_ = *(const PG8_LAS bf16x8*)(lds + PG8_SB(b, h) + boff + n * 2048 + 1024); \
        dst##8[n] = __builtin_shufflevector(lo_, hi_, 0, 1, 2, 3, 4, 5, 6, 7, 8, 9, 10, 11, 12, 13, 14, 15); } } \
      else { _Pragma("unroll") for (int n = 0; n < 2; ++n) _Pragma("unroll") for (int k = 0; k < 2; ++k) dst[n][k] = *(const PG8_LAS bf16x8*)(lds + PG8_SB(b, h) + boff + n * 2048 + k * 1024); } } while (0)
#define PG8_CAT8(x0, x1) __builtin_shufflevector(__builtin_bit_cast(i32x4v, x0), __builtin_bit_cast(i32x4v, x1), 0, 1, 2, 3, 4, 5, 6, 7)
#define PG8_MMA(ai, bj, At, Bt) do { __builtin_amdgcn_s_setprio(1); if constexpr (FP8) { _Pragma("unroll") for (int m = 0; m < 4; ++m) _Pragma("unroll") for (int n = 0; n < 2; ++n) \
        acc[ai][bj][m][n] = __builtin_amdgcn_mfma_scale_f32_16x16x128_f8f6f4(__builtin_bit_cast(i32x8v, Bt##8[n]), __builtin_bit_cast(i32x8v, At##8[m]), acc[ai][bj][m][n], 0, 0, 0, 0x7f7f7f7f, 0, 0x7f7f7f7f); } \
      else { _Pragma("unroll") for (int m = 0; m < 4; ++m) _Pragma("unroll") for (int n = 0; n < 2; ++n) _Pragma("unroll") for (int k = 0; k < 2; ++k) \
        acc[ai][bj][m][n] = __builtin_amdgcn_mfma_f32_16x16x32_bf16(Bt[n][k], At[m][k], acc[ai][bj][m][n], 0, 0, 0); } __builtin_amdgcn_s_setprio(0); } while (0)
#define PG8_WAIT_V(n) asm volatile("s_waitcnt vmcnt(" #n ")" ::: "memory")
#define PG8_WAIT_L(n) asm volatile("s_waitcnt lgkmcnt(" #n ")" ::: "memory")
#define PG8_BAR __builtin_amdgcn_s_barrier()
#define PG8_SCHED __builtin_amdgcn_sched_barrier(0)
    Unit cur, nxt; int ui = 0;
    if (!S.next(0, cur)) return;
    f32x4 acc[2][2][4][2];
#pragma unroll
    for (int a = 0; a < 2; ++a)
#pragma unroll
        for (int b = 0; b < 2; ++b)
#pragma unroll
            for (int m = 0; m < 4; ++m)
#pragma unroll
                for (int n = 0; n < 2; ++n) acc[a][b][m][n] = (f32x4){0.f, 0.f, 0.f, 0.f};
    bf16x8 At[4][2], B0[2][2], B1[2][2];
    bf16x16v At8[4], B08[2], B18[2];
    u32x4 bx[8]; if constexpr (VAR == 2) { _Pragma("unroll") for (int j_ = 0; j_ < 8; ++j_) bx[j_] = (u32x4){0u, 0u, 0u, 0u}; }
    const char* cA = (const char*)g.A + (size_t)cur.pm * tstep; const char* cB = (const char*)g.Bt + (size_t)cur.pn * tstep;
    S.a_ready(cur);
    if constexpr (SP2) {
        PG8_STAGE(PG8_SB(0, 0), cB, voffB); PG8_STAGE(PG8_SB(0, 1), cB + hstep, voffB); PG8_STAGE(PG8_SA(0, 0), cA, voffA); PG8_STAGE(PG8_SA(0, 1), cA + hstep, voffA);
        if (wr == 1) PG8_BAR;
        PG8_WAIT_V(2); PG8_BAR;
        PG8_STAGE(PG8_SB(1, 0), cB + kstep, voffB); PG8_STAGE(PG8_SA(1, 0), cA + kstep, voffA); PG8_STAGE(PG8_SB(1, 1), cB + hstep + kstep, voffB);
        PG8_WAIT_V(6); PG8_BAR;
    } else {
        PG8_STAGE(PG8_SB(0, 0), cB, voffB); PG8_STAGE(PG8_SA(0, 0), cA, voffA); PG8_STAGE(PG8_SB(0, 1), cB + hstep, voffB); PG8_STAGE(PG8_SA(0, 1), cA + hstep, voffA);
        if (wr == 1) PG8_BAR;
        PG8_WAIT_V(4); PG8_BAR;
        PG8_STAGE(PG8_SB(1, 0), cB + kstep, voffB); PG8_STAGE(PG8_SA(1, 0), cA + kstep, voffA); PG8_STAGE(PG8_SB(1, 1), cB + hstep + kstep, voffB);
        PG8_WAIT_V(6); PG8_BAR;
    }
    for (;;) {
        const bool has_next = S.next(ui + 1, nxt);
        const char* nA = has_next ? (const char*)g.A + (size_t)nxt.pm * tstep : cA; const char* nB = has_next ? (const char*)g.Bt + (size_t)nxt.pn * tstep : cB;
        for (int t = 0; t < nt; t += 2) {
            const bool last = (t == nt - 2);
            const char* a1 = cA + (size_t)(t + 1) * kstep;
            const char* a2 = last ? nA : cA + (size_t)(t + 2) * kstep; const char* b2 = last ? nB : cB + (size_t)(t + 2) * kstep;
            const char* a3 = a2 + kstep; const char* b3 = b2 + kstep;
            if (last && has_next) S.a_ready(nxt);
            if constexpr (SP2) {
#define PG8_STB(bufoff, gbase) do { if constexpr (VAR == 0) { PG8_STAGE(bufoff, gbase, voffB); } } while (0)
#define PG8_WV() do { if constexpr (VAR == 0) { PG8_WAIT_V(8); } else if constexpr (VAR == 1) { PG8_WAIT_V(4); } else { PG8_WAIT_V(12); } } while (0)
#define PG8_WV0() do { if constexpr (FP8) { PG8_WV(); } else if constexpr (VAR == 0 && Epi::NVM_MIN == 16) { if (t == 0 && ui > 0) { PG8_WAIT_V(24); } else { PG8_WAIT_V(8); } } else if constexpr (VAR == 0 && Epi::NVM_MIN == 8) { if (t == 0 && ui > 0) { PG8_WAIT_V(16); } else { PG8_WAIT_V(8); } } else { PG8_WV(); } } while (0)
#define PG8_BREG(gbase) do { if constexpr (VAR == 2) { _Pragma("unroll") for (int j_ = 0; j_ < 8; ++j_) asm volatile("" :: "v"(bx[j_])); \
        _Pragma("unroll") for (int j_ = 0; j_ < 8; ++j_) bx[j_] = *(const u32x4*)((gbase) + wc * 8192 + j_ * 1024 + lane * 16); } } while (0)
            PG8_LDB(B0, 0, 0); PG8_LDB(B1, 0, 1); PG8_SCHED; PG8_LDA(At, 0, 0); PG8_STAGE(PG8_SA(1, 1), a1 + hstep, voffA); PG8_BREG(b2);
            PG8_WV0(); PG8_WAIT_L(0); PG8_BAR; PG8_MMA(0, 0, At, B0); PG8_MMA(0, 1, At, B1); PG8_BAR; PG8_SCHED;
            PG8_LDA(At, 0, 1); PG8_STB(PG8_SB(0, 0), b2); PG8_STB(PG8_SB(0, 1), b2 + hstep); PG8_STAGE(PG8_SA(0, 0), a2, voffA);
            PG8_WV0(); PG8_WAIT_L(0); PG8_BAR; PG8_MMA(1, 0, At, B0); PG8_MMA(1, 1, At, B1); PG8_BAR; PG8_SCHED;
            PG8_LDB(B0, 1, 0); PG8_LDB(B1, 1, 1); PG8_SCHED; PG8_LDA(At, 1, 0); PG8_STAGE(PG8_SA(0, 1), a2 + hstep, voffA); PG8_BREG(b3);
            PG8_WV(); PG8_WAIT_L(0); PG8_BAR; PG8_MMA(0, 0, At, B0); PG8_MMA(0, 1, At, B1); PG8_BAR; PG8_SCHED;
            PG8_LDA(At, 1, 1); PG8_STB(PG8_SB(1, 0), b3); PG8_STB(PG8_SB(1, 1), b3 + hstep); PG8_STAGE(PG8_SA(1, 0), a3, voffA);
            PG8_WV(); PG8_WAIT_L(0); PG8_BAR; PG8_MMA(1, 0, At, B0); PG8_MMA(1, 1, At, B1); PG8_BAR; PG8_SCHED;
#undef PG8_STB
#undef PG8_WV
#undef PG8_WV0
#undef PG8_BREG
            } else {
            PG8_LDB(B0, 0, 0); PG8_SCHED; PG8_LDA(At, 0, 0); PG8_STAGE(PG8_SA(1, 1), a1 + hstep, voffA);
            PG8_WAIT_L(8); PG8_BAR; PG8_WAIT_L(0); PG8_MMA(0, 0, At, B0); PG8_BAR; PG8_SCHED;
            PG8_LDB(B1, 0, 1); PG8_STAGE(PG8_SB(0, 0), b2, voffB);
            PG8_BAR; PG8_WAIT_L(0); PG8_MMA(0, 1, At, B1); PG8_BAR;
            PG8_LDA(At, 0, 1); PG8_STAGE(PG8_SA(0, 0), a2, voffA);
            PG8_BAR; PG8_WAIT_L(0); PG8_MMA(1, 0, At, B0); PG8_BAR; PG8_SCHED;
            PG8_STAGE(PG8_SB(0, 1), b2 + hstep, voffB);
            PG8_WAIT_V(6); PG8_BAR; PG8_MMA(1, 1, At, B1); PG8_BAR;
            PG8_LDB(B0, 1, 0); PG8_SCHED; PG8_LDA(At, 1, 0); PG8_STAGE(PG8_SA(0, 1), a2 + hstep, voffA);
            PG8_WAIT_L(8); PG8_BAR; PG8_WAIT_L(0); PG8_MMA(0, 0, At, B0); PG8_BAR; PG8_SCHED;
            PG8_LDB(B1, 1, 1); PG8_STAGE(PG8_SB(1, 0), b3, voffB);
            PG8_BAR; PG8_WAIT_L(0); PG8_MMA(0, 1, At, B1); PG8_BAR;
            PG8_LDA(At, 1, 1); PG8_STAGE(PG8_SA(1, 0), a3, voffA);
            PG8_BAR; PG8_WAIT_L(0); PG8_MMA(1, 0, At, B0); PG8_BAR; PG8_SCHED;
            PG8_STAGE(PG8_SB(1, 1), b3 + hstep, voffB);
            PG8_WAIT_V(6); PG8_BAR; PG8_MMA(1, 1, At, B1); PG8_BAR;
            }
        }
        if constexpr (ALIGN_EPI) { if (wr == 0) PG8_BAR; }
        if constexpr (!Epi::AFTER_DRAIN) {
            { int ln_; asm volatile("v_mbcnt_lo_u32_b32 %0, -1, 0\n\tv_mbcnt_hi_u32_b32 %0, -1, %0" : "=&v"(ln_)); E(acc, cur, wr, wc, ln_ & 15, ln_ >> 4); }
            S.done(cur); }
        if (!has_next) break;
#pragma unroll
        for (int a = 0; a < 2; ++a)
#pragma unroll
            for (int b = 0; b < 2; ++b)
#pragma unroll
                for (int m = 0; m < 4; ++m)
#pragma unroll
                    for (int n = 0; n < 2; ++n) acc[a][b][m][n] = (f32x4){0.f, 0.f, 0.f, 0.f};
        cur = nxt; cA = nA; cB = nB; ++ui;
        if constexpr (ALIGN_EPI) { if (wr == 1) PG8_BAR; }
    }
    PG8_WAIT_V(0);
    if constexpr (!ALIGN_EPI) { if (wr == 0) PG8_BAR; }
    PG8_BAR;
    if constexpr (Epi::AFTER_DRAIN) { E.fused(acc, cur, wr, wc, fr, fq, lds, wid, lane); S.done(cur); }
#undef PG8_SA
#undef PG8_SB
#undef PG8_STAGE
#undef PG8_LDA
#undef PG8_LDB
#undef PG8_MMA
#undef PG8_CAT8
#undef PG8_WAIT_V
#undef PG8_WAIT_L
#undef PG8_BAR
#undef PG8_SCHED
}
struct Gemm2 { const bf16_t* A; const bf16_t* Bt; int M, N, K, Ks; const bf16_t* A8; const bf16_t* B8; int K8; };
template <class Epi, class Sched>
__device__ __forceinline__ void gemm_phase_tail8(PG8_LAS unsigned char* lds, const Gemm2 g, const Sched& S, const Epi& E, const int wid) {
    int lane_; asm volatile("v_mbcnt_lo_u32_b32 %0, -1, 0\n\tv_mbcnt_hi_u32_b32 %0, -1, %0" : "=&v"(lane_));
    const int tid = wid * 64 + lane_, wr = wid >> 2, wc = wid & 3;
    const int ntA = g.K / BK, ntB = g.K8 / (2 * BK);
    unsigned voff[1]; voff[0] = (unsigned)(tid * 16);
    const size_t kstep = 32768, hstep = 16384, tstepA = (size_t)(g.Ks / BK) * 32768, tstepB = (size_t)ntB * 32768;
    const unsigned ldsw = (unsigned)wid * 1024u; const unsigned ldsb_ = (unsigned)(uintptr_t)lds + ldsw;
#define PT_SA(b, h) (((b) * 2 + (h)) * HTB)
#define PT_SB(b, h) ((4 + (b) * 2 + (h)) * HTB)
#define PT_STAGE(bufoff, gbase) do { _Pragma("unroll") for (int _i = 0; _i < 2; ++_i) { const char* gb_ = (const char*)(gbase) + _i * 8192; \
        asm volatile("s_mov_b32 m0, %0\n\ts_nop 0\n\tglobal_load_lds_dwordx4 %1, %2" :: "s"(ldsb_ + (unsigned)((bufoff) + _i * 8192)), "v"(voff[0]), "s"(gb_) : "memory", "m0"); } } while (0)
#define PT_LDA(F8, b, h) do { if constexpr (F8) { _Pragma("unroll") for (int m = 0; m < 4; ++m) { const bf16x8 lo_ = *(const PG8_LAS bf16x8*)(lds + PT_SA(b, h) + aoff + m * 2048), hi_ = *(const PG8_LAS bf16x8*)(lds + PT_SA(b, h) + aoff + m * 2048 + 1024); \
        At8[m] = __builtin_shufflevector(lo_, hi_, 0, 1, 2, 3, 4, 5, 6, 7, 8, 9, 10, 11, 12, 13, 14, 15); } } \
      else { _Pragma("unroll") for (int m = 0; m < 4; ++m) _Pragma("unroll") for (int k = 0; k < 2; ++k) At[m][k] = *(const PG8_LAS bf16x8*)(lds + PT_SA(b, h) + aoff + m * 2048 + k * 1024); } } while (0)
#define PT_LDB(F8, dst, b, h) do { if constexpr (F8) { _Pragma("unroll") for (int n = 0; n < 2; ++n) { const bf16x8 lo_ = *(const PG8_LAS bf16x8*)(lds + PT_SB(b, h) + boff + n * 2048), hi_ = *(const PG8_LAS bf16x8*)(lds + PT_SB(b, h) + boff + n * 2048 + 1024); \
        dst##8[n] = __builtin_shufflevector(lo_, hi_, 0, 1, 2, 3, 4, 5, 6, 7, 8, 9, 10, 11, 12, 13, 14, 15); } } \
      else { _Pragma("unroll") for (int n = 0; n < 2; ++n) _Pragma("unroll") for (int k = 0; k < 2; ++k) dst[n][k] = *(const PG8_LAS bf16x8*)(lds + PT_SB(b, h) + boff + n * 2048 + k * 1024); } } while (0)
#define PT_MMA(F8, ai, bj, Bt) do { __builtin_amdgcn_s_setprio(1); if constexpr (F8) { _Pragma("unroll") for (int m = 0; m < 4; ++m) _Pragma("unroll") for (int n = 0; n < 2; ++n) \
        acc[ai][bj][m][n] = __builtin_amdgcn_mfma_scale_f32_16x16x128_f8f6f4(__builtin_bit_cast(i32x8v, Bt##8[n]), __builtin_bit_cast(i32x8v, At8[m]), acc[ai][bj][m][n], 0, 0, 0, 0x78787878, 0, 0x7f7f7f7f); } \
      else { _Pragma("unroll") for (int m = 0; m < 4; ++m) _Pragma("unroll") for (int n = 0; n < 2; ++n) _Pragma("unroll") for (int k = 0; k < 2; ++k) \
        acc[ai][bj][m][n] = __builtin_amdgcn_mfma_f32_16x16x32_bf16(Bt[n][k], At[m][k], acc[ai][bj][m][n], 0, 0, 0); } __builtin_amdgcn_s_setprio(0); } while (0)
#define PT_WV asm volatile("s_waitcnt vmcnt(8)" ::: "memory")
#define PT_WL asm volatile("s_waitcnt lgkmcnt(0)" ::: "memory")
#define PT_BAR __builtin_amdgcn_s_barrier()
#define PT_SCHED __builtin_amdgcn_sched_barrier(0)
#define PT_BODY(F8) do { \
            PT_LDB(F8, B0, 0, 0); PT_LDB(F8, B1, 0, 1); PT_SCHED; PT_LDA(F8, 0, 0); PT_STAGE(PT_SA(1, 1), a1 + hstep); \
            PT_WV; PT_WL; PT_BAR; PT_MMA(F8, 0, 0, B0); PT_MMA(F8, 0, 1, B1); PT_BAR; PT_SCHED; \
            PT_LDA(F8, 0, 1); PT_STAGE(PT_SB(0, 0), b2); PT_STAGE(PT_SB(0, 1), b2 + hstep); PT_STAGE(PT_SA(0, 0), a2); \
            PT_WV; PT_WL; PT_BAR; PT_MMA(F8, 1, 0, B0); PT_MMA(F8, 1, 1, B1); PT_BAR; PT_SCHED; \
            PT_LDB(F8, B0, 1, 0); PT_LDB(F8, B1, 1, 1); PT_SCHED; PT_LDA(F8, 1, 0); PT_STAGE(PT_SA(0, 1), a2 + hstep); \
            PT_WV; PT_WL; PT_BAR; PT_MMA(F8, 0, 0, B0); PT_MMA(F8, 0, 1, B1); PT_BAR; PT_SCHED; \
            PT_LDA(F8, 1, 1); PT_STAGE(PT_SB(1, 0), b3); PT_STAGE(PT_SB(1, 1), b3 + hstep); PT_STAGE(PT_SA(1, 0), a3); \
            PT_WV; PT_WL; PT_BAR; PT_MMA(F8, 1, 0, B0); PT_MMA(F8, 1, 1, B1); PT_BAR; PT_SCHED; } while (0)
    Unit cur, nxt; int ui = 0;
    if (!S.next(0, cur)) return;
    f32x4 acc[2][2][4][2];
#pragma unroll
    for (int a = 0; a < 2; ++a)
#pragma unroll
        for (int b = 0; b < 2; ++b)
#pragma unroll
            for (int m = 0; m < 4; ++m)
#pragma unroll
                for (int n = 0; n < 2; ++n) acc[a][b][m][n] = (f32x4){0.f, 0.f, 0.f, 0.f};
    bf16x8 At[4][2], B0[2][2], B1[2][2];
    bf16x16v At8[4], B08[2], B18[2];
    const char* cA = (const char*)g.A + (size_t)cur.pm * tstepA; const char* cB = (const char*)g.Bt + (size_t)cur.pn * tstepA;
    const char* cA8 = (const char*)g.A8 + (size_t)cur.pm * tstepB; const char* cB8 = (const char*)g.B8 + (size_t)cur.pn * tstepB;
    PT_STAGE(PT_SB(0, 0), cB); PT_STAGE(PT_SB(0, 1), cB + hstep); PT_STAGE(PT_SA(0, 0), cA); PT_STAGE(PT_SA(0, 1), cA + hstep);
    if (wr == 1) PT_BAR;
    asm volatile("s_waitcnt vmcnt(2)" ::: "memory"); PT_BAR;
    PT_STAGE(PT_SB(1, 0), cB + kstep); PT_STAGE(PT_SA(1, 0), cA + kstep); PT_STAGE(PT_SB(1, 1), cB + hstep + kstep);
    asm volatile("s_waitcnt vmcnt(6)" ::: "memory"); PT_BAR;
    for (;;) {
        const bool has_next = S.next(ui + 1, nxt);
        const char* nA = has_next ? (const char*)g.A + (size_t)nxt.pm * tstepA : cA; const char* nB = has_next ? (const char*)g.Bt + (size_t)nxt.pn * tstepA : cB;
        {
            int ln_; asm volatile("v_mbcnt_lo_u32_b32 %0, -1, 0\n\tv_mbcnt_hi_u32_b32 %0, -1, %0" : "=&v"(ln_));
            const int aoff = lds_byte(wr * 64 + (ln_ & 15), (ln_ >> 4) * 8), boff = lds_byte(wc * 32 + (ln_ & 15), (ln_ >> 4) * 8);
            for (int t = 0; t < ntA; t += 2) { const bool last = (t == ntA - 2);
                const char* a1 = cA + (size_t)(t + 1) * kstep;
                const char* a2 = last ? cA8 : cA + (size_t)(t + 2) * kstep; const char* b2 = last ? cB8 : cB + (size_t)(t + 2) * kstep;
                const char* a3 = a2 + kstep; const char* b3 = b2 + kstep;
                PT_BODY(false); } }
        {
            int ln_; asm volatile("v_mbcnt_lo_u32_b32 %0, -1, 0\n\tv_mbcnt_hi_u32_b32 %0, -1, %0" : "=&v"(ln_));
            const int aoff = wr * 8192 + ln_ * 16, boff = wc * 4096 + ln_ * 16;
            for (int t = 0; t < ntB; t += 2) { const bool last = (t == ntB - 2);
                const char* a1 = cA8 + (size_t)(t + 1) * kstep;
                const char* a2 = last ? nA : cA8 + (size_t)(t + 2) * kstep; const char* b2 = last ? nB : cB8 + (size_t)(t + 2) * kstep;
                const char* a3 = a2 + kstep; const char* b3 = b2 + kstep;
                PT_BODY(true); } }
        if (wr == 0) PT_BAR;
        { int ln_; asm volatile("v_mbcnt_lo_u32_b32 %0, -1, 0\n\tv_mbcnt_hi_u32_b32 %0, -1, %0" : "=&v"(ln_)); E(acc, cur, wr, wc, ln_ & 15, ln_ >> 4); }
        if (!has_next) break;
#pragma unroll
        for (int a = 0; a < 2; ++a)
#pragma unroll
            for (int b = 0; b < 2; ++b)
#pragma unroll
                for (int m = 0; m < 4; ++m)
#pragma unroll
                    for (int n = 0; n < 2; ++n) acc[a][b][m][n] = (f32x4){0.f, 0.f, 0.f, 0.f};
        cur = nxt; cA = nA; cB = nB; cA8 = (const char*)g.A8 + (size_t)cur.pm * tstepB; cB8 = (const char*)g.B8 + (size_t)cur.pn * tstepB; ++ui;
        if (wr == 1) PT_BAR;
    }
    asm volatile("s_waitcnt vmcnt(0)" ::: "memory");
    PT_BAR;
#undef PT_SA
#undef PT_SB
#undef PT_STAGE
#undef PT_LDA
#undef PT_LDB
#undef PT_MMA
#undef PT_WV
#undef PT_WL
#undef PT_BAR
#undef PT_SCHED
#undef PT_BODY
}
}

#ifndef PG8_SP2
#define PG8_SP2 true
#endif
#ifndef PG8_ALIGN
#define PG8_ALIGN true
#endif
#ifndef PROBE_MASK
#define PROBE_MASK 0
#endif
#ifndef WGM_DOWN
#define WGM_DOWN 4
#endif
#ifndef PROBE_VAR
#define PROBE_VAR 0
#endif
constexpr int DN8_PN = 24;
constexpr int DN8_KT = 86 - DN8_PN;
#ifndef MK_N_LAUNCHES
#define MK_N_LAUNCHES 1
#endif

constexpr int D = 4096, DFF = 11008, NUP = 2 * DFF, NIN = 10240, AW = 2048, LW = 2048;
constexpr int MP = 16384, MS = 8192, MTOK = MP + MS;
constexpr int NMEM = 9 * 256;
constexpr int XAW = 512;
constexpr float EPS = 1e-6f;
constexpr int NWAVES = 8;
constexpr int N_PHASES = 13;

constexpr size_t MiB = 1u << 20;
constexpr size_t WS_CTL = 0, CTL_ZERO_BYTES = 2 * MiB;
constexpr size_t WS_WG = 2 * MiB, WS_WQ = 4 * MiB, WS_WKV = 8 * MiB, WS_WO = 16 * MiB, WS_MEMN = 20 * MiB;
constexpr size_t WS_WOUT = 38 * MiB, WS_WIN = 70 * MiB, WS_WUP1 = 150 * MiB, WS_WDN1 = 322 * MiB, WS_WUP2 = 408 * MiB, WS_WDN2 = 580 * MiB;
constexpr size_t WS_XN = 666 * MiB, WS_YA = WS_XN, WS_HF = WS_XN + 96 * MiB;
constexpr size_t WS_Y = 858 * MiB, WS_HB = 1050 * MiB, WS_PROJ = WS_HB, WS_XQ = WS_HB, WS_XO = WS_HB + 24 * MiB, WS_KVM = WS_HB + 48 * MiB;
constexpr size_t WS_HBK = 1566 * MiB, WS_END = 1662 * MiB;
static_assert(WS_WUP1 + (size_t)NUP * D * 2 <= WS_WDN1 && WS_WDN1 + (size_t)D * DFF * 2 <= WS_WUP2 && WS_WUP2 + (size_t)NUP * D * 2 <= WS_WDN2 && WS_WDN2 + (size_t)D * DFF * 2 <= WS_XN, "ws map (ffn weights)");
static_assert(WS_XN + (size_t)MTOK * D * 2 <= WS_Y && WS_Y + (size_t)MTOK * D * 2 <= WS_HB && WS_HB + (size_t)MTOK * DFF * 2 <= WS_HBK && WS_HBK + (size_t)MTOK * LW * 2 <= WS_END, "ws map (activations)");
static_assert(WS_MEMN + (size_t)NMEM * D * 2 <= WS_WOUT && WS_WOUT + (size_t)D * D * 2 <= WS_WIN && WS_WIN + (size_t)NIN * D * 2 <= WS_WUP1, "ws map (small)");
constexpr int CW_NACTR = 64;
constexpr int CW_CONVCTR = 256;
constexpr int CW_BAR = 4096;
constexpr int CW_SS = 16384;
static_assert((CW_SS + 6 * MTOK * 2) * 4 <= (int)CTL_ZERO_BYTES, "CTL words inside the memset region");

constexpr int RING_OFF = 0, RING_BYTES = 131072;
constexpr int LDSCTL_OFF = RING_BYTES, MISC_OFF = LDSCTL_OFF + 320;
constexpr int LDS_BYTES = 147456;
constexpr int XBPTR_LDS_OFF = RING_BYTES + 320 + 80;
constexpr int NA_BIAS_OFF = RING_BYTES + 1024;

#define GAS __attribute__((address_space(1)))
#define LAS __attribute__((address_space(3)))
typedef unsigned short bf16;
typedef unsigned v4u __attribute__((ext_vector_type(4)));
typedef unsigned v2u __attribute__((ext_vector_type(2)));
typedef float f32x4 __attribute__((ext_vector_type(4)));
typedef GAS unsigned gu32;
#define LDS_WAIT() asm volatile("s_waitcnt lgkmcnt(0)" ::: "memory")
#define VM_WAIT() asm volatile("s_waitcnt vmcnt(0)" ::: "memory")
__device__ __forceinline__ unsigned f2bf(float f) { unsigned u = __builtin_bit_cast(unsigned, f); return (u + 0x7fffu + ((u >> 16) & 1u)) >> 16; }
__device__ __forceinline__ unsigned pk2(float lo, float hi) { return f2bf(lo) | (f2bf(hi) << 16); }
__device__ __forceinline__ float bflo(unsigned w) { return __uint_as_float(w << 16); }
__device__ __forceinline__ float bfhi(unsigned w) { return __uint_as_float(w & 0xffff0000u); }
__device__ __forceinline__ float bf2f(bf16 b) { return __uint_as_float(((unsigned)b) << 16); }
__device__ __forceinline__ float wave_sum(float v) {
#pragma unroll
    for (int o = 1; o < 64; o <<= 1) v += __shfl_xor(v, o);
    return v;
}
__device__ __forceinline__ void unpack8(const v4u w, float (&f)[8]) { f[0] = bflo(w.x); f[1] = bfhi(w.x); f[2] = bflo(w.y); f[3] = bfhi(w.y); f[4] = bflo(w.z); f[5] = bfhi(w.z); f[6] = bflo(w.w); f[7] = bfhi(w.w); }

namespace pg8 {
typedef unsigned long long ssq_t;
__device__ __forceinline__ float ss_get(const ssq_t* p) { const ssq_t v = *p; return ((float)(unsigned)(v >> 32) * 4294967296.0f + (float)(unsigned)v) * (1.0f / 65536.0f); }
__device__ __forceinline__ ssq_t ss_fix(float s) { return (ssq_t)(s * 65536.0f); }
__device__ __forceinline__ float ss_val(ssq_t v) { return ((float)(unsigned)(v >> 32) * 4294967296.0f + (float)(unsigned)v) * (1.0f / 65536.0f); }
struct EpiSwiGLU {
    static constexpr bool PERM = true, AFTER_DRAIN = false; static constexpr int NVM_MIN = 8;
    bf16_t* H; const ssq_t* ss; int pn8; float rsc; char* H8;
    __device__ __forceinline__ void operator()(const f32x4 (&acc)[2][2][4][2], const Unit& u, int wr, int wc, int fr, int fq) const {
        const int row0 = u.pm * BM + wr * 64 + fr, col0 = u.pn * HALF + wc * 32 + 8 * fq;
        ssq_t sv[2][4];
#pragma unroll
        for (int ai = 0; ai < 2; ++ai)
#pragma unroll
            for (int m = 0; m < 4; ++m) sv[ai][m] = ss[row0 + ai * HALF + m * 16];
#pragma unroll
        for (int ai = 0; ai < 2; ++ai)
#pragma unroll
            for (int m = 0; m < 4; ++m) { const int row = row0 + ai * HALF + m * 16; const float rs = rsqrtf(ss_val(sv[ai][m]) * (1.0f / 4096.0f) + 1e-6f) * rsc;
                float hv[8]; const float nlr = -1.4426950408889634f * rs, rs2 = rs * rs;
#pragma unroll
                for (int n = 0; n < 2; ++n)
#pragma unroll
                    for (int j = 0; j < 4; j += 2) { const f32x2 a2 = {acc[ai][0][m][n][j], acc[ai][0][m][n][j + 1]}, b2 = {acc[ai][1][m][n][j], acc[ai][1][m][n][j + 1]};
                        const f32x2 t = a2 * nlr; f32x2 e; e.x = __builtin_amdgcn_exp2f(t.x); e.y = __builtin_amdgcn_exp2f(t.y);
                        const f32x2 d = e + 1.0f; f32x2 s; s.x = __builtin_amdgcn_rcpf(d.x); s.y = __builtin_amdgcn_rcpf(d.y);
                        const f32x2 r = (a2 * b2) * (s * rs2); hv[4 * n + j] = r.x; hv[4 * n + j + 1] = r.y; }
                if (u.pn >= pn8) { int w0 = 0, w1 = 0; w0 = __builtin_amdgcn_cvt_pk_fp8_f32(hv[0], hv[1], w0, false); w0 = __builtin_amdgcn_cvt_pk_fp8_f32(hv[2], hv[3], w0, true);
                    w1 = __builtin_amdgcn_cvt_pk_fp8_f32(hv[4], hv[5], w1, false); w1 = __builtin_amdgcn_cvt_pk_fp8_f32(hv[6], hv[7], w1, true);
                    typedef int i32x2v __attribute__((ext_vector_type(2))); *(i32x2v*)(H8 + blk8_off(row, col0 - pn8 * HALF, 86 - pn8)) = (i32x2v){w0, w1}; }
                else { u32x4 w; w.x = cvt_pk_bf16(hv[0], hv[1]); w.y = cvt_pk_bf16(hv[2], hv[3]); w.z = cvt_pk_bf16(hv[4], hv[5]); w.w = cvt_pk_bf16(hv[6], hv[7]);
                    *(u32x4*)((char*)H + blk_off(row, col0, 172)) = w; } }
    }
};
struct EpiNull {
    static constexpr bool PERM = true, AFTER_DRAIN = false; static constexpr int NVM_MIN = 0;
    __device__ __forceinline__ void operator()(const f32x4 (&acc)[2][2][4][2], const Unit&, int, int, int, int) const {
#pragma unroll
        for (int a = 0; a < 2; ++a)
#pragma unroll
            for (int b = 0; b < 2; ++b)
#pragma unroll
                for (int m = 0; m < 4; ++m)
#pragma unroll
                    for (int n = 0; n < 2; ++n) asm volatile("" :: "v"(acc[a][b][m][n])); }
};
template <class E_> struct EpiTwice {
    static constexpr bool PERM = E_::PERM, AFTER_DRAIN = false; static constexpr int NVM_MIN = E_::NVM_MIN; E_ e;
    __device__ __forceinline__ void operator()(const f32x4 (&acc)[2][2][4][2], const Unit& u, int wr, int wc, int fr, int fq) const { e(acc, u, wr, wc, fr, fq); asm volatile("" ::: "memory"); e(acc, u, wr, wc, fr, fq); }
};
struct EpiResid {
    static constexpr bool PERM = true, AFTER_DRAIN = false; static constexpr int NVM_MIN = 16;
    bf16_t* xb; ssq_t* ssout; char* x8; float alpha;
    __device__ __forceinline__ void operator()(const f32x4 (&acc)[2][2][4][2], const Unit& u, int wr, int wc, int fr, int fq) const {
        const int row0 = u.pm * BM + wr * 64 + fr, col0 = u.pn * BM + wc * 32 + 8 * fq;
        bf16_t* xb = this->xb;
        if (!xb) {
            const unsigned lo_ = __builtin_amdgcn_readfirstlane(*(volatile PG8_LAS unsigned*)(PG8_LAS unsigned char*)(uintptr_t)XBPTR_LDS_OFF), hi_ = __builtin_amdgcn_readfirstlane(*(volatile PG8_LAS unsigned*)(PG8_LAS unsigned char*)(uintptr_t)(XBPTR_LDS_OFF + 4));
            xb = (bf16_t*)(((unsigned long long)hi_ << 32) | lo_); }
        u32x4 xv[2][4][2];
#pragma unroll
        for (int ai = 0; ai < 2; ++ai)
#pragma unroll
            for (int m = 0; m < 4; ++m)
#pragma unroll
                for (int bj = 0; bj < 2; ++bj) { unsigned long long o_ = blk_off(row0 + ai * HALF + m * 16, col0 + bj * HALF, 64); asm volatile("" : "+v"(o_)); xv[ai][m][bj] = *(const u32x4*)((const char*)xb + o_); }
#pragma unroll
        for (int ai = 0; ai < 2; ++ai)
#pragma unroll
            for (int m = 0; m < 4; ++m) { const int row = row0 + ai * HALF + m * 16; float sq = 0.f;
#pragma unroll
                for (int bj = 0; bj < 2; ++bj) { unsigned long long o_ = blk_off(row, col0 + bj * HALF, 64); asm volatile("" : "+v"(o_));
                    u32x4* p = (u32x4*)((char*)xb + o_); const u32x4 xi = xv[ai][m][bj];
                    const f32x4 a0 = acc[ai][bj][m][0] * alpha, a1 = acc[ai][bj][m][1] * alpha;
                    const float v0 = __uint_as_float(xi.x << 16) + a0[0], v1 = __uint_as_float(xi.x & 0xffff0000u) + a0[1], v2 = __uint_as_float(xi.y << 16) + a0[2], v3 = __uint_as_float(xi.y & 0xffff0000u) + a0[3];
                    const float v4 = __uint_as_float(xi.z << 16) + a1[0], v5 = __uint_as_float(xi.z & 0xffff0000u) + a1[1], v6 = __uint_as_float(xi.w << 16) + a1[2], v7 = __uint_as_float(xi.w & 0xffff0000u) + a1[3];
                    sq += ((v0 * v0 + v1 * v1) + (v2 * v2 + v3 * v3)) + ((v4 * v4 + v5 * v5) + (v6 * v6 + v7 * v7));
                    u32x4 w; w.x = cvt_pk_bf16(v0, v1); w.y = cvt_pk_bf16(v2, v3); w.z = cvt_pk_bf16(v4, v5); w.w = cvt_pk_bf16(v6, v7); *p = w;
                    if (x8) { int w0 = 0, w1 = 0; w0 = __builtin_amdgcn_cvt_pk_fp8_f32(v0, v1, w0, false); w0 = __builtin_amdgcn_cvt_pk_fp8_f32(v2, v3, w0, true); w1 = __builtin_amdgcn_cvt_pk_fp8_f32(v4, v5, w1, false); w1 = __builtin_amdgcn_cvt_pk_fp8_f32(v6, v7, w1, true);
                        typedef int i32x2v __attribute__((ext_vector_type(2))); *(i32x2v*)(x8 + blk8_off(row, col0 + bj * HALF, 32)) = (i32x2v){w0, w1}; } }
                { const int la_ = (fq * 16 + fr) << 2;
                  sq += __builtin_bit_cast(float, __builtin_amdgcn_ds_bpermute(la_ ^ 64, __builtin_bit_cast(int, sq))); sq += __builtin_bit_cast(float, __builtin_amdgcn_ds_bpermute(la_ ^ 128, __builtin_bit_cast(int, sq))); }
                if (fq == 0 && ssout) atomicAdd(ssout + row, ss_fix(sq)); }
    }
};
struct EpiScaleBf16 {
    static constexpr bool PERM = true, AFTER_DRAIN = false; static constexpr int NVM_MIN = 16;
    bf16_t* O; int ldc; const ssq_t* ss; float qscale; int qcols;
    __device__ __forceinline__ void operator()(const f32x4 (&acc)[2][2][4][2], const Unit& u, int wr, int wc, int fr, int fq) const {
        const int row0 = u.pm * BM + wr * 64 + fr, col0 = u.pn * BM + wc * 32 + 8 * fq;
        const float sc = (u.pn * BM < qcols) ? qscale : 1.0f;
        ssq_t sv[2][4];
#pragma unroll
        for (int ai = 0; ai < 2; ++ai)
#pragma unroll
            for (int m = 0; m < 4; ++m) sv[ai][m] = ss ? ss[row0 + ai * HALF + m * 16] : 0ull;
#pragma unroll
        for (int ai = 0; ai < 2; ++ai)
#pragma unroll
            for (int m = 0; m < 4; ++m) { const int row = row0 + ai * HALF + m * 16; const float rs = (ss ? rsqrtf(ss_val(sv[ai][m]) * (1.0f / 4096.0f) + 1e-6f) : 1.0f) * sc;
                bf16_t* rowp = O + (size_t)row * ldc + col0;
#pragma unroll
                for (int bj = 0; bj < 2; ++bj) { const f32x4 v0 = acc[ai][bj][m][0] * rs, v1 = acc[ai][bj][m][1] * rs;
                    u32x4 w; w.x = cvt_pk_bf16(v0[0], v0[1]); w.y = cvt_pk_bf16(v0[2], v0[3]); w.z = cvt_pk_bf16(v1[0], v1[1]); w.w = cvt_pk_bf16(v1[2], v1[3]);
                    *(u32x4*)(rowp + bj * HALF) = w; } }
    }
};
struct EpiProj {
    static constexpr bool PERM = true, AFTER_DRAIN = false; static constexpr int NVM_MIN = 16;
    bf16_t* QKVH; bf16_t* UG; const ssq_t* ss; float qscale;
    __device__ __forceinline__ void operator()(const f32x4 (&acc)[2][2][4][2], const Unit& u, int wr, int wc, int fr, int fq) const {
        const int row0 = u.pm * BM + wr * 64 + fr, dimoff = wc * 32 + 8 * fq;
        const int kind = u.pn >> 3; const float sc = (kind == 0) ? qscale : 1.0f;
        ssq_t sv[2][4];
#pragma unroll
        for (int ai = 0; ai < 2; ++ai)
#pragma unroll
            for (int m = 0; m < 4; ++m) sv[ai][m] = ss[row0 + ai * HALF + m * 16];
#pragma unroll
        for (int ai = 0; ai < 2; ++ai)
#pragma unroll
            for (int m = 0; m < 4; ++m) { const int row = row0 + ai * HALF + m * 16; const float rs = rsqrtf(ss_val(sv[ai][m]) * (1.0f / 4096.0f) + 1e-6f) * sc;
#pragma unroll
                for (int bj = 0; bj < 2; ++bj) { const f32x4 v0 = acc[ai][bj][m][0] * rs, v1 = acc[ai][bj][m][1] * rs;
                    u32x4 w; w.x = cvt_pk_bf16(v0[0], v0[1]); w.y = cvt_pk_bf16(v0[2], v0[3]); w.z = cvt_pk_bf16(v1[0], v1[1]); w.w = cvt_pk_bf16(v1[2], v1[3]);
                    bf16_t* p = (u.pn < 24) ? QKVH + ((size_t)(kind * 16 + 2 * (u.pn & 7) + bj) * 24576 + row) * 128 + dimoff
                                            : UG + (size_t)row * 4096 + (u.pn - 24) * 256 + bj * HALF + dimoff;
                    *(u32x4*)p = w; } }
    }
};
}

__device__ __forceinline__ void transpose_item(const float* W, int K, int N, bf16* WTd, int k0, int n0, LAS float* scr, int lane) {
#pragma unroll 8
    for (int i = 0; i < 32; ++i) { const int kk = 2 * i + (lane >> 5); scr[kk * 33 + (lane & 31)] = W[(size_t)(k0 + kk) * N + n0 + (lane & 31)]; }
    LDS_WAIT(); asm volatile("" ::: "memory");
    const int c = lane & 7;
#pragma unroll
    for (int j = 0; j < 4; ++j) { const int n = (lane >> 3) + 8 * j; const LAS float* s = scr + (8 * c) * 33 + n;
        v4u o; o.x = pk2(s[0 * 33], s[1 * 33]); o.y = pk2(s[2 * 33], s[3 * 33]); o.z = pk2(s[4 * 33], s[5 * 33]); o.w = pk2(s[6 * 33], s[7 * 33]);
        *(GAS v4u*)(WTd + (size_t)n * K + k0 + 8 * c) = o; }
    LDS_WAIT(); asm volatile("" ::: "memory");
}
__device__ __forceinline__ void transpose_item_blk(const float* W, int K, int N, char* tkb, int k0, int n0, int r0, bool perm, const float* gk, LAS float* scr, int lane) {
    f32x4 v[8];
#pragma unroll
    for (int i = 0; i < 8; ++i) v[i] = *(const f32x4*)(W + (size_t)(k0 + (lane >> 3) + 8 * i) * N + n0 + (lane & 7) * 4);
#pragma unroll
    for (int i = 0; i < 8; ++i) { LAS float* d = scr + ((lane >> 3) + 8 * i) * 33 + (lane & 7) * 4; d[0] = v[i][0]; d[1] = v[i][1]; d[2] = v[i][2]; d[3] = v[i][3]; }
    const int c = lane & 7;
    f32x4 g0 = {1.f, 1.f, 1.f, 1.f}, g1 = {1.f, 1.f, 1.f, 1.f};
    if (gk) { g0 = *(const f32x4*)(gk + k0 + 8 * c); g1 = *(const f32x4*)(gk + k0 + 8 * c + 4); }
    LDS_WAIT(); asm volatile("" ::: "memory");
#pragma unroll
    for (int j = 0; j < 4; ++j) { const int n = (lane >> 3) + 8 * j; const LAS float* s = scr + (8 * c) * 33 + n;
        v4u o; o.x = pk2(s[0 * 33] * g0[0], s[1 * 33] * g0[1]); o.y = pk2(s[2 * 33] * g0[2], s[3 * 33] * g0[3]); o.z = pk2(s[4 * 33] * g1[0], s[5 * 33] * g1[1]); o.w = pk2(s[6 * 33] * g1[2], s[7 * 33] * g1[3]);
        const int rt = r0 + (perm ? pg8::perm32inv(n) : n);
        *(GAS v4u*)(tkb + ((rt >> 7) << 14) + pg8::lds_byte(rt & 127, 8 * c)) = o; }
    LDS_WAIT(); asm volatile("" ::: "memory");
}
__device__ __forceinline__ void transpose_item_f8(const float* W, int K, int N, char* tkb, int k0, int n0, int r0, bool perm, float scale, const float* gk, LAS float* scr, int lane) {
    f32x4 v[8];
#pragma unroll
    for (int i = 0; i < 8; ++i) v[i] = *(const f32x4*)(W + (size_t)(k0 + (lane >> 3) + 8 * i) * N + n0 + (lane & 7) * 4);
#pragma unroll
    for (int i = 0; i < 8; ++i) { LAS float* d = scr + ((lane >> 3) + 8 * i) * 33 + (lane & 7) * 4; d[0] = v[i][0]; d[1] = v[i][1]; d[2] = v[i][2]; d[3] = v[i][3]; }
    LDS_WAIT(); asm volatile("" ::: "memory");
    const int n = lane & 31, rt = r0 + (perm ? pg8::perm32inv(n) : n), r = rt & 127;
#pragma unroll
    for (int e = 0; e < 2; ++e) { const int c = (lane >> 5) + 2 * e; const LAS float* s = scr + (16 * c) * 33 + n; int w[4];
#pragma unroll
        for (int q = 0; q < 4; ++q) { f32x4 gq = {scale, scale, scale, scale}; if (gk) gq = *(const f32x4*)(gk + k0 + 16 * c + 4 * q) * scale;
            int t = 0; t = __builtin_amdgcn_cvt_pk_fp8_f32(s[(4 * q) * 33] * gq[0], s[(4 * q + 1) * 33] * gq[1], t, false); t = __builtin_amdgcn_cvt_pk_fp8_f32(s[(4 * q + 2) * 33] * gq[2], s[(4 * q + 3) * 33] * gq[3], t, true); w[q] = t; }
        const int c8 = ((k0 & 127) >> 4) + c;
        *(GAS v4u*)(tkb + ((rt >> 7) << 14) + (r >> 4) * 2048 + (c8 & 1) * 1024 + ((c8 >> 1) * 16 + (r & 15)) * 16) = (v4u){(unsigned)w[0], (unsigned)w[1], (unsigned)w[2], (unsigned)w[3]}; }
    LDS_WAIT(); asm volatile("" ::: "memory");
}
__device__ __forceinline__ void transpose_matrix(const float* W, int K, int N, bf16* WT, int row_off, bool perm, const float* gk, LAS float* scr, int lane, int gw, int NGW) {
    const int nblk = N / 32, nkt = K / 64, nitems = nkt * nblk;
    for (int it = gw; it < nitems; it += NGW) { const int kb = it / nblk, nb = it % nblk, drow = row_off + 32 * nb;
        transpose_item_blk(W, K, N, (char*)WT + ((size_t)((drow >> 8) * nkt + kb) << 15), 64 * kb, 32 * nb, drow & 255, perm, gk, scr, lane); }
}
__device__ __forceinline__ void transpose_up(const float* W1, const float* W3, bf16* WT, const float* gk, LAS float* scr, int lane, int gw, int NGW) {
    const int nblk = DFF / 32, nkt = D / 64, per = nkt * nblk;
    for (int it = gw; it < 2 * per; it += NGW) { const int which = it >= per, r = which ? it - per : it; const int kb = r / nblk, nb = r % nblk, n0 = 32 * nb;
        transpose_item_blk(which ? W3 : W1, D, DFF, (char*)WT + ((size_t)((n0 >> 7) * nkt + kb) << 15), 64 * kb, n0, (n0 & 127) + (which ? 128 : 0), true, gk, scr, lane); }
}

__device__ __forceinline__ float gelu_tanh(float x) { return 0.5f * x * (1.0f + tanhf(0.7978845608028654f * (x + 0.044715f * x * x * x))); }


typedef short bf16x8s __attribute__((ext_vector_type(8)));
typedef short s16x4 __attribute__((ext_vector_type(4)));
__device__ __forceinline__ s16x4 tr_read16(unsigned addr) { s16x4 r; asm volatile("ds_read_b64_tr_b16 %0, %1" : "=&v"(r) : "v"(addr) : "memory"); return r; }
template <bool IS_NA>
__device__ __forceinline__ void attn_task(const bf16* qp, const bf16* kbase, const bf16* vbase, size_t stride, int irows, const float* brow0, int c, int cs, int c0,
                                          bf16* op, int orow, int ocol, LAS unsigned char* wl, int lane) {
    const int fr = lane & 15, fq = lane >> 4;
    bf16x8s qf[4];
#pragma unroll
    for (int ks = 0; ks < 4; ++ks) qf[ks] = *(const bf16x8s*)(qp + 32 * ks);
    f32x4 S[8][2];
    bf16x8s kr[3][2][4];
#define AT_LOADK(slot, i) do { _Pragma("unroll") for (int hh = 0; hh < 2; ++hh) _Pragma("unroll") for (int ks = 0; ks < 4; ++ks) \
        kr[slot][hh][ks] = *(const bf16x8s*)(kbase + (size_t)((i) * irows + 4 * hh) * stride + 32 * ks); } while (0)
#define AT_SCORE(slot, i) do { _Pragma("unroll") for (int hh = 0; hh < 2; ++hh) { f32x4 a_ = {0.f, 0.f, 0.f, 0.f}; \
        _Pragma("unroll") for (int ks = 0; ks < 4; ++ks) a_ = __builtin_amdgcn_mfma_f32_16x16x32_bf16(kr[slot][hh][ks], qf[ks], a_, 0, 0, 0); S[i][hh] = a_; } } while (0)
    v4u vr[3][8];
#define AT_LOADV(slot, i) do { _Pragma("unroll") for (int inst = 0; inst < 8; ++inst) vr[slot][inst] = *(const v4u*)(vbase + (size_t)((i) * irows + 4 * inst) * stride); } while (0)
    AT_LOADK(0, 0); AT_LOADK(1, 1); AT_LOADK(2, 2);
    __builtin_amdgcn_sched_barrier(0);
#pragma unroll
    for (int i = 0; i < 8; ++i) {
        AT_SCORE(i % 3, i); __builtin_amdgcn_sched_barrier(0);
        if (i + 3 < 8) { AT_LOADK(i % 3, i + 3); } else { AT_LOADV(i - 5, i - 5); }
        __builtin_amdgcn_sched_barrier(0);
    }
#undef AT_LOADK
#undef AT_SCORE
    float mx = -1e30f;
#pragma unroll
    for (int hh = 0; hh < 2; ++hh)
#pragma unroll
        for (int j = 0; j < 4; ++j) {
            bool ok = true; int bi = 0;
            if (IS_NA) { const int kc = c0 + 8 * fq + 4 * hh + j; ok = (kc >= cs) && (kc < cs + 16); bi = min(max(kc - c + 15, 0), 30); }
#pragma unroll
            for (int i = 0; i < 8; ++i) { float s = S[i][hh][j]; if (IS_NA) { s = ok ? s + brow0[i * 31 + bi] : -1e30f; S[i][hh][j] = s; } mx = fmaxf(mx, s); } }
    mx = fmaxf(mx, __shfl_xor(mx, 16)); mx = fmaxf(mx, __shfl_xor(mx, 32));
    float l = 0.f;
    v4u pw[8];
#pragma unroll
    for (int i = 0; i < 8; ++i) {
#pragma unroll
        for (int hh = 0; hh < 2; ++hh)
#pragma unroll
            for (int j = 0; j < 4; ++j) { const float p = __builtin_amdgcn_exp2f((S[i][hh][j] - mx) * 1.4426950408889634f); S[i][hh][j] = p; l += p; }
        pw[i].x = pg8::cvt_pk_bf16(S[i][0][0], S[i][0][1]); pw[i].y = pg8::cvt_pk_bf16(S[i][0][2], S[i][0][3]); pw[i].z = pg8::cvt_pk_bf16(S[i][1][0], S[i][1][1]); pw[i].w = pg8::cvt_pk_bf16(S[i][1][2], S[i][1][3]); }
    l += __shfl_xor(l, 16); l += __shfl_xor(l, 32);
    const int rho0 = lane >> 4, ch = lane & 15, q_ = (lane & 15) >> 2, p_ = lane & 3;
    const unsigned wbase = (unsigned)(uintptr_t)wl;
    unsigned rrow[2], rf[2];
#pragma unroll
    for (int h2 = 0; h2 < 2; ++h2) { const int row = 8 * fq + 4 * h2 + q_; rrow[h2] = wbase + 256u * row + 8u * (p_ & 1); rf[h2] = (unsigned)((q_ << 2) | ((2 * fq + h2) & 3)); }
    f32x4 O[8];
#pragma unroll
    for (int dt = 0; dt < 8; ++dt) O[dt] = (f32x4){0.f, 0.f, 0.f, 0.f};
#pragma unroll
    for (int i = 0; i < 8; ++i) {
#pragma unroll
        for (int inst = 0; inst < 8; ++inst) { const int rho = rho0 + 4 * inst; const int f = (rho0 << 2) | (inst & 3); *(LAS v4u*)(wl + 256 * rho + 16 * (ch ^ f)) = vr[i % 3][inst]; }
        if (i + 3 < 8) { AT_LOADV(i % 3, i + 3); }
        const bf16x8s pf = __builtin_bit_cast(bf16x8s, pw[i]);
        s16x4 lo[8], hi[8];
#pragma unroll
        for (int dt = 0; dt < 8; ++dt) { lo[dt] = tr_read16(rrow[0] + 16u * ((unsigned)(2 * dt + (p_ >> 1)) ^ rf[0])); hi[dt] = tr_read16(rrow[1] + 16u * ((unsigned)(2 * dt + (p_ >> 1)) ^ rf[1])); }
        asm volatile("s_waitcnt lgkmcnt(0)" ::: "memory"); __builtin_amdgcn_sched_barrier(0);
#pragma unroll
        for (int dt = 0; dt < 8; ++dt) { const bf16x8s vf = (bf16x8s){lo[dt][0], lo[dt][1], lo[dt][2], lo[dt][3], hi[dt][0], hi[dt][1], hi[dt][2], hi[dt][3]};
            O[dt] = __builtin_amdgcn_mfma_f32_16x16x32_bf16(vf, pf, O[dt], 0, 0, 0); }
    }
#undef AT_LOADV
    const float inv = 1.0f / l;
#pragma unroll
    for (int dt = 0; dt < 8; ++dt) { const f32x4 v = O[dt] * inv; v2u o; o.x = pg8::cvt_pk_bf16(v[0], v[1]); o.y = pg8::cvt_pk_bf16(v[2], v[3]);
        if (IS_NA) *(v2u*)(op + dt * 16) = o; else *(v2u*)((char*)op + pg8::blk_off(orow, ocol + dt * 16, 8)) = o; }
}
__device__ __forceinline__ void na_block_task(int t, const bf16* PROJ, const float* rpb, bf16* YA, LAS unsigned char* lds, int wave, int lane, int dup = 0) {
    const int hp = t / 384, R = t % 384, g = wave & 3, h = 2 * hp + (dup ? 0 : (wave >> 2));
    int r, rows, seq0; if (R < 256) { seq0 = (R >> 5) * 2048; r = R & 31; rows = 32; } else { seq0 = MP; r = R - 256; rows = 128; }
    const int fr = lane & 15, fq = lane >> 4;
    const int rst = min(max(r - 4, 0), rows - 8), c0 = min(max(16 * g - 8, 0), 32), c = 16 * g + fr, cs = min(max(c - 8, 0), 48);
    const size_t m = (size_t)R * 64 + c;
    const bf16* qp = PROJ + ((size_t)h * MTOK + m) * 128 + 8 * fq;
    const bf16* kbase = PROJ + ((size_t)(16 + h) * MTOK + seq0 + rst * 64 + c0 + 8 * (fr >> 2) + (fr & 3)) * 128 + 8 * fq;
    const bf16* vbase = PROJ + ((size_t)(32 + h) * MTOK + seq0 + rst * 64 + c0 + (lane >> 4)) * 128 + (lane & 15) * 8;
    const float* brow0 = rpb + (h * 15 + (rst - r + 7)) * 31;
    attn_task<true>(qp, kbase, vbase, (size_t)128, 64, brow0, c, cs, c0, YA + m * AW + h * 128 + 4 * fq, 0, 0, lds + RING_OFF + wave * 8192, lane);
}
__device__ __forceinline__ void wait_vmcnt_n(int n) {
    switch (n) { case 0: asm volatile("s_waitcnt vmcnt(0)" ::: "memory"); break; case 2: asm volatile("s_waitcnt vmcnt(2)" ::: "memory"); break; case 4: asm volatile("s_waitcnt vmcnt(4)" ::: "memory"); break;
                 case 6: asm volatile("s_waitcnt vmcnt(6)" ::: "memory"); break; case 8: asm volatile("s_waitcnt vmcnt(8)" ::: "memory"); break; case 10: asm volatile("s_waitcnt vmcnt(10)" ::: "memory"); break;
                 case 12: asm volatile("s_waitcnt vmcnt(12)" ::: "memory"); break; default: asm volatile("s_waitcnt vmcnt(0)" ::: "memory"); break; } }
template <int OFF>
__device__ __forceinline__ void na_coop_body(const bf16* kg, const bf16* vg, int nU, const bf16* qp, const LAS float* brow0, int c, int cs, int c0, bf16* op, LAS unsigned char* lds, int wave, int lane) {
    constexpr int NR = 8;
    const int fr = lane & 15, fq = lane >> 4;
    bf16x8s qf[4];
#pragma unroll
    for (int ks = 0; ks < 4; ++ks) qf[ks] = *(const bf16x8s*)(qp + 32 * ks);
    unsigned goff[2];
#pragma unroll
    for (int e = 0; e < 2; ++e) { const int key = wave * 8 + e * 4 + (lane >> 4), chp = lane & 15, f = ((key & 3) << 2) | ((key >> 2) & 3); goff[e] = (unsigned)((key * 128 + (chp ^ f) * 8) * 2); }
#define NC_ISSUE(it) do { const int j_ = ((it) % 9) < nU ? ((it) % 9) : nU - 1; const bf16* b_ = ((it) < 9 ? kg : vg) + (size_t)j_ * 64 * 128; \
        _Pragma("unroll") for (int e_ = 0; e_ < 2; ++e_) __builtin_amdgcn_global_load_lds((const unsigned*)((const char*)b_ + goff[e_]), (LAS unsigned*)(lds + ((it) % NR) * 16384 + wave * 2048 + e_ * 1024), 16, 0, 0); } while (0)
#define NC_NWAIT(it) (2 * (((it) + NR - 2 < 17 ? (it) + NR - 2 : 17) - (it)))
#pragma unroll
    for (int s_ = 0; s_ < NR - 1; ++s_) { NC_ISSUE(s_); }
    unsigned kro[2], krf[2];
#pragma unroll
    for (int hh = 0; hh < 2; ++hh) { const int key = c0 + 8 * (fr >> 2) + 4 * hh + (fr & 3); kro[hh] = (unsigned)(256 * key); krf[hh] = (unsigned)(((key & 3) << 2) | ((key >> 2) & 3)); }
    f32x4 S[8][2];
#pragma unroll
    for (int it = 0; it < 9; ++it) {
        unsigned rb_ = (unsigned)((it % NR) * 16384); asm volatile("" : "+s"(rb_));
        LAS unsigned char* buf = lds + rb_;
        wait_vmcnt_n(NC_NWAIT(it)); __builtin_amdgcn_s_barrier(); asm volatile("" ::: "memory");
        NC_ISSUE(it + NR - 1);
        if (it - OFF >= 0 && it - OFF < 8) {
#pragma unroll
            for (int hh = 0; hh < 2; ++hh) { f32x4 a_ = {0.f, 0.f, 0.f, 0.f};
#pragma unroll
                for (int ks = 0; ks < 4; ++ks) { const bf16x8s kf = *(const LAS bf16x8s*)(buf + kro[hh] + 16u * ((unsigned)(4 * ks + fq) ^ krf[hh]));
                    a_ = __builtin_amdgcn_mfma_f32_16x16x32_bf16(kf, qf[ks], a_, 0, 0, 0); }
                S[it - OFF][hh] = a_; } }
    }
    float mx = -1e30f;
#pragma unroll
    for (int hh = 0; hh < 2; ++hh)
#pragma unroll
        for (int j = 0; j < 4; ++j) { const int kc = c0 + 8 * fq + 4 * hh + j; const bool ok = (kc >= cs) && (kc < cs + 16); const int bi = min(max(kc - c + 15, 0), 30);
#pragma unroll
            for (int i = 0; i < 8; ++i) { float s = S[i][hh][j]; s = ok ? s + brow0[i * 31 + bi] : -1e30f; S[i][hh][j] = s; mx = fmaxf(mx, s); } }
    mx = fmaxf(mx, __shfl_xor(mx, 16)); mx = fmaxf(mx, __shfl_xor(mx, 32));
    float l = 0.f; v4u pw[8];
#pragma unroll
    for (int i = 0; i < 8; ++i) {
#pragma unroll
        for (int hh = 0; hh < 2; ++hh)
#pragma unroll
            for (int j = 0; j < 4; ++j) { const float p = __builtin_amdgcn_exp2f((S[i][hh][j] - mx) * 1.4426950408889634f); S[i][hh][j] = p; l += p; }
        pw[i].x = pg8::cvt_pk_bf16(S[i][0][0], S[i][0][1]); pw[i].y = pg8::cvt_pk_bf16(S[i][0][2], S[i][0][3]); pw[i].z = pg8::cvt_pk_bf16(S[i][1][0], S[i][1][1]); pw[i].w = pg8::cvt_pk_bf16(S[i][1][2], S[i][1][3]); }
    l += __shfl_xor(l, 16); l += __shfl_xor(l, 32);
    const int q_ = (lane & 15) >> 2, p_ = lane & 3;
    unsigned vro[2], vrf[2];
#pragma unroll
    for (int h2 = 0; h2 < 2; ++h2) { const int key = c0 + 8 * fq + 4 * h2 + q_; vro[h2] = (unsigned)(256 * key + 8 * (p_ & 1)); vrf[h2] = (unsigned)(((key & 3) << 2) | ((key >> 2) & 3)); }
    f32x4 O[8];
#pragma unroll
    for (int dt = 0; dt < 8; ++dt) O[dt] = (f32x4){0.f, 0.f, 0.f, 0.f};
#pragma unroll
    for (int it = 9; it < 18; ++it) {
        unsigned rb_ = (unsigned)((it % NR) * 16384); asm volatile("" : "+s"(rb_));
        LAS unsigned char* buf = lds + rb_; const unsigned bufa = (unsigned)(uintptr_t)buf;
        wait_vmcnt_n(NC_NWAIT(it)); __builtin_amdgcn_s_barrier(); asm volatile("" ::: "memory");
        if (it + NR - 1 < 18) { NC_ISSUE(it + NR - 1); }
        if (it - 9 - OFF >= 0 && it - 9 - OFF < 8) {
            const bf16x8s pf = __builtin_bit_cast(bf16x8s, pw[it - 9 - OFF]);
            s16x4 lo[8], hi[8];
#pragma unroll
            for (int dt = 0; dt < 8; ++dt) { lo[dt] = tr_read16(bufa + vro[0] + 16u * ((unsigned)(2 * dt + (p_ >> 1)) ^ vrf[0])); hi[dt] = tr_read16(bufa + vro[1] + 16u * ((unsigned)(2 * dt + (p_ >> 1)) ^ vrf[1])); }
            asm volatile("s_waitcnt lgkmcnt(0)" ::: "memory"); __builtin_amdgcn_sched_barrier(0);
#pragma unroll
            for (int dt = 0; dt < 8; ++dt) { const bf16x8s vf = (bf16x8s){lo[dt][0], lo[dt][1], lo[dt][2], lo[dt][3], hi[dt][0], hi[dt][1], hi[dt][2], hi[dt][3]};
                O[dt] = __builtin_amdgcn_mfma_f32_16x16x32_bf16(vf, pf, O[dt], 0, 0, 0); } }
    }
#undef NC_ISSUE
#undef NC_NWAIT
    const float inv = 1.0f / l;
#pragma unroll
    for (int dt = 0; dt < 8; ++dt) { const f32x4 v = O[dt] * inv; v2u o; o.x = pg8::cvt_pk_bf16(v[0], v[1]); o.y = pg8::cvt_pk_bf16(v[2], v[3]); *(v2u*)(op + dt * 16) = o; }
}
__device__ __forceinline__ void na_coop_task(int t, const bf16* PROJ, const float* rpb, bf16* YA, LAS unsigned char* lds, int tid, int wave, int lane) {
    const int h = t / 192, rp = t % 192, R0 = 2 * rp, q = wave >> 2, g = wave & 3, R = R0 + q;
    int r0, rows, seq0; if (R0 < 256) { seq0 = (R0 >> 5) * 2048; r0 = R0 & 31; rows = 32; } else { seq0 = MP; r0 = R0 - 256; rows = 128; }
    const int fr = lane & 15, fq = lane >> 4;
    const int rstA = min(max(r0 - 4, 0), rows - 8), rstB = min(max(r0 + 1 - 4, 0), rows - 8), d = rstB - rstA, nU = 8 + d;
    const int r = r0 + q, rst = q ? rstB : rstA, off = q ? d : 0;
    const int c0 = min(max(16 * g - 8, 0), 32), c = 16 * g + fr, cs = min(max(c - 8, 0), 48);
    const size_t m = (size_t)R * 64 + c;
    const bf16* qp = PROJ + ((size_t)h * MTOK + m) * 128 + 8 * fq;
    const bf16* kg = PROJ + ((size_t)(16 + h) * MTOK + seq0 + rstA * 64) * 128;
    const bf16* vg = PROJ + ((size_t)(32 + h) * MTOK + seq0 + rstA * 64) * 128;
    LAS float* btab = (LAS float*)(lds + NA_BIAS_OFF);
    if (tid < 465) btab[tid] = rpb[h * 465 + tid];
    asm volatile("s_waitcnt lgkmcnt(0)" ::: "memory");
    const LAS float* brow0 = btab + (rst - r + 7) * 31;
    bf16* op = YA + m * AW + h * 128 + 4 * fq;
    if (off) na_coop_body<1>(kg, vg, nU, qp, brow0, c, cs, c0, op, lds + RING_OFF, wave, lane);
    else     na_coop_body<0>(kg, vg, nU, qp, brow0, c, cs, c0, op, lds + RING_OFF, wave, lane);
}
__device__ __forceinline__ void xa_coop_task(int t, const bf16* XQ, const bf16* KVM, bf16* XO, LAS unsigned char* lds, int tid, int wave, int lane) {
    const int h = t & 3, qb = t >> 2;
    const int s = (qb < 128) ? (qb >> 4) : 8;
    const int fr = lane & 15, fq = lane >> 4;
    const size_t m = (size_t)qb * 128 + wave * 16 + fr;
    const bf16* qp = XQ + m * XAW + h * 128 + 8 * fq;
    bf16x8s qf[4];
#pragma unroll
    for (int ks = 0; ks < 4; ++ks) qf[ks] = *(const bf16x8s*)(qp + 32 * ks);
    LAS unsigned char* kbuf = lds + RING_OFF; LAS unsigned char* vbuf = lds + RING_OFF + 65536;
    const bf16* kg = KVM + (size_t)(s * 256) * 1024 + h * 128;
    {
        v4u rg[8];
#pragma unroll
        for (int e = 0; e < 8; ++e) { const int cidx = tid + 512 * e, key = cidx >> 4, ch = cidx & 15; rg[e] = *(const v4u*)(kg + (size_t)key * 1024 + ch * 8); }
#pragma unroll
        for (int e = 0; e < 8; ++e) { const int cidx = tid + 512 * e, key = cidx >> 4, ch = cidx & 15, f = ((key & 3) << 2) | ((key >> 2) & 3); *(LAS v4u*)(kbuf + 256 * key + 16 * (ch ^ f)) = rg[e]; }
#pragma unroll
        for (int e = 0; e < 8; ++e) { const int cidx = tid + 512 * e, key = cidx >> 4, ch = cidx & 15; rg[e] = *(const v4u*)(kg + 512 + (size_t)key * 1024 + ch * 8); }
#pragma unroll
        for (int e = 0; e < 8; ++e) { const int cidx = tid + 512 * e, key = cidx >> 4, ch = cidx & 15, f = ((key & 3) << 2) | ((key >> 2) & 3); *(LAS v4u*)(vbuf + 256 * key + 16 * (ch ^ f)) = rg[e]; }
    }
    asm volatile("s_waitcnt lgkmcnt(0)" ::: "memory"); __builtin_amdgcn_s_barrier(); asm volatile("" ::: "memory");
    unsigned kro[2], krf[2];
#pragma unroll
    for (int hh = 0; hh < 2; ++hh) { const int key = 8 * (fr >> 2) + 4 * hh + (fr & 3); kro[hh] = (unsigned)(256 * key); krf[hh] = (unsigned)(((key & 3) << 2) | ((key >> 2) & 3)); }
    f32x4 S[8][2];
#pragma unroll
    for (int i = 0; i < 8; ++i) { unsigned ib = (unsigned)(i * 8192); asm volatile("" : "+s"(ib));
#pragma unroll
        for (int hh = 0; hh < 2; ++hh) { f32x4 a_ = {0.f, 0.f, 0.f, 0.f};
#pragma unroll
            for (int ks = 0; ks < 4; ++ks) { const bf16x8s kf = *(const LAS bf16x8s*)(kbuf + ib + kro[hh] + 16u * ((unsigned)(4 * ks + fq) ^ krf[hh]));
                a_ = __builtin_amdgcn_mfma_f32_16x16x32_bf16(kf, qf[ks], a_, 0, 0, 0); }
            S[i][hh] = a_; } }
    float mx = -1e30f;
#pragma unroll
    for (int i = 0; i < 8; ++i)
#pragma unroll
        for (int hh = 0; hh < 2; ++hh)
#pragma unroll
            for (int j = 0; j < 4; ++j) mx = fmaxf(mx, S[i][hh][j]);
    mx = fmaxf(mx, __shfl_xor(mx, 16)); mx = fmaxf(mx, __shfl_xor(mx, 32));
    float l = 0.f; v4u pw[8];
#pragma unroll
    for (int i = 0; i < 8; ++i) {
#pragma unroll
        for (int hh = 0; hh < 2; ++hh)
#pragma unroll
            for (int j = 0; j < 4; ++j) { const float p = __builtin_amdgcn_exp2f((S[i][hh][j] - mx) * 1.4426950408889634f); S[i][hh][j] = p; l += p; }
        pw[i].x = pg8::cvt_pk_bf16(S[i][0][0], S[i][0][1]); pw[i].y = pg8::cvt_pk_bf16(S[i][0][2], S[i][0][3]); pw[i].z = pg8::cvt_pk_bf16(S[i][1][0], S[i][1][1]); pw[i].w = pg8::cvt_pk_bf16(S[i][1][2], S[i][1][3]); }
    l += __shfl_xor(l, 16); l += __shfl_xor(l, 32);
    const int q_ = (lane & 15) >> 2, p_ = lane & 3;
    const unsigned vba = (unsigned)(uintptr_t)vbuf;
    unsigned vro[2], vrf[2];
#pragma unroll
    for (int h2 = 0; h2 < 2; ++h2) { const int key = 8 * fq + 4 * h2 + q_; vro[h2] = (unsigned)(256 * key + 8 * (p_ & 1)); vrf[h2] = (unsigned)(((key & 3) << 2) | ((key >> 2) & 3)); }
    f32x4 O[8];
#pragma unroll
    for (int dt = 0; dt < 8; ++dt) O[dt] = (f32x4){0.f, 0.f, 0.f, 0.f};
#pragma unroll
    for (int i = 0; i < 8; ++i) { unsigned ib = (unsigned)(i * 8192); asm volatile("" : "+s"(ib));
        const bf16x8s pf = __builtin_bit_cast(bf16x8s, pw[i]);
        s16x4 lo[8], hi[8];
#pragma unroll
        for (int dt = 0; dt < 8; ++dt) { lo[dt] = tr_read16(vba + ib + vro[0] + 16u * ((unsigned)(2 * dt + (p_ >> 1)) ^ vrf[0])); hi[dt] = tr_read16(vba + ib + vro[1] + 16u * ((unsigned)(2 * dt + (p_ >> 1)) ^ vrf[1])); }
        asm volatile("s_waitcnt lgkmcnt(0)" ::: "memory"); __builtin_amdgcn_sched_barrier(0);
#pragma unroll
        for (int dt = 0; dt < 8; ++dt) { const bf16x8s vf = (bf16x8s){lo[dt][0], lo[dt][1], lo[dt][2], lo[dt][3], hi[dt][0], hi[dt][1], hi[dt][2], hi[dt][3]};
            O[dt] = __builtin_amdgcn_mfma_f32_16x16x32_bf16(vf, pf, O[dt], 0, 0, 0); } }
    const float inv = 1.0f / l;
#pragma unroll
    for (int dt = 0; dt < 8; ++dt) { const f32x4 v = O[dt] * inv; v2u o; o.x = pg8::cvt_pk_bf16(v[0], v[1]); o.y = pg8::cvt_pk_bf16(v[2], v[3]);
        *(v2u*)((char*)XO + pg8::blk_off((int)m, h * 128 + 4 * fq + dt * 16, 8)) = o; }
}
__device__ __forceinline__ void xa_wave_task(int wt, const bf16* XQ, const bf16* KVM, bf16* XO, LAS unsigned char* lds, int wave, int lane) {
    const int qg = wt >> 2, h = wt & 3;
    const int fr = lane & 15, fq = lane >> 4;
    const size_t m = (size_t)qg * 16 + fr;
    const int s = (qg < 1024) ? (qg >> 7) : 8;
    const bf16* qp = XQ + m * XAW + h * 128 + 8 * fq;
    const bf16* kbase = KVM + (size_t)(s * 256 + 8 * (fr >> 2) + (fr & 3)) * 1024 + h * 128 + 8 * fq;
    const bf16* vbase = KVM + (size_t)(s * 256 + (lane >> 4)) * 1024 + 512 + h * 128 + (lane & 15) * 8;
    attn_task<false>(qp, kbase, vbase, (size_t)1024, 32, nullptr, 0, 0, 0, XO, (int)m, h * 128 + 4 * fq, lds + RING_OFF + wave * 8192, lane);
}

template <int DIR, int PC>
__device__ __forceinline__ void lru_unit(int s, int n, int tbeg, int ntile, const bf16* PROJ, const bf16* WG, const float* conv_w, const float* conv_b, const float* ba, const float* bx, const float* lam,
                                         bf16* Hout, bf16* Pout, LAS unsigned char* lds, int tid, int wave, int lane) {
    constexpr int RS = 272;
    const int seq0 = s < 8 ? s * 2048 : MP, T = s < 8 ? 2048 : 8192;
    const int fr = lane & 15, fq = lane >> 4;
    bf16x8s wf[2][4];
    { const bf16* wp = WG + ((size_t)(n * 2 + DIR) * 256 + 16 * wave + fr) * 128 + 8 * fq;
#pragma unroll
      for (int gi = 0; gi < 2; ++gi)
#pragma unroll
          for (int ks = 0; ks < 4; ++ks) wf[gi][ks] = *(const bf16x8s*)(wp + gi * 128 * 128 + 32 * ks); }
    const int chw = n * 128 + 16 * wave + fr;
    const float bra = -1.4426950408889634f * ba[DIR * 2048 + chw], bxi = -1.4426950408889634f * bx[DIR * 2048 + chw], sp8 = -8.0f * 1.4426950408889634f * log1pf(expf(-lam[DIR * 2048 + chw]));
    const int cp = lane, tg = wave, chc = n * 128 + 2 * cp;
    const float cw00 = conv_w[chc], cw01 = conv_w[chc + 1], cw10 = conv_w[2048 + chc], cw11 = conv_w[2048 + chc + 1], cw20 = conv_w[4096 + chc], cw21 = conv_w[4096 + chc + 1],
                cw30 = conv_w[6144 + chc], cw31 = conv_w[6144 + chc + 1], cb0 = conv_b[chc], cb1 = conv_b[chc + 1];
    const bf16* ub = PROJ + (size_t)seq0 * 4096 + chc;
    unsigned ur[11];
    { const int t0 = (tbeg + (DIR ? ntile - 1 : 0)) * 64 + 8 * tg - 1;
#pragma unroll
      for (int k = 0; k < 11; ++k) { const int t = t0 + k; ur[k] = (t >= 0 && t < T) ? *(const unsigned*)(ub + (size_t)t * 4096) : 0u; } }
    float carry = 0.f, pcar = 1.0f;
    for (int ti = 0; ti < ntile; ++ti) {
        const int tb = (tbeg + (DIR ? ntile - 1 - ti : ti)) * 64;
        LAS unsigned char* xt = lds + (ti & 1) * (64 * RS);
#pragma unroll
        for (int tt = 0; tt < 8; ++tt) {
            const float x0 = cw00 * bflo(ur[tt]) + cw10 * bflo(ur[tt + 1]) + cw20 * bflo(ur[tt + 2]) + cw30 * bflo(ur[tt + 3]) + cb0;
            const float x1 = cw01 * bfhi(ur[tt]) + cw11 * bfhi(ur[tt + 1]) + cw21 * bfhi(ur[tt + 2]) + cw31 * bfhi(ur[tt + 3]) + cb1;
            *(LAS unsigned*)(xt + (8 * tg + tt) * RS + 4 * cp) = pg8::cvt_pk_bf16(x0, x1); }
        if (ti + 1 < ntile) { const int t0 = (tbeg + (DIR ? ntile - 2 - ti : ti + 1)) * 64 + 8 * tg - 1;
#pragma unroll
            for (int k = 0; k < 11; ++k) { const int t = t0 + k; ur[k] = (t >= 0 && t < T) ? *(const unsigned*)(ub + (size_t)t * 4096) : 0u; } }
        asm volatile("s_waitcnt lgkmcnt(0)" ::: "memory"); __builtin_amdgcn_s_barrier(); asm volatile("" ::: "memory");
        f32x4 accr[4], acci[4];
#pragma unroll
        for (int m = 0; m < 4; ++m) { accr[m] = (f32x4){0.f, 0.f, 0.f, 0.f}; acci[m] = (f32x4){0.f, 0.f, 0.f, 0.f};
#pragma unroll
            for (int ks = 0; ks < 4; ++ks) { const bf16x8s af = *(const LAS bf16x8s*)(xt + (16 * m + fr) * RS + (32 * ks + 8 * fq) * 2);
                accr[m] = __builtin_amdgcn_mfma_f32_16x16x32_bf16(af, wf[0][ks], accr[m], 0, 0, 0);
                acci[m] = __builtin_amdgcn_mfma_f32_16x16x32_bf16(af, wf[1][ks], acci[m], 0, 0, 0); } }
        float av[4][4], bv[4][4];
#pragma unroll
        for (int m = 0; m < 4; ++m)
#pragma unroll
            for (int j = 0; j < 4; ++j) { const float xc = bf2f(*(const LAS bf16*)(xt + (16 * m + 4 * fq + j) * RS + (16 * wave + fr) * 2));
                const float rg = __builtin_amdgcn_rcpf(1.0f + __builtin_amdgcn_exp2f(fmaf(accr[m][j], -1.4426950408889634f, bra)));
                const float ig = __builtin_amdgcn_rcpf(1.0f + __builtin_amdgcn_exp2f(fmaf(acci[m][j], -1.4426950408889634f, bxi)));
                const float a = __builtin_amdgcn_exp2f(rg * sp8); av[m][j] = a; bv[m][j] = __builtin_amdgcn_sqrtf(fmaxf(1.0f - a * a, 0.f)) * ig * xc; }
        float Ai[4], Bi[4], Ae[4], Be[4], At[4], Bt[4];
#pragma unroll
        for (int m = 0; m < 4; ++m) {
            float A, B;
            if (DIR == 0) { A = av[m][0]; B = bv[m][0];
#pragma unroll
                for (int j = 1; j < 4; ++j) { B = B * av[m][j] + bv[m][j]; A *= av[m][j]; } }
            else { A = av[m][3]; B = bv[m][3];
#pragma unroll
                for (int j = 2; j >= 0; --j) { B = B * av[m][j] + bv[m][j]; A *= av[m][j]; } }
            Ai[m] = A; Bi[m] = B; }
        { float A1[4], B1[4];
#pragma unroll
          for (int m = 0; m < 4; ++m) { A1[m] = DIR ? __shfl_down(Ai[m], 16) : __shfl_up(Ai[m], 16); B1[m] = DIR ? __shfl_down(Bi[m], 16) : __shfl_up(Bi[m], 16); }
          const bool has = DIR ? (fq < 3) : (fq > 0);
#pragma unroll
          for (int m = 0; m < 4; ++m) if (has) { Bi[m] = Ai[m] * B1[m] + Bi[m]; Ai[m] = A1[m] * Ai[m]; } }
        { float A2[4], B2[4];
#pragma unroll
          for (int m = 0; m < 4; ++m) { A2[m] = DIR ? __shfl_down(Ai[m], 32) : __shfl_up(Ai[m], 32); B2[m] = DIR ? __shfl_down(Bi[m], 32) : __shfl_up(Bi[m], 32); }
          const bool has = DIR ? (fq < 2) : (fq > 1);
#pragma unroll
          for (int m = 0; m < 4; ++m) if (has) { Bi[m] = Ai[m] * B2[m] + Bi[m]; Ai[m] = A2[m] * Ai[m]; } }
#pragma unroll
        for (int m = 0; m < 4; ++m) {
            Ae[m] = DIR ? __shfl_down(Ai[m], 16) : __shfl_up(Ai[m], 16); Be[m] = DIR ? __shfl_down(Bi[m], 16) : __shfl_up(Bi[m], 16);
            At[m] = __shfl(Ai[m], (DIR ? 0 : 48) + fr); Bt[m] = __shfl(Bi[m], (DIR ? 0 : 48) + fr); }
        bf16* hp = Hout + (size_t)(seq0 + tb) * LW + chw; bf16* pp = Pout + (size_t)tb * LW + chw;
#pragma unroll
        for (int mm = 0; mm < 4; ++mm) { const int m = DIR ? 3 - mm : mm;
            const bool first = DIR ? (fq == 3) : (fq == 0);
            float h = first ? carry : Ae[m] * carry + Be[m]; float pv = first ? pcar : Ae[m] * pcar;
            if (DIR == 0) {
#pragma unroll
                for (int j = 0; j < 4; ++j) { h = av[m][j] * h + bv[m][j]; hp[(size_t)(16 * m + 4 * fq + j) * LW] = (bf16)pg8::cvt_pk_bf16(h, h);
                    if (PC) { pv *= av[m][j]; pp[(size_t)(16 * m + 4 * fq + j) * LW] = (bf16)pg8::cvt_pk_bf16(pv, pv); } } }
            else {
#pragma unroll
                for (int j = 3; j >= 0; --j) { h = av[m][j] * h + bv[m][j]; hp[(size_t)(16 * m + 4 * fq + j) * LW] = (bf16)pg8::cvt_pk_bf16(h, h);
                    if (PC) { pv *= av[m][j]; pp[(size_t)(16 * m + 4 * fq + j) * LW] = (bf16)pg8::cvt_pk_bf16(pv, pv); } } }
            carry = At[m] * carry + Bt[m]; if (PC) pcar *= At[m]; }
    }
    __syncthreads();
}
__device__ __forceinline__ void lru_dispatch(int u, const bf16* PROJ, const bf16* WG, const float* const* in, bf16* HF, bf16* HBk, bf16* PCA, LAS unsigned char* lds, int tid, int wave, int lane) {
    if (u < 64) { const int n = (u >> 2) & 15, e = (u >> 1) & 1, half = u & 1;
        if (e == 0) { if (half == 0) lru_unit<0, 0>(8, n, 0, 64, PROJ, WG, in[11], in[12], in[14], in[16], in[17], HF, PCA, lds, tid, wave, lane);
                      else           lru_unit<0, 1>(8, n, 64, 64, PROJ, WG, in[11], in[12], in[14], in[16], in[17], HF, PCA, lds, tid, wave, lane); }
        else        { if (half == 0) lru_unit<1, 0>(8, n, 64, 64, PROJ, WG, in[11], in[12], in[14], in[16], in[17], HBk, PCA, lds, tid, wave, lane);
                      else           lru_unit<1, 1>(8, n, 0, 64, PROJ, WG, in[11], in[12], in[14], in[16], in[17], HBk, PCA, lds, tid, wave, lane); } }
    else { const int v = u - 64, s = v >> 5, n = (v >> 1) & 15, e = v & 1;
        if (e == 0) lru_unit<0, 0>(s, n, 0, 32, PROJ, WG, in[11], in[12], in[14], in[16], in[17], HF, PCA, lds, tid, wave, lane);
        else        lru_unit<1, 0>(s, n, 0, 32, PROJ, WG, in[11], in[12], in[14], in[16], in[17], HBk, PCA, lds, tid, wave, lane); }
}

#define XB_TMO      128
#define XB_XCNT(j)  (256  + 64 * (j))
#define XB_XSUB(j)  (1280 + 64 * (j))
#define XB_XGEN(j)  (2304 + 64 * (j))
#define XB_TOP      3328
#define XB_TOPGEN   3392
#define XCD_BAR_WORDS 3456
#define XB_SPIN_CAP (1u << 18)

__device__ __forceinline__ unsigned xb_ld(unsigned* p)              { return __hip_atomic_load(p, __ATOMIC_RELAXED, __HIP_MEMORY_SCOPE_AGENT); }
__device__ __forceinline__ unsigned xb_add(unsigned* p, unsigned v) { return __hip_atomic_fetch_add(p, v, __ATOMIC_RELAXED, __HIP_MEMORY_SCOPE_AGENT); }
__device__ __forceinline__ unsigned xb_xcc_id() { return (unsigned)__builtin_amdgcn_s_getreg((3 << 11) | 20) & 0xFu; }
#define XB_SPIN(cond, bar) do { unsigned _sp = 0; while (cond) { __builtin_amdgcn_s_sleep(1); \
    if ((++_sp & 255u) == 0u) { if (xb_ld(&(bar)[XB_TMO])) break; if (_sp > XB_SPIN_CAP) { atomicAdd(&(bar)[XB_TMO], 1u); break; } } } } while (0)

struct XcdBarrier {
    unsigned* bar; unsigned x;
    volatile LAS unsigned* st;
};

__device__ __forceinline__ XcdBarrier xcd_barrier_post(unsigned* bar, volatile LAS unsigned* st) {
    XcdBarrier b; b.bar = bar; b.x = xb_xcc_id(); b.st = st;
    if (threadIdx.x == 0) (void)xb_add(&bar[XB_XCNT(b.x)], 1u);
    return b;
}
__device__ __forceinline__ void xcd_barrier_complete(unsigned* bar, unsigned x, unsigned& nloc, unsigned& nx) {
    const unsigned G = gridDim.x * gridDim.y * gridDim.z;
    unsigned sum, cnt, mine, sp = 0u;
    for (;;) {
        sum = 0u; cnt = 0u; mine = 0u;
#pragma unroll
        for (unsigned j = 0; j < 16; ++j) { const unsigned c = xb_ld(&bar[XB_XCNT(j)]); sum += c; cnt += (c > 0u) ? 1u : 0u; mine = (j == x) ? c : mine; }
        if (sum == G) break;
        __builtin_amdgcn_s_sleep(1);
        if ((++sp & 255u) == 0u) { if (xb_ld(&bar[XB_TMO])) break; if (sp > XB_SPIN_CAP) { atomicAdd(&bar[XB_TMO], 1u); break; } }
    }
    nloc = mine > 0u ? mine : 1u; nx = cnt > 0u ? cnt : 1u;
}

__device__ __forceinline__ void xcd_barrier(const XcdBarrier& b, bool wave0 = true) {
    asm volatile("s_waitcnt vmcnt(0)" ::: "memory");
    __syncthreads();
    unsigned bl_; asm volatile("v_mbcnt_lo_u32_b32 %0, -1, 0\n\tv_mbcnt_hi_u32_b32 %0, -1, %0" : "=&v"(bl_));
    if (wave0 && bl_ == 0u) {
        unsigned* bar = b.bar;
        __builtin_amdgcn_s_waitcnt(0);
        unsigned nloc = b.st[0], nx = b.st[1];
        if (nloc == 0u) { xcd_barrier_complete(bar, b.x, nloc, nx); b.st[0] = nloc; b.st[1] = nx; }
        const unsigned old = xb_add(&bar[XB_XSUB(b.x)], 1u);
        const unsigned gen = old / nloc;
        if (old + 1u == (gen + 1u) * nloc) {
            __builtin_amdgcn_fence(__ATOMIC_RELEASE, "agent");
            asm volatile("s_waitcnt vmcnt(0)" ::: "memory");
            const unsigned og = xb_add(&bar[XB_TOP], 1u);
            const unsigned tg = og / nx;
            if (og + 1u == (tg + 1u) * nx) xb_add(&bar[XB_TOPGEN], 1u);
            else XB_SPIN(xb_ld(&bar[XB_TOPGEN]) == tg, bar);
            __builtin_amdgcn_fence(__ATOMIC_ACQUIRE, "agent");
            xb_add(&bar[XB_XGEN(b.x)], 1u);
            asm volatile("s_waitcnt vmcnt(0)" ::: "memory");
        } else {
            XB_SPIN(xb_ld(&bar[XB_XGEN(b.x)]) == gen, bar);
            __builtin_amdgcn_fence(__ATOMIC_ACQUIRE, "agent");
            asm volatile("s_waitcnt vmcnt(0)" ::: "memory");
        }
    }
    __syncthreads();
}


constexpr int CI_UP = 2 * (D / 64) * (DFF / 32), CI_DN = (DFF / 64) * (D / 32), CI_IN = (D / 64) * (NIN / 32), CI_OUT = (D / 64) * (D / 32), CI_Q = (D / 64) * (XAW / 32), CI_O = (XAW / 64) * (D / 32), CI_G = 512;
constexpr int CI_TOTAL = CI_DN + CI_IN + CI_OUT + 3 * CI_Q + CI_O + CI_G + CI_UP + CI_DN;
constexpr int CI_P1 = CI_TOTAL - CI_DN, CI_P10 = CI_TOTAL;
constexpr int CONV_CHUNK = 128;
__device__ __forceinline__ void deferred_item(int g, const float* const* in, unsigned char* ws, LAS float* scr, int lane) {
    const float* W; int K, N, row_off = 0, up = 0; bf16* WT; const float* gk = nullptr;
    if (g < CI_DN) { W = in[7]; K = DFF; N = D; WT = (bf16*)(ws + WS_WDN1); }
    else if ((g -= CI_DN) < CI_OUT) { W = in[20]; K = D; N = D; WT = (bf16*)(ws + WS_WOUT); }
    else if ((g -= CI_OUT) < CI_IN) { W = in[9]; K = D; N = NIN; WT = (bf16*)(ws + WS_WIN); gk = in[8]; }
    else if ((g -= CI_IN) < CI_Q) { W = in[23]; K = D; N = XAW; WT = (bf16*)(ws + WS_WQ); gk = in[21]; }
    else if ((g -= CI_Q) < CI_Q) { W = in[24]; K = D; N = XAW; WT = (bf16*)(ws + WS_WKV); }
    else if ((g -= CI_Q) < CI_Q) { W = in[25]; K = D; N = XAW; WT = (bf16*)(ws + WS_WKV); row_off = XAW; }
    else if ((g -= CI_Q) < CI_O) { W = in[26]; K = XAW; N = D; WT = (bf16*)(ws + WS_WO); }
    else if ((g -= CI_O) < CI_G) { const int mat = g >> 3, sub = g & 7, gi = mat & 1, e = (mat >> 1) & 1, nn = mat >> 2;
        const float* Wsrc = (gi ? in[15] : in[13]) + ((size_t)(e * 16 + nn) << 14); const int k0 = (sub >> 2) * 64, n0 = (sub & 3) * 32;
        transpose_item(Wsrc, 128, 128, (bf16*)(ws + WS_WG) + ((size_t)(nn * 2 + e) * 256 + gi * 128 + n0) * 128, k0, n0, scr, lane); return; }
    else if ((g -= CI_G) < CI_UP) { const int which = g >= CI_UP / 2; if (which) g -= CI_UP / 2;
        const int nblk = DFF / 32, kb = g / nblk, nb = g % nblk, n0 = 32 * nb, k0 = 64 * kb, drow = 256 * (n0 >> 7) + (n0 & 127) + (which ? 128 : 0);
        transpose_item_f8(which ? in[29] : in[28], D, DFF, (char*)(ws + WS_WUP2) + ((size_t)((drow >> 8) * (D / 128) + (k0 >> 7)) << 15), k0, n0, drow & 255, true, 128.0f, in[27], scr, lane); return; }
    else { g -= CI_UP; W = in[30]; K = DFF; N = D; WT = (bf16*)(ws + WS_WDN2);
        const int nblk_ = D / 32, kb_ = g / nblk_, nb_ = g % nblk_, n0_ = 32 * nb_, k0_ = 64 * kb_;
        if (k0_ >= DN8_PN * 128) {
            transpose_item_f8(W, DFF, D, (char*)(ws + WS_WUP1) + ((size_t)((n0_ >> 8) * DN8_KT + ((k0_ - DN8_PN * 128) >> 7)) << 15), k0_, n0_, n0_ & 255, true, 128.0f, nullptr, scr, lane); return; } }
    const int nblk = N / 32, nkt = K / 64, kb = g / nblk, nb = g % nblk, n0 = 32 * nb;
    const int drow = up ? 256 * (n0 >> 7) + (n0 & 127) + (up == 2 ? 128 : 0) : row_off + n0;
    transpose_item_blk(W, K, N, (char*)WT + ((size_t)((drow >> 8) * nkt + kb) << 15), 64 * kb, n0, drow & 255, true, gk, scr, lane);
}
__device__ __forceinline__ void phase_prologue(const float* const* in, unsigned char* ws, LAS unsigned char* lds, pg8::ssq_t* ss0, int lane, int wave, int gw, int NGW) {
    bf16* W_G = (bf16*)(ws + WS_WG); bf16* W_Q = (bf16*)(ws + WS_WQ); bf16* W_KV = (bf16*)(ws + WS_WKV); bf16* W_O = (bf16*)(ws + WS_WO); bf16* MEMN = (bf16*)(ws + WS_MEMN);
    bf16* W_OUT = (bf16*)(ws + WS_WOUT); bf16* W_IN = (bf16*)(ws + WS_WIN); bf16* W_UP1 = (bf16*)(ws + WS_WUP1); bf16* W_DN1 = (bf16*)(ws + WS_WDN1);
    bf16* W_UP2 = (bf16*)(ws + WS_WUP2); bf16* W_DN2 = (bf16*)(ws + WS_WDN2); bf16* XN = (bf16*)(ws + WS_XN);
            for (int m = gw; m < MTOK; m += NGW) {
            const float* xr = (m < MP) ? in[0] + (size_t)m * D : in[1] + (size_t)(m - MP) * D;
            float s = 0.f;
#pragma unroll 4
            for (int j = 0; j < 16; ++j) { const f32x4 v = *(const f32x4*)(xr + (j * 64 + lane) * 4);
                s += (v[0] * v[0] + v[1] * v[1]) + (v[2] * v[2] + v[3] * v[3]);
                v2u o; o.x = pk2(v[0], v[1]); o.y = pk2(v[2], v[3]); *(v2u*)((char*)XN + pg8::blk_off(m, (j * 64 + lane) * 4, 64)) = o; }
            s = wave_sum(s); if (lane == 0) ss0[m] = pg8::ss_fix(s);
        }
        const float* gm = in[22];
        for (int m = gw; m < NMEM; m += NGW) {
            const float* xr = (m < 2048) ? in[2] + (size_t)m * D : in[3] + (size_t)(m - 2048) * D;
            f32x4 v[16]; float s = 0.f;
#pragma unroll
            for (int j = 0; j < 16; ++j) { v[j] = *(const f32x4*)(xr + (j * 64 + lane) * 4); s += (v[j][0] * v[j][0] + v[j][1] * v[j][1]) + (v[j][2] * v[j][2] + v[j][3] * v[j][3]); }
            s = wave_sum(s); const float rs = rsqrtf(s * (1.0f / D) + EPS);
#pragma unroll
            for (int j = 0; j < 16; ++j) { const f32x4 g = *(const f32x4*)(gm + (j * 64 + lane) * 4);
                v2u o; o.x = pk2(v[j][0] * rs * g[0], v[j][1] * rs * g[1]); o.y = pk2(v[j][2] * rs * g[2], v[j][3] * rs * g[3]); *(v2u*)((char*)MEMN + pg8::blk_off(m, (j * 64 + lane) * 4, 64)) = o; }
        }
        LAS float* scr = (LAS float*)(lds + RING_OFF + wave * 16384);
        transpose_up(in[5], in[6], W_UP1, in[4], scr, lane, gw, NGW);
        for (int g = CI_P10 + gw; g < CI_TOTAL; g += NGW) deferred_item(g, in, ws, scr, lane);
}
__device__ __forceinline__ void phase_mixer(const float* const* in, const bf16* PROJ, const bf16* UG, const bf16* W_G, bf16* HF, bf16* HBK, bf16* PCA, bf16* YA, unsigned* ctr, volatile LAS unsigned* MISC, LAS unsigned char* lds, int G, int bx, int tid, int wave, int lane, int mode = 3) {
        if (mode & 1) {
        for (int u = bx; u < 320; u += (u < 256 ? (bx >= 64 && bx < 128 ? 256 - 64 : 1024) : 1024)) lru_dispatch(u, UG, W_G, in, HF, HBK, PCA, lds, tid, wave, lane);
        }
        if (mode & 6)
        for (;;) {
            __syncthreads();
            if (tid == 0) MISC[0] = atomicAdd(ctr, 1u);
            __syncthreads();
            const int it = __builtin_amdgcn_readfirstlane((int)MISC[0]);
            if (it >= 3072) break;
            na_coop_task(it, PROJ, in[10], YA, lds, tid, wave, lane);
        }
}
__device__ __forceinline__ void phase_finalize(const float* const* in, const bf16* PROJ, const bf16* HF, const bf16* HBK, const bf16* PCA, const bf16* YA, bf16* Y, int lane, int gw, int NGW) {
        const float* ga = in[18]; const float* gl = in[19];
        for (int m = gw; m < MTOK; m += NGW) {
            float y[32]; float s = 0.f;
#pragma unroll
            for (int j = 0; j < 4; ++j) { const int c0 = (j * 64 + lane) * 8; float a[8], b[8], gt[8];
                unpack8(*(const v4u*)(HF + (size_t)m * LW + c0), a); unpack8(*(const v4u*)(HBK + (size_t)m * LW + c0), b); unpack8(*(const v4u*)(PROJ + (size_t)m * 4096 + 2048 + c0), gt);
                if (m >= MP) { const int t = m - MP; float pc[8], bd[8]; unpack8(*(const v4u*)(PCA + (size_t)t * LW + c0), pc);
                    if (t >= 4096) { unpack8(*(const v4u*)(HF + (size_t)(MP + 4095) * LW + c0), bd);
#pragma unroll
                        for (int k = 0; k < 8; ++k) a[k] += pc[k] * bd[k]; }
                    else { unpack8(*(const v4u*)(HBK + (size_t)(MP + 4096) * LW + c0), bd);
#pragma unroll
                        for (int k = 0; k < 8; ++k) b[k] += pc[k] * bd[k]; } }
#pragma unroll
                for (int k = 0; k < 8; ++k) { const float v = (a[k] + b[k]) * gelu_tanh(gt[k]); y[8 * j + k] = v; s += v * v; } }
            s = wave_sum(s); float rs = rsqrtf(s * (1.0f / LW) + EPS);
#pragma unroll
            for (int j = 0; j < 4; ++j) { const int c0 = (j * 64 + lane) * 8; const f32x4 g0 = *(const f32x4*)(gl + c0), g1 = *(const f32x4*)(gl + c0 + 4);
                v4u o; o.x = pk2(y[8 * j] * rs * g0[0], y[8 * j + 1] * rs * g0[1]); o.y = pk2(y[8 * j + 2] * rs * g0[2], y[8 * j + 3] * rs * g0[3]);
                o.z = pk2(y[8 * j + 4] * rs * g1[0], y[8 * j + 5] * rs * g1[1]); o.w = pk2(y[8 * j + 6] * rs * g1[2], y[8 * j + 7] * rs * g1[3]);
                *(v4u*)((char*)Y + pg8::blk_off(m, AW + c0, 64)) = o; }
            s = 0.f;
#pragma unroll
            for (int j = 0; j < 4; ++j) { const int c0 = (j * 64 + lane) * 8; float a[8]; unpack8(*(const v4u*)(YA + (size_t)m * AW + c0), a);
#pragma unroll
                for (int k = 0; k < 8; ++k) { y[8 * j + k] = a[k]; s += a[k] * a[k]; } }
            s = wave_sum(s); rs = rsqrtf(s * (1.0f / AW) + EPS);
#pragma unroll
            for (int j = 0; j < 4; ++j) { const int c0 = (j * 64 + lane) * 8; const f32x4 g0 = *(const f32x4*)(ga + c0), g1 = *(const f32x4*)(ga + c0 + 4);
                v4u o; o.x = pk2(y[8 * j] * rs * g0[0], y[8 * j + 1] * rs * g0[1]); o.y = pk2(y[8 * j + 2] * rs * g0[2], y[8 * j + 3] * rs * g0[3]);
                o.z = pk2(y[8 * j + 4] * rs * g1[0], y[8 * j + 5] * rs * g1[1]); o.w = pk2(y[8 * j + 6] * rs * g1[2], y[8 * j + 7] * rs * g1[3]);
                *(v4u*)((char*)Y + pg8::blk_off(m, c0, 64)) = o; }
        }
}
__device__ __forceinline__ void phase_xattn(const bf16* XQ, const bf16* KVM, bf16* XO, LAS unsigned char* lds, int wave, int lane, int gw, int NGW) {
        for (int t = blockIdx.x; t < (MTOK / 128) * 4; t += gridDim.x) { __syncthreads(); xa_coop_task(t, XQ, KVM, XO, lds, wave * 64 + lane, wave, lane); }
}

struct Args { const float* in[32]; float* out; unsigned char* ws; int ph_lo, ph_hi; };
static_assert(sizeof(Args) == 32 * 8 + 8 + 8 + 8, "Args has no padding");

__global__ void __launch_bounds__(NWAVES * 64, 2) mk_fwd(Args args) {
    extern __shared__ __attribute__((aligned(16))) unsigned char lds_raw[];
    LAS unsigned char* lds = (LAS unsigned char*)lds_raw;
    volatile LAS unsigned* MISC = (volatile LAS unsigned*)(lds + MISC_OFF);
    const int tid = threadIdx.x, lane = tid & 63, wave = __builtin_amdgcn_readfirstlane(tid >> 6);
    const int G = gridDim.x, bx = blockIdx.x;
    const int gw = bx * NWAVES + wave, NGW = G * NWAVES;
    unsigned char* ws = args.ws;
    unsigned* ctl = (unsigned*)(ws + WS_CTL);
    pg8::ssq_t* ss0 = (pg8::ssq_t*)(ctl + CW_SS); pg8::ssq_t* ss1 = ss0 + MTOK; pg8::ssq_t* ss2 = ss1 + MTOK; pg8::ssq_t* ss3 = ss2 + MTOK; pg8::ssq_t* ss4 = ss3 + MTOK;
    bf16* W_G = (bf16*)(ws + WS_WG); bf16* W_Q = (bf16*)(ws + WS_WQ); bf16* W_KV = (bf16*)(ws + WS_WKV); bf16* W_O = (bf16*)(ws + WS_WO); bf16* MEMN = (bf16*)(ws + WS_MEMN);
    bf16* W_OUT = (bf16*)(ws + WS_WOUT); bf16* W_IN = (bf16*)(ws + WS_WIN); bf16* W_UP1 = (bf16*)(ws + WS_WUP1); bf16* W_DN1 = (bf16*)(ws + WS_WDN1);
    bf16* W_UP2 = (bf16*)(ws + WS_WUP2); bf16* W_DN2 = (bf16*)(ws + WS_WDN2);
    bf16* XN = (bf16*)(ws + WS_XN); bf16* HBK = (bf16*)(ws + WS_HBK);
    bf16* PCA = (bf16*)args.out + (size_t)2 * MTOK * AW;
    bf16* YA = (bf16*)args.out; bf16* HF = (bf16*)args.out + (size_t)MTOK * AW;
    bf16* Y = (bf16*)(ws + WS_Y); bf16* HB = (bf16*)(ws + WS_HB); bf16* PROJ = (bf16*)(ws + WS_PROJ); bf16* UG = PROJ + (size_t)48 * MTOK * 128;
    bf16* XQ = (bf16*)(ws + WS_XQ); bf16* XO = (bf16*)(ws + WS_XO); bf16* KVM = (bf16*)(ws + WS_KVM);
    float* out = args.out;

    for (int i = tid; i < (LDS_BYTES - LDSCTL_OFF) / 4; i += NWAVES * 64) ((LAS unsigned*)(lds + LDSCTL_OFF))[i] = 0u;
    __syncthreads();
    if (tid == 0) { const unsigned long long xp_ = (unsigned long long)XN; MISC[20] = (unsigned)xp_; MISC[21] = (unsigned)(xp_ >> 32); }
    __syncthreads();
    const int lo = args.ph_lo, hi = args.ph_hi;
    XcdBarrier bar; bar.bar = ctl + CW_BAR; bar.x = 0; bar.st = nullptr;
    if (hi - lo > 1) bar = xcd_barrier_post(ctl + CW_BAR, MISC + 8);
#define IN(k) (lo <= (k) && (k) < hi)
#define LANE_NOW() ({ int l_; asm volatile("v_mbcnt_lo_u32_b32 %0, -1, 0\n\tv_mbcnt_hi_u32_b32 %0, -1, %0" : "=&v"(l_)); l_; })
#define SEAM(k) do { if (IN(k) && IN((k) + 1)) { xcd_barrier(bar, wave == 0); if (PROBE_MASK & 32768) xcd_barrier(bar, wave == 0); } } while (0)

    if (IN(0)) { phase_prologue(args.in, ws, lds, ss0, lane, wave, gw, NGW);
        if (PROBE_MASK & 1) { xcd_barrier(bar); phase_prologue(args.in, ws, lds, ss0, lane, wave, gw, NGW); } }
    SEAM(0);
    if (IN(1)) {
        pg8::Gemm g{XN, W_UP1, MTOK, NUP, D}; pg8::StaticOrder S; S.init(MTOK, NUP, G, bx);
        pg8::EpiSwiGLU E{HB, ss0, 1 << 30, 1.0f, nullptr};
        if (PROBE_MASK & 4096) { pg8::EpiTwice<pg8::EpiSwiGLU> ET{E}; pg8::gemm_phase<pg8::EpiTwice<pg8::EpiSwiGLU>, pg8::StaticOrder, PG8_ALIGN, PG8_SP2>(lds + RING_OFF, g, S, ET, wave); } else
        pg8::gemm_phase<pg8::EpiSwiGLU, pg8::StaticOrder, PG8_ALIGN, PG8_SP2>(lds + RING_OFF, g, S, E, wave);
        if (PROBE_MASK & 2) { xcd_barrier(bar); pg8::gemm_phase<pg8::EpiSwiGLU, pg8::StaticOrder, PG8_ALIGN, PG8_SP2>(lds + RING_OFF, g, S, E, wave); }
        const int lane = LANE_NOW(), tid = wave * 64 + lane;
        for (;;) {
            __syncthreads();
            if (tid == 0) MISC[0] = atomicAdd(ctl + CW_CONVCTR, 1u);
            __syncthreads();
            const int chunk = (int)MISC[0];
            if (chunk * CONV_CHUNK >= CI_P1) break;
            LAS float* scr = (LAS float*)(lds + RING_OFF + wave * 16384);
            for (int j = 0; j < CONV_CHUNK / NWAVES; ++j) { const int gi = chunk * CONV_CHUNK + wave * (CONV_CHUNK / NWAVES) + j; if (gi < CI_P1) deferred_item(gi, args.in, ws, scr, lane); }
        }
        if (PROBE_MASK & 65536) { xcd_barrier(bar);
            for (;;) {
                __syncthreads();
                if (tid == 0) MISC[0] = atomicAdd(ctl + CW_CONVCTR + 128, 1u);
                __syncthreads();
                const int chunk = (int)MISC[0];
                if (chunk * CONV_CHUNK >= CI_P1) break;
                LAS float* scr = (LAS float*)(lds + RING_OFF + wave * 16384);
                for (int j = 0; j < CONV_CHUNK / NWAVES; ++j) { const int gi = chunk * CONV_CHUNK + wave * (CONV_CHUNK / NWAVES) + j; if (gi < CI_P1) deferred_item(gi, args.in, ws, scr, lane); }
            } }
    }
    SEAM(1);
    if (IN(2)) {
        pg8::Gemm g{HB, W_DN1, MTOK, D, DFF}; pg8::StaticOrder S; S.init(MTOK, D, G, bx, WGM_DOWN, 1);
        pg8::EpiResid E{XN, ss1, nullptr, 0.5f};
        pg8::gemm_phase<pg8::EpiResid, pg8::StaticOrder, PG8_ALIGN, PG8_SP2>(lds + RING_OFF, g, S, E, wave);
        if (PROBE_MASK & 8192) { xcd_barrier(bar); pg8::Gemm gl{XN, W_UP1, MTOK, NUP, D}; pg8::StaticOrder Sl; Sl.init(MTOK, NUP, G, bx); pg8::EpiNull EN;
            pg8::gemm_phase<pg8::EpiNull, pg8::StaticOrder, PG8_ALIGN, PG8_SP2, PROBE_VAR>(lds + RING_OFF, gl, Sl, EN, wave); }
        if (PROBE_MASK & 4) { xcd_barrier(bar); pg8::EpiResid E2{XN, ss4 + MTOK, nullptr, 0.0f}; pg8::gemm_phase<pg8::EpiResid, pg8::StaticOrder, PG8_ALIGN, PG8_SP2>(lds + RING_OFF, g, S, E2, wave); }
    }
    SEAM(2);
    if (IN(3)) {
        pg8::Gemm g{XN, W_IN, MTOK, NIN, D}; pg8::StaticOrder S; S.init(MTOK, NIN, G, bx);
        pg8::EpiProj E{PROJ, UG, ss1, 0.08838834764831845f};
        pg8::gemm_phase<pg8::EpiProj, pg8::StaticOrder, PG8_ALIGN, PG8_SP2>(lds + RING_OFF, g, S, E, wave);
        if (PROBE_MASK & 8) { xcd_barrier(bar); pg8::gemm_phase<pg8::EpiProj, pg8::StaticOrder, PG8_ALIGN, PG8_SP2>(lds + RING_OFF, g, S, E, wave); }
    }
    SEAM(3);
    if (IN(4)) { const int lane = LANE_NOW(), tid = wave * 64 + lane; phase_mixer(args.in, PROJ, UG, W_G, HF, HBK, PCA, YA, ctl + CW_NACTR, MISC, lds, G, bx, tid, wave, lane);
        if (PROBE_MASK & 16) { xcd_barrier(bar); phase_mixer(args.in, PROJ, UG, W_G, HF, HBK, PCA, YA, ctl + CW_NACTR + 64, MISC, lds, G, bx, tid, wave, lane); }
        if (PROBE_MASK & 1024) { xcd_barrier(bar); phase_mixer(args.in, PROJ, UG, W_G, HF, HBK, PCA, YA, ctl + CW_NACTR + 64, MISC, lds, G, bx, tid, wave, lane, 1); }
        if (PROBE_MASK & 16384) { xcd_barrier(bar); phase_mixer(args.in, PROJ, UG, W_G, HF, HBK, PCA, YA, ctl + CW_NACTR + 64, MISC, lds, G, bx, tid, wave, lane, 4); }
        if (PROBE_MASK & 2048) { xcd_barrier(bar); phase_mixer(args.in, PROJ, UG, W_G, HF, HBK, PCA, YA, ctl + CW_NACTR + 64, MISC, lds, G, bx, tid, wave, lane, 2); } }
    SEAM(4);
    if (IN(5)) { const int lane = LANE_NOW(); phase_finalize(args.in, UG, HF, HBK, PCA, YA, Y, lane, gw, NGW);
        if (PROBE_MASK & 32) { xcd_barrier(bar); phase_finalize(args.in, UG, HF, HBK, PCA, YA, Y, lane, gw, NGW); } }
    SEAM(5);
    if (IN(6)) {
        pg8::Gemm g{Y, W_OUT, MTOK, D, D}; pg8::StaticOrder S; S.init(MTOK, D, G, bx);
        pg8::EpiResid E{XN, ss2, nullptr, 1.0f};
        pg8::gemm_phase<pg8::EpiResid, pg8::StaticOrder, PG8_ALIGN, PG8_SP2>(lds + RING_OFF, g, S, E, wave);
        if (PROBE_MASK & 64) { xcd_barrier(bar); pg8::EpiResid E2{XN, ss4 + MTOK, nullptr, 0.0f}; pg8::gemm_phase<pg8::EpiResid, pg8::StaticOrder, PG8_ALIGN, PG8_SP2>(lds + RING_OFF, g, S, E2, wave); }
    }
    SEAM(6);
    if (IN(7)) {
        if (bx < 192 || G < 228) {
            pg8::Gemm g{XN, W_Q, MTOK, XAW, D}; pg8::StaticOrder S; S.init(MTOK, XAW, G < 228 ? G : 192, bx);
            pg8::EpiScaleBf16 E{XQ, XAW, ss2, 0.08838834764831845f, XAW};
            pg8::gemm_phase<pg8::EpiScaleBf16, pg8::StaticOrder, PG8_ALIGN, PG8_SP2>(lds + RING_OFF, g, S, E, wave);
        }
        if ((bx >= 192 && bx < 228) || G < 228) {
            pg8::Gemm g{MEMN, W_KV, NMEM, 2 * XAW, D}; pg8::StaticOrder S; S.init(NMEM, 2 * XAW, G < 228 ? G : 36, G < 228 ? bx : bx - 192);
            pg8::EpiScaleBf16 E{KVM, 2 * XAW, nullptr, 1.0f, 0};
            pg8::gemm_phase<pg8::EpiScaleBf16, pg8::StaticOrder, PG8_ALIGN, PG8_SP2>(lds + RING_OFF, g, S, E, wave);
        }
    }
    SEAM(7);
    if (IN(8)) { const int lane = LANE_NOW(); phase_xattn(XQ, KVM, XO, lds, wave, lane, gw, NGW);
        if (PROBE_MASK & 256) { xcd_barrier(bar); phase_xattn(XQ, KVM, XO, lds, wave, lane, gw, NGW); } }
    SEAM(8);
    if (IN(9)) {
        pg8::Gemm g{XO, W_O, MTOK, D, XAW}; pg8::StaticOrder S; S.init(MTOK, D, G, bx);
        pg8::EpiResid E{XN, ss3, (char*)(ws + WS_Y), 1.0f};
        pg8::gemm_phase<pg8::EpiResid, pg8::StaticOrder, PG8_ALIGN, PG8_SP2>(lds + RING_OFF, g, S, E, wave);
        if (PROBE_MASK & 512) { xcd_barrier(bar); pg8::EpiResid E2{XN, ss4 + MTOK, nullptr, 0.0f}; pg8::gemm_phase<pg8::EpiResid, pg8::StaticOrder, PG8_ALIGN, PG8_SP2>(lds + RING_OFF, g, S, E2, wave); }
    }
    SEAM(9);
    if (IN(10)) {
        pg8::Gemm g{(const pg8::bf16_t*)(ws + WS_Y), W_UP2, MTOK, NUP, D}; pg8::StaticOrder S; S.init(MTOK, NUP, G, bx);
        pg8::EpiSwiGLU E{HB, ss3, DN8_PN, 1.0f / 128.0f, (char*)out};
        pg8::gemm_phase<pg8::EpiSwiGLU, pg8::StaticOrder, PG8_ALIGN, PG8_SP2, 0, true>(lds + RING_OFF, g, S, E, wave);
        const int lane = LANE_NOW(), tid = wave * 64 + lane;
        for (;;) {
            __syncthreads();
            if (tid == 0) MISC[0] = atomicAdd(ctl + CW_CONVCTR + 64, 1u);
            __syncthreads();
            const int chunk = (int)MISC[0];
            if (CI_P1 + chunk * CONV_CHUNK >= CI_P10) break;
            LAS float* scr = (LAS float*)(lds + RING_OFF + wave * 16384);
            for (int j = 0; j < CONV_CHUNK / NWAVES; ++j) { const int gi = CI_P1 + chunk * CONV_CHUNK + wave * (CONV_CHUNK / NWAVES) + j; if (gi < CI_P10) deferred_item(gi, args.in, ws, scr, lane); }
        }
    }
    SEAM(10);
    if (IN(11)) {
        pg8::StaticOrder S; S.init(MTOK, D, G, bx, 8, 1);
        pg8::Gemm2 g{HB, W_DN2, MTOK, D, DN8_PN * 128, DFF, (const pg8::bf16_t*)out, (const pg8::bf16_t*)(ws + WS_WUP1), DFF - DN8_PN * 128};
        pg8::EpiResid E{XN, ss4, nullptr, 0.5f};
        pg8::gemm_phase_tail8<pg8::EpiResid, pg8::StaticOrder>(lds + RING_OFF, g, S, E, wave);
    }
    SEAM(11);
    if (IN(12)) {
        const float* gf = args.in[31];
        int ln12; asm volatile("v_mbcnt_lo_u32_b32 %0, -1, 0\n\tv_mbcnt_hi_u32_b32 %0, -1, %0" : "=&v"(ln12));
        const int lane = ln12;
        const int gq = lane >> 3, rb = (lane >> 2) & 1, chk = lane & 3;
        for (int p = gw; p < MTOK / 2; p += NGW) {
            const int m = 2 * p + rb; const float rs = rsqrtf(pg8::ss_get(ss4 + m) * (1.0f / D) + EPS); float* orow = out + (size_t)m * D;
#pragma unroll 4
            for (int j = 0; j < 16; ++j) { const int c0 = (j * 8 + gq) * 32 + chk * 8; float a[8]; unpack8(*(const v4u*)((const char*)XN + pg8::blk_off(m, c0, 64)), a);
                const f32x4 g0 = *(const f32x4*)(gf + c0), g1 = *(const f32x4*)(gf + c0 + 4);
                __builtin_nontemporal_store((f32x4){a[0] * rs * g0[0], a[1] * rs * g0[1], a[2] * rs * g0[2], a[3] * rs * g0[3]}, (f32x4*)(orow + c0));
                __builtin_nontemporal_store((f32x4){a[4] * rs * g1[0], a[5] * rs * g1[1], a[6] * rs * g1[2], a[7] * rs * g1[3]}, (f32x4*)(orow + c0 + 4)); }
        }
    }
#undef IN
#undef LANE_NOW
#undef SEAM
}

extern "C" void kernel_launch(void* const* d_in, const int* in_sizes, int n_in, void* d_out, int out_size, void* d_ws, size_t ws_size, hipStream_t stream) {
    static int grid = 0;
    if (grid == 0) {
        if (n_in != 32 || in_sizes[0] != MP * D || in_sizes[1] != MS * D || out_size != MTOK * D || ws_size < WS_END) {
            fprintf(stderr, "kernel_launch: shape/workspace mismatch: n_in %d in0 %d in1 %d out %d ws %zu (need %zu); nothing launched\n", n_in, n_in > 0 ? in_sizes[0] : -1, n_in > 1 ? in_sizes[1] : -1, out_size, ws_size, (size_t)WS_END);
            grid = -1; return; }
        int dev = 0, cus = 0, per_cu = 0;
        if (hipGetDevice(&dev) != hipSuccess || hipDeviceGetAttribute(&cus, hipDeviceAttributeMultiprocessorCount, dev) != hipSuccess) { grid = -1; return; }
        if (hipFuncSetAttribute((const void*)mk_fwd, hipFuncAttributeMaxDynamicSharedMemorySize, LDS_BYTES) != hipSuccess) { fprintf(stderr, "kernel_launch: hipFuncSetAttribute failed\n"); grid = -1; return; }
        if (hipOccupancyMaxActiveBlocksPerMultiprocessor(&per_cu, (const void*)mk_fwd, NWAVES * 64, LDS_BYTES) != hipSuccess || per_cu < 1)
            fprintf(stderr, "kernel_launch: note: occupancy query reports %d workgroups per CU\n", per_cu);
        (void)hipGetLastError();
        grid = cus;
    }
    if (grid < 0) return;
    if (hipMemsetAsync((char*)d_ws + WS_CTL, 0, CTL_ZERO_BYTES, stream) != hipSuccess) return;
    Args a{};
    for (int i = 0; i < 32; ++i) a.in[i] = (const float*)d_in[i];
    a.out = (float*)d_out; a.ws = (unsigned char*)d_ws;
#if MK_N_LAUNCHES == 1
    a.ph_lo = 0; a.ph_hi = N_PHASES;
    hipLaunchKernelGGL(mk_fwd, dim3(grid), dim3(NWAVES * 64), LDS_BYTES, stream, a);
#else
    for (int p = 0; p < N_PHASES; ++p) { a.ph_lo = p; a.ph_hi = p + 1; hipLaunchKernelGGL(mk_fwd, dim3(grid), dim3(NWAVES * 64), LDS_BYTES, stream, a); }
#endif
    const hipError_t le = hipPeekAtLastError();
    if (le != hipSuccess) fprintf(stderr, "kernel_launch: launch failed: %s\n", hipGetErrorName(le));
}
```

```cpp
#include <hip/hip_runtime.h>
#include <cstdio>
#include <cstdint>
namespace pg8 {
#define PG8_LAS __attribute__((address_space(3)))
typedef unsigned short bf16_t;
typedef short bf16x8 __attribute__((ext_vector_type(8)));
typedef float f32x4 __attribute__((ext_vector_type(4)));
typedef unsigned u32x4 __attribute__((ext_vector_type(4)));
constexpr int BM = 256, BK = 64, HALF = 128, HTB = HALF * BK * 2  , STAGE_BYTES = 8 * HTB, NXCD = 8, WGM = 8;

__host__ __device__ __forceinline__ int lds_byte(int r, int c) { const int st = (r >> 4) * 2 + (c >> 5), rr = r & 15, cc = c & 31, ob = rr * 64 + cc * 2; return st * 1024 + (ob ^ (((ob >> 9) & 1) << 5)); }
__host__ __device__ __forceinline__ void stage_rc(int b, int& R, int& C) { const int st = b / 1024, sb = b % 1024, swz = sb ^ (((sb >> 9) & 1) << 5); R = (st >> 1) * 16 + swz / 64; C = (st & 1) * 32 + (swz % 64) / 2; }
__host__ __device__ __forceinline__ int perm32(int rho) { const int n = rho >> 4, i = rho & 15; return 8 * (i >> 2) + 4 * n + (i & 3); }

__host__ __device__ __forceinline__ int perm32inv(int v) { return 16 * ((v >> 2) & 1) + 4 * (v >> 3) + (v & 3); }
__host__ __device__ __forceinline__ size_t blk_off(int row, int col, int nkt) { const int p = row >> 8, h = (row >> 7) & 1, r = row & 127, kt = col >> 6, c = col & 63; return ((size_t)((p * nkt + kt) * 2 + h) << 14) + (size_t)lds_byte(r, c); }
typedef int i32x4v __attribute__((ext_vector_type(4)));
typedef int i32x8v __attribute__((ext_vector_type(8)));
typedef short bf16x16v __attribute__((ext_vector_type(16)));
__host__ __device__ __forceinline__ size_t blk8_off(int row, int col, int nkt8) { const int p = row >> 8, h = (row >> 7) & 1, r = row & 127, kt = col >> 7, cb = col & 127, c8 = cb >> 4;
    return ((size_t)((p * nkt8 + kt) * 2 + h) << 14) + (size_t)((r >> 4) * 2048 + (c8 & 1) * 1024 + ((c8 >> 1) * 16 + (r & 15)) * 16 + (cb & 15)); }
struct Unit { int pm, pn; };
struct Gemm { const bf16_t* A; const bf16_t* Bt; int M, N, K; int Ks = 0; };

#ifndef PG8_XCDROWS
#define PG8_XCDROWS 1
#endif
struct StaticOrder {
    int nM, nN, nwg, G, c, wgm, rev;
    __host__ __device__ void init(int M, int N, int G_, int c_, int wgm_ = WGM, int rev_ = 0) { nM = M / BM; nN = N / BM; nwg = nM * nN; G = G_; c = c_; wgm = wgm_; rev = rev_; }
    __host__ __device__ bool next(int i, Unit& u) const {
        const long L = (long)i * G + c; if (L >= nwg) return false;
        if (PG8_XCDROWS && nM % NXCD == 0 && G % NXCD == 0) {
            const int xcd = (int)(L % NXCD), off = (int)(L / NXCD), nMl = nM / NXCD, nig = wgm * nN, gid = off / nig, fm = gid * wgm, gsz = (nMl - fm) < wgm ? (nMl - fm) : wgm, w = off % nig;
            u.pm = xcd * nMl + fm + w % gsz; u.pn = w / gsz; if (rev) u.pm = nM - 1 - u.pm; return true; }
        int wgid = (int)L; { const int q = nwg / NXCD, r = nwg % NXCD, xcd = wgid % NXCD, off = wgid / NXCD; wgid = (xcd < r ? xcd * (q + 1) : r * (q + 1) + (xcd - r) * q) + off; }
        const int nig = wgm * nN, gid = wgid / nig, fm = gid * wgm, gsz = (nM - fm) < wgm ? (nM - fm) : wgm;
        u.pm = fm + ((wgid % nig) % gsz); u.pn = (wgid % nig) / gsz; if (rev) u.pm = nM - 1 - u.pm; return true;
    }
    __device__ __forceinline__ void a_ready(const Unit&) const {}
    __device__ __forceinline__ void done(const Unit&) const {}
};
__device__ __forceinline__ unsigned cvt_pk_bf16(float lo, float hi) { unsigned r; asm volatile("v_cvt_pk_bf16_f32 %0, %1, %2" : "=v"(r) : "v"(lo), "v"(hi)); return r; }
typedef float f32x2 __attribute__((ext_vector_type(2)));
template <class Epi, class Sched, bool ALIGN_EPI = false, bool SP2 = false, int VAR = 0, bool FP8 = false>
__device__ __forceinline__ void gemm_phase(PG8_LAS unsigned char* lds, const Gemm g, const Sched& S, const Epi& E, const int wid) {
    int lane_; asm volatile("v_mbcnt_lo_u32_b32 %0, -1, 0\n\tv_mbcnt_hi_u32_b32 %0, -1, %0" : "=&v"(lane_));
    const int lane = lane_, tid = wid * 64 + lane, wr = wid >> 2, wc = wid & 3, fr = lane & 15, fq = lane >> 4;
    const int K = g.K, nt = K / (FP8 ? 2 * BK : BK);
    unsigned voffA[2], voffB[2];
#pragma unroll
    for (int i = 0; i < 2; ++i) { voffA[i] = (unsigned)(tid * 16 + i * 8192); voffB[i] = voffA[i]; }
    const size_t kstep = 32768;
    const size_t hstep = 16384;
    const size_t tstep = (size_t)((g.Ks ? g.Ks : K) / (FP8 ? 2 * BK : BK)) * 32768;
    const unsigned ldsw = (unsigned)wid * 1024u; const unsigned ldsb_ = (unsigned)(uintptr_t)lds + ldsw;
    const int aoff = FP8 ? (wr * 8192 + lane * 16) : lds_byte(wr * 64 + fr, fq * 8), boff = FP8 ? (wc * 4096 + lane * 16) : lds_byte(wc * 32 + fr, fq * 8);
#define PG8_SA(b, h) (((b) * 2 + (h)) * HTB)
#define PG8_SB(b, h) ((4 + (b) * 2 + (h)) * HTB)
#define PG8_STAGE(bufoff, gbase, voff) do { _Pragma("unroll") for (int _i = 0; _i < 2; ++_i) { const char* gb_ = (const char*)(gbase) + _i * 8192;     \
        asm volatile("s_mov_b32 m0, %0\n\ts_nop 0\n\tglobal_load_lds_dwordx4 %1, %2" :: "s"(ldsb_ + (unsigned)((bufoff) + _i * 8192)), "v"((voff)[0]), "s"(gb_) : "memory", "m0"); } } while (0)
#define PG8_LDA(dst, b, h) do { if constexpr (FP8) { _Pragma("unroll") for (int m = 0; m < 4; ++m) { const bf16x8 lo_ = *(const PG8_LAS bf16x8*)(lds + PG8_SA(b, h) + aoff + m * 2048), hi_ = *(const PG8_LAS bf16x8*)(lds + PG8_SA(b, h) + aoff + m * 2048 + 1024); \
        dst##8[m] = __builtin_shufflevector(lo_, hi_, 0, 1, 2, 3, 4, 5, 6, 7, 8, 9, 10, 11, 12, 13, 14, 15); } } \
      else { _Pragma("unroll") for (int m = 0; m < 4; ++m) _Pragma("unroll") for (int k = 0; k < 2; ++k) dst[m][k] = *(const PG8_LAS bf16x8*)(lds + PG8_SA(b, h) + aoff + m * 2048 + k * 1024); } } while (0)
#define PG8_LDB(dst, b, h) do { if constexpr (FP8) { _Pragma("unroll") for (int n = 0; n < 2; ++n) { const bf16x8 lo_ = *(const PG8_LAS bf16x8*)(lds + PG8_SB(b, h) + boff + n * 2048), hi_ = *(const PG8_LAS bf16x8*)(lds + PG8_SB(b, h) + boff + n * 2048 + 1024); \
        dst##8[n] = __builtin_shufflevector(lo_, hi_, 0, 1, 2, 3, 4, 5, 6, 7, 8, 9, 10, 11, 12, 13, 14, 15); } } \
      else { _Pragma("unroll") for (int n = 0; n < 2; ++n) _Pragma("unroll") for (int k = 0; k < 2; ++k) dst[n][k] = *(const PG8_LAS bf16x8*)(lds + PG8_SB(b, h) + boff + n * 2048 + k * 1024); } } while (0)
#define PG8_CAT8(x0, x1) __builtin_shufflevector(__builtin_bit_cast(i32x4v, x0), __builtin_bit_cast(i32x4v, x1), 0, 1, 2, 3, 4, 5, 6, 7)
#define PG8_MMA(ai, bj, At, Bt) do { __builtin_amdgcn_s_setprio(1); if constexpr (FP8) { _Pragma("unroll") for (int m = 0; m < 4; ++m) _Pragma("unroll") for (int n = 0; n < 2; ++n) \
        acc[ai][bj][m][n] = __builtin_amdgcn_mfma_scale_f32_16x16x128_f8f6f4(__builtin_bit_cast(i32x8v, Bt##8[n]), __builtin_bit_cast(i32x8v, At##8[m]), acc[ai][bj][m][n], 0, 0, 0, 0x7f7f7f7f, 0, 0x7f7f7f7f); } \
      else { _Pragma("unroll") for (int m = 0; m < 4; ++m) _Pragma("unroll") for (int n = 0; n < 2; ++n) _Pragma("unroll") for (int k = 0; k < 2; ++k) \
        acc[ai][bj][m][n] = __builtin_amdgcn_mfma_f32_16x16x32_bf16(Bt[n][k], At[m][k], acc[ai][bj][m][n], 0, 0, 0); } __builtin_amdgcn_s_setprio(0); } while (0)
#define PG8_WAIT_V(n) asm volatile("s_waitcnt vmcnt(" #n ")" ::: "memory")
#define PG8_WAIT_L(n) asm volatile("s_waitcnt lgkmcnt(" #n ")" ::: "memory")
#define PG8_BAR __builtin_amdgcn_s_barrier()
#define PG8_SCHED __builtin_amdgcn_sched_barrier(0)
    Unit cur, nxt; int ui = 0;
    if (!S.next(0, cur)) return;
    f32x4 acc[2][2][4][2];
#pragma unroll
    for (int a = 0; a < 2; ++a)
#pragma unroll
        for (int b = 0; b < 2; ++b)
#pragma unroll
            for (int m = 0; m < 4; ++m)
#pragma unroll
                for (int n = 0; n < 2; ++n) acc[a][b][m][n] = (f32x4){0.f, 0.f, 0.f, 0.f};
    bf16x8 At[4][2], B0[2][2], B1[2][2];
    bf16x16v At8[4], B08[2], B18[2];
    u32x4 bx[8]; if constexpr (VAR == 2) { _Pragma("unroll") for (int j_ = 0; j_ < 8; ++j_) bx[j_] = (u32x4){0u, 0u, 0u, 0u}; }
    const char* cA = (const char*)g.A + (size_t)cur.pm * tstep; const char* cB = (const char*)g.Bt + (size_t)cur.pn * tstep;
    S.a_ready(cur);
    if constexpr (SP2) {
        PG8_STAGE(PG8_SB(0, 0), cB, voffB); PG8_STAGE(PG8_SB(0, 1), cB + hstep, voffB); PG8_STAGE(PG8_SA(0, 0), cA, voffA); PG8_STAGE(PG8_SA(0, 1), cA + hstep, voffA);
        if (wr == 1) PG8_BAR;
        PG8_WAIT_V(2); PG8_BAR;
        PG8_STAGE(PG8_SB(1, 0), cB + kstep, voffB); PG8_STAGE(PG8_SA(1, 0), cA + kstep, voffA); PG8_STAGE(PG8_SB(1, 1), cB + hstep + kstep, voffB);
        PG8_WAIT_V(6); PG8_BAR;
    } else {
        PG8_STAGE(PG8_SB(0, 0), cB, voffB); PG8_STAGE(PG8_SA(0, 0), cA, voffA); PG8_STAGE(PG8_SB(0, 1), cB + hstep, voffB); PG8_STAGE(PG8_SA(0, 1), cA + hstep, voffA);
        if (wr == 1) PG8_BAR;
        PG8_WAIT_V(4); PG8_BAR;
        PG8_STAGE(PG8_SB(1, 0), cB + kstep, voffB); PG8_STAGE(PG8_SA(1, 0), cA + kstep, voffA); PG8_STAGE(PG8_SB(1, 1), cB + hstep + kstep, voffB);
        PG8_WAIT_V(6); PG8_BAR;
    }
    for (;;) {
        const bool has_next = S.next(ui + 1, nxt);
        const char* nA = has_next ? (const char*)g.A + (size_t)nxt.pm * tstep : cA; const char* nB = has_next ? (const char*)g.Bt + (size_t)nxt.pn * tstep : cB;
        for (int t = 0; t < nt; t += 2) {
            const bool last = (t == nt - 2);
            const char* a1 = cA + (size_t)(t + 1) * kstep;
            const char* a2 = last ? nA : cA + (size_t)(t + 2) * kstep; const char* b2 = last ? nB : cB + (size_t)(t + 2) * kstep;
            const char* a3 = a2 + kstep; const char* b3 = b2 + kstep;
            if (last && has_next) S.a_ready(nxt);
            if constexpr (SP2) {
#define PG8_STB(bufoff, gbase) do { if constexpr (VAR == 0) { PG8_STAGE(bufoff, gbase, voffB); } } while (0)
#define PG8_WV() do { if constexpr (VAR == 0) { PG8_WAIT_V(8); } else if constexpr (VAR == 1) { PG8_WAIT_V(4); } else { PG8_WAIT_V(12); } } while (0)
#define PG8_WV0() do { if constexpr (FP8) { PG8_WV(); } else if constexpr (VAR == 0 && Epi::NVM_MIN == 16) { if (t == 0 && ui > 0) { PG8_WAIT_V(24); } else { PG8_WAIT_V(8); } } else if constexpr (VAR == 0 && Epi::NVM_MIN == 8) { if (t == 0 && ui > 0) { PG8_WAIT_V(16); } else { PG8_WAIT_V(8); } } else { PG8_WV(); } } while (0)
#define PG8_BREG(gbase) do { if constexpr (VAR == 2) { _Pragma("unroll") for (int j_ = 0; j_ < 8; ++j_) asm volatile("" :: "v"(bx[j_])); \
        _Pragma("unroll") for (int j_ = 0; j_ < 8; ++j_) bx[j_] = *(const u32x4*)((gbase) + wc * 8192 + j_ * 1024 + lane * 16); } } while (0)
            PG8_LDB(B0, 0, 0); PG8_LDB(B1, 0, 1); PG8_SCHED; PG8_LDA(At, 0, 0); PG8_STAGE(PG8_SA(1, 1), a1 + hstep, voffA); PG8_BREG(b2);
            PG8_WV0(); PG8_WAIT_L(0); PG8_BAR; PG8_MMA(0, 0, At, B0); PG8_MMA(0, 1, At, B1); PG8_BAR; PG8_SCHED;
            PG8_LDA(At, 0, 1); PG8_STB(PG8_SB(0, 0), b2); PG8_STB(PG8_SB(0, 1), b2 + hstep); PG8_STAGE(PG8_SA(0, 0), a2, voffA);
            PG8_WV0(); PG8_WAIT_L(0); PG8_BAR; PG8_MMA(1, 0, At, B0); PG8_MMA(1, 1, At, B1); PG8_BAR; PG8_SCHED;
            PG8_LDB(B0, 1, 0); PG8_LDB(B1, 1, 1); PG8_SCHED; PG8_LDA(At, 1, 0); PG8_STAGE(PG8_SA(0, 1), a2 + hstep, voffA); PG8_BREG(b3);
            PG8_WV(); PG8_WAIT_L(0); PG8_BAR; PG8_MMA(0, 0, At, B0); PG8_MMA(0, 1, At, B1); PG8_BAR; PG8_SCHED;
            PG8_LDA(At, 1, 1); PG8_STB(PG8_SB(1, 0), b3); PG8_STB(PG8_SB(1, 1), b3 + hstep); PG8_STAGE(PG8_SA(1, 0), a3, voffA);
            PG8_WV(); PG8_WAIT_L(0); PG8_BAR; PG8_MMA(1, 0, At, B0); PG8_MMA(1, 1, At, B1); PG8_BAR; PG8_SCHED;
#undef PG8_STB
#undef PG8_WV
#undef PG8_WV0
#undef PG8_BREG
            } else {
            PG8_LDB(B0, 0, 0); PG8_SCHED; PG8_LDA(At, 0, 0); PG8_STAGE(PG8_SA(1, 1), a1 + hstep, voffA);
            PG8_WAIT_L(8); PG8_BAR; PG8_WAIT_L(0); PG8_MMA(0, 0, At, B0); PG8_BAR; PG8_SCHED;
            PG8_LDB(B1, 0, 1); PG8_STAGE(PG8_SB(0, 0), b2, voffB);
            PG8_BAR; PG8_WAIT_L(0); PG8_MMA(0, 1, At, B1); PG8_BAR;
            PG8_LDA(At, 0, 1); PG8_STAGE(PG8_SA(0, 0), a2, voffA);
            PG8_BAR; PG8_WAIT_L(0); PG8_MMA(1, 0, At, B0); PG8_BAR; PG8_SCHED;
            PG8_STAGE(PG8_SB(0, 1), b2 + hstep, voffB);
            PG8_WAIT_V(6); PG8_BAR; PG8_MMA(1, 1, At, B1); PG8_BAR;
            PG8_LDB(B0, 1, 0); PG8_SCHED; PG8_LDA(At, 1, 0); PG8_STAGE(PG8_SA(0, 1), a2 + hstep, voffA);
            PG8_WAIT_L(8); PG8_BAR; PG8_WAIT_L(0); PG8_MMA(0, 0, At, B0); PG8_BAR; PG8_SCHED;
            PG8_LDB(B1, 1, 1); PG8_STAGE(PG8_SB(1, 0), b3, voffB);
            PG8_BAR; PG8_WAIT_L(0); PG8_MMA(0, 1, At, B1); PG8_BAR;
            PG8_LDA(At, 1, 1); PG8_STAGE(PG8_SA(1, 0), a3, voffA);
            PG8_BAR; PG8_WAIT_L(0); PG8_MMA(1, 0, At, B0); PG8_BAR; PG8_SCHED;
            PG8_STAGE(PG8_SB(1, 1), b3 + hstep, voffB);
            PG8_WAIT_V(6); PG8_BAR; PG8_MMA(1, 1, At, B1); PG8_BAR;
            }
        }
        if constexpr (ALIGN_EPI) { if (wr == 0) PG8_BAR; }
        if constexpr (!Epi::AFTER_DRAIN) {
            { int ln_; asm volatile("v_mbcnt_lo_u32_b32 %0, -1, 0\n\tv_mbcnt_hi_u32_b32 %0, -1, %0" : "=&v"(ln_)); E(acc, cur, wr, wc, ln_ & 15, ln_ >> 4); }
            S.done(cur); }
        if (!has_next) break;
#pragma unroll
        for (int a = 0; a < 2; ++a)
#pragma unroll
            for (int b = 0; b < 2; ++b)
#pragma unroll
                for (int m = 0; m < 4; ++m)
#pragma unroll
                    for (int n = 0; n < 2; ++n) acc[a][b][m][n] = (f32x4){0.f, 0.f, 0.f, 0.f};
        cur = nxt; cA = nA; cB = nB; ++ui;
        if constexpr (ALIGN_EPI) { if (wr == 1) PG8_BAR; }
    }
    PG8_WAIT_V(0);
    if constexpr (!ALIGN_EPI) { if (wr == 0) PG8_BAR; }
    PG8_BAR;
    if constexpr (Epi::AFTER_DRAIN) { E.fused(acc, cur, wr, wc, fr, fq, lds, wid, lane); S.done(cur); }
#undef PG8_SA
#undef PG8_SB
#undef PG8_STAGE
#undef PG8_LDA
#undef PG8_LDB
#undef PG8_MMA
#undef PG8_CAT8
#undef PG8_WAIT_V
#undef PG8_WAIT_L
#undef PG8_BAR
#undef PG8_SCHED
}
struct Gemm2 { const bf16_t* A; const bf16_t* Bt; int M, N, K, Ks; const bf16_t* A8; const bf16_t* B8; int K8; };
template <class Epi, class Sched>
__device__ __forceinline__ void gemm_phase_tail8(PG8_LAS unsigned char* lds, const Gemm2 g, const Sched& S, const Epi& E, const int wid) {
    int lane_; asm volatile("v_mbcnt_lo_u32_b32 %0, -1, 0\n\tv_mbcnt_hi_u32_b32 %0, -1, %0" : "=&v"(lane_));
    const int tid = wid * 64 + lane_, wr = wid >> 2, wc = wid & 3;
    const int ntA = g.K / BK, ntB = g.K8 / (2 * BK);
    unsigned voff[1]; voff[0] = (unsigned)(tid * 16);
    const size_t kstep = 32768, hstep = 16384, tstepA = (size_t)(g.Ks / BK) * 32768, tstepB = (size_t)ntB * 32768;
    const unsigned ldsw = (unsigned)wid * 1024u; const unsigned ldsb_ = (unsigned)(uintptr_t)lds + ldsw;
#define PT_SA(b, h) (((b) * 2 + (h)) * HTB)
#define PT_SB(b, h) ((4 + (b) * 2 + (h)) * HTB)
#define PT_STAGE(bufoff, gbase) do { _Pragma("unroll") for (int _i = 0; _i < 2; ++_i) { const char* gb_ = (const char*)(gbase) + _i * 8192; \
        asm volatile("s_mov_b32 m0, %0\n\ts_nop 0\n\tglobal_load_lds_dwordx4 %1, %2" :: "s"(ldsb_ + (unsigned)((bufoff) + _i * 8192)), "v"(voff[0]), "s"(gb_) : "memory", "m0"); } } while (0)
#define PT_LDA(F8, b, h) do { if constexpr (F8) { _Pragma("unroll") for (int m = 0; m < 4; ++m) { const bf16x8 lo_ = *(const PG8_LAS bf16x8*)(lds + PT_SA(b, h) + aoff + m * 2048), hi_ = *(const PG8_LAS bf16x8*)(lds + PT_SA(b, h) + aoff + m * 2048 + 1024); \
        At8[m] = __builtin_shufflevector(lo_, hi_, 0, 1, 2, 3, 4, 5, 6, 7, 8, 9, 10, 11, 12, 13, 14, 15); } } \
      else { _Pragma("unroll") for (int m = 0; m < 4; ++m) _Pragma("unroll") for (int k = 0; k < 2; ++k) At[m][k] = *(const PG8_LAS bf16x8*)(lds + PT_SA(b, h) + aoff + m * 2048 + k * 1024); } } while (0)
#define PT_LDB(F8, dst, b, h) do { if constexpr (F8) { _Pragma("unroll") for (int n = 0; n < 2; ++n) { const bf16x8 lo_ = *(const PG8_LAS bf16x8*)(lds + PT_SB(b, h) + boff + n * 2048), hi_ = *(const PG8_LAS bf16x8*)(lds + PT_SB(b, h) + boff + n * 2048 + 1024); \
        dst##8[n] = __builtin_shufflevector(lo_, hi_, 0, 1, 2, 3, 4, 5, 6, 7, 8, 9, 10, 11, 12, 13, 14, 15); } } \
      else { _Pragma("unroll") for (int n = 0; n < 2; ++n) _Pragma("unroll") for (int k = 0; k < 2; ++k) dst[n][k] = *(const PG8_LAS bf16x8*)(lds + PT_SB(b, h) + boff + n * 2048 + k * 1024); } } while (0)
#define PT_MMA(F8, ai, bj, Bt) do { __builtin_amdgcn_s_setprio(1); if constexpr (F8) { _Pragma("unroll") for (int m = 0; m < 4; ++m) _Pragma("unroll") for (int n = 0; n < 2; ++n) \
        acc[ai][bj][m][n] = __builtin_amdgcn_mfma_scale_f32_16x16x128_f8f6f4(__builtin_bit_cast(i32x8v, Bt##8[n]), __builtin_bit_cast(i32x8v, At8[m]), acc[ai][bj][m][n], 0, 0, 0, 0x78787878, 0, 0x7f7f7f7f); } \
      else { _Pragma("unroll") for (int m = 0; m < 4; ++m) _Pragma("unroll") for (int n = 0; n < 2; ++n) _Pragma("unroll") for (int k = 0; k < 2; ++k) \
        acc[ai][bj][m][n] = __builtin_amdgcn_mfma_f32_16x16x32_bf16(Bt[n][k], At[m][k], acc[ai][bj][m][n], 0, 0, 0); } __builtin_amdgcn_s_setprio(0); } while (0)
#define PT_WV asm volatile("s_waitcnt vmcnt(8)" ::: "memory")
#define PT_WL asm volatile("s_waitcnt lgkmcnt(0)" ::: "memory")
#define PT_BAR __builtin_amdgcn_s_barrier()
#define PT_SCHED __builtin_amdgcn_sched_barrier(0)
#define PT_BODY(F8) do { \
            PT_LDB(F8, B0, 0, 0); PT_LDB(F8, B1, 0, 1); PT_SCHED; PT_LDA(F8, 0, 0); PT_STAGE(PT_SA(1, 1), a1 + hstep); \
            PT_WV; PT_WL; PT_BAR; PT_MMA(F8, 0, 0, B0); PT_MMA(F8, 0, 1, B1); PT_BAR; PT_SCHED; \
            PT_LDA(F8, 0, 1); PT_STAGE(PT_SB(0, 0), b2); PT_STAGE(PT_SB(0, 1), b2 + hstep); PT_STAGE(PT_SA(0, 0), a2); \
            PT_WV; PT_WL; PT_BAR; PT_MMA(F8, 1, 0, B0); PT_MMA(F8, 1, 1, B1); PT_BAR; PT_SCHED; \
            PT_LDB(F8, B0, 1, 0); PT_LDB(F8, B1, 1, 1); PT_SCHED; PT_LDA(F8, 1, 0); PT_STAGE(PT_SA(0, 1), a2 + hstep); \
            PT_WV; PT_WL; PT_BAR; PT_MMA(F8, 0, 0, B0); PT_MMA(F8, 0, 1, B1); PT_BAR; PT_SCHED; \
            PT_LDA(F8, 1, 1); PT_STAGE(PT_SB(1, 0), b3); PT_STAGE(PT_SB(1, 1), b3 + hstep); PT_STAGE(PT_SA(1, 0), a3); \
            PT_WV; PT_WL; PT_BAR; PT_MMA(F8, 1, 0, B0); PT_MMA(F8, 1, 1, B1); PT_BAR; PT_SCHED; } while (0)
    Unit cur, nxt; int ui = 0;
    if (!S.next(0, cur)) return;
    f32x4 acc[2][2][4][2];
#pragma unroll
    for (int a = 0; a < 2; ++a)
#pragma unroll
        for (int b = 0; b < 2; ++b)
#pragma unroll
            for (int m = 0; m < 4; ++m)
#pragma unroll
                for (int n = 0; n < 2; ++n) acc[a][b][m][n] = (f32x4){0.f, 0.f, 0.f, 0.f};
    bf16x8 At[4][2], B0[2][2], B1[2][2];
    bf16x16v At8[4], B08[2], B18[2];
    const char* cA = (const char*)g.A + (size_t)cur.pm * tstepA; const char* cB = (const char*)g.Bt + (size_t)cur.pn * tstepA;
    const char* cA8 = (const char*)g.A8 + (size_t)cur.pm * tstepB; const char* cB8 = (const char*)g.B8 + (size_t)cur.pn * tstepB;
    PT_STAGE(PT_SB(0, 0), cB); PT_STAGE(PT_SB(0, 1), cB + hstep); PT_STAGE(PT_SA(0, 0), cA); PT_STAGE(PT_SA(0, 1), cA + hstep);
    if (wr == 1) PT_BAR;
    asm volatile("s_waitcnt vmcnt(2)" ::: "memory"); PT_BAR;
    PT_STAGE(PT_SB(1, 0), cB + kstep); PT_STAGE(PT_SA(1, 0), cA + kstep); PT_STAGE(PT_SB(1, 1), cB + hstep + kstep);
    asm volatile("s_waitcnt vmcnt(6)" ::: "memory"); PT_BAR;
    for (;;) {
        const bool has_next = S.next(ui + 1, nxt);
        const char* nA = has_next ? (const char*)g.A + (size_t)nxt.pm * tstepA : cA; const char* nB = has_next ? (const char*)g.Bt + (size_t)nxt.pn * tstepA : cB;
        {
            int ln_; asm volatile("v_mbcnt_lo_u32_b32 %0, -1, 0\n\tv_mbcnt_hi_u32_b32 %0, -1, %0" : "=&v"(ln_));
            const int aoff = lds_byte(wr * 64 + (ln_ & 15), (ln_ >> 4) * 8), boff = lds_byte(wc * 32 + (ln_ & 15), (ln_ >> 4) * 8);
            for (int t = 0; t < ntA; t += 2) { const bool last = (t == ntA - 2);
                const char* a1 = cA + (size_t)(t + 1) * kstep;
                const char* a2 = last ? cA8 : cA + (size_t)(t + 2) * kstep; const char* b2 = last ? cB8 : cB + (size_t)(t + 2) * kstep;
                const char* a3 = a2 + kstep; const char* b3 = b2 + kstep;
                PT_BODY(false); } }
        {
            int ln_; asm volatile("v_mbcnt_lo_u32_b32 %0, -1, 0\n\tv_mbcnt_hi_u32_b32 %0, -1, %0" : "=&v"(ln_));
            const int aoff = wr * 8192 + ln_ * 16, boff = wc * 4096 + ln_ * 16;
            for (int t = 0; t < ntB; t += 2) { const bool last = (t == ntB - 2);
                const char* a1 = cA8 + (size_t)(t + 1) * kstep;
                const char* a2 = last ? nA : cA8 + (size_t)(t + 2) * kstep; const char* b2 = last ? nB : cB8 + (size_t)(t + 2) * kstep;
                const char* a3 = a2 + kstep; const char* b3 = b2 + kstep;
                PT_BODY(true); } }
        if (wr == 0) PT_BAR;
        { int ln_; asm volatile("v_mbcnt_lo_u32_b32 %0, -1, 0\n\tv_mbcnt_hi_u32_b32 %0, -1, %0" : "=&v"(ln_)); E(acc, cur, wr, wc, ln_ & 15, ln_ >> 4); }
        if (!has_next) break;
#pragma unroll
        for (int a = 0; a < 2; ++a)
#pragma unroll
            for (int b = 0; b < 2; ++b)
#pragma unroll
                for (int m = 0; m < 4; ++m)
#pragma unroll
                    for (int n = 0; n < 2; ++n) acc[a][b][m][n] = (f32x4){0.f, 0.f, 0.f, 0.f};
        cur = nxt; cA = nA; cB = nB; cA8 = (const char*)g.A8 + (size_t)cur.pm * tstepB; cB8 = (const char*)g.B8 + (size_t)cur.pn * tstepB; ++ui;
        if (wr == 1) PT_BAR;
    }
    asm volatile("s_waitcnt vmcnt(0)" ::: "memory");
    PT_BAR;
#undef PT_SA
#undef PT_SB
#undef PT_STAGE
#undef PT_LDA
#undef PT_LDB
#undef PT_MMA
#undef PT_WV
#undef PT_WL
#undef PT_BAR
#undef PT_SCHED
#undef PT_BODY
}
}

#ifndef PG8_SP2
#define PG8_SP2 true
#endif
#ifndef PG8_ALIGN
#define PG8_ALIGN true
#endif
#ifndef PROBE_MASK
#define PROBE_MASK 0
#endif
#ifndef WGM_DOWN
#define WGM_DOWN 4
#endif
#ifndef PROBE_VAR
#define PROBE_VAR 0
#endif
constexpr int DN8_PN = 12;
constexpr int DN8_KT = 86 - DN8_PN;
#ifndef MK_N_LAUNCHES
#define MK_N_LAUNCHES 1
#endif

constexpr int D = 4096, DFF = 11008, NUP = 2 * DFF, NIN = 10240, AW = 2048, LW = 2048;
constexpr int MP = 16384, MS = 8192, MTOK = MP + MS;
constexpr int NMEM = 9 * 256;
constexpr int XAW = 512;
constexpr float EPS = 1e-6f;
constexpr int NWAVES = 8;
constexpr int N_PHASES = 13;

constexpr size_t MiB = 1u << 20;
constexpr size_t WS_CTL = 0, CTL_ZERO_BYTES = 2 * MiB;
constexpr size_t WS_WG = 2 * MiB, WS_WQ = 4 * MiB, WS_WKV = 8 * MiB, WS_WO = 16 * MiB, WS_MEMN = 20 * MiB;
constexpr size_t WS_WOUT = 38 * MiB, WS_WIN = 70 * MiB, WS_WUP1 = 150 * MiB, WS_WDN1 = 322 * MiB, WS_WUP2 = 408 * MiB, WS_WDN2 = 580 * MiB;
constexpr size_t WS_XN = 666 * MiB, WS_YA = WS_XN, WS_HF = WS_XN + 96 * MiB;
constexpr size_t WS_Y = 858 * MiB, WS_HB = 1050 * MiB, WS_PROJ = WS_HB, WS_XQ = WS_HB, WS_XO = WS_HB + 24 * MiB, WS_KVM = WS_HB + 48 * MiB;
constexpr size_t WS_HBK = 1566 * MiB, WS_END = 1662 * MiB;
static_assert(WS_WUP1 + (size_t)NUP * D * 2 <= WS_WDN1 && WS_WDN1 + (size_t)D * DFF * 2 <= WS_WUP2 && WS_WUP2 + (size_t)NUP * D * 2 <= WS_WDN2 && WS_WDN2 + (size_t)D * DFF * 2 <= WS_XN, "ws map (ffn weights)");
static_assert(WS_XN + (size_t)MTOK * D * 2 <= WS_Y && WS_Y + (size_t)MTOK * D * 2 <= WS_HB && WS_HB + (size_t)MTOK * DFF * 2 <= WS_HBK && WS_HBK + (size_t)MTOK * LW * 2 <= WS_END, "ws map (activations)");
static_assert(WS_MEMN + (size_t)NMEM * D * 2 <= WS_WOUT && WS_WOUT + (size_t)D * D * 2 <= WS_WIN && WS_WIN + (size_t)NIN * D * 2 <= WS_WUP1, "ws map (small)");
constexpr int CW_NACTR = 64;
constexpr int CW_CONVCTR = 256;
constexpr int CW_BAR = 4096;
constexpr int CW_SS = 16384;
static_assert((CW_SS + 6 * MTOK * 2) * 4 <= (int)CTL_ZERO_BYTES, "CTL words inside the memset region");

constexpr int RING_OFF = 0, RING_BYTES = 131072;
constexpr int LDSCTL_OFF = RING_BYTES, MISC_OFF = LDSCTL_OFF + 320;
constexpr int LDS_BYTES = 147456;
constexpr int XBPTR_LDS_OFF = RING_BYTES + 320 + 80;
constexpr int NA_BIAS_OFF = RING_BYTES + 1024;

#define GAS __attribute__((address_space(1)))
#define LAS __attribute__((address_space(3)))
typedef unsigned short bf16;
typedef unsigned v4u __attribute__((ext_vector_type(4)));
typedef unsigned v2u __attribute__((ext_vector_type(2)));
typedef float f32x4 __attribute__((ext_vector_type(4)));
typedef GAS unsigned gu32;
#define LDS_WAIT() asm volatile("s_waitcnt lgkmcnt(0)" ::: "memory")
#define VM_WAIT() asm volatile("s_waitcnt vmcnt(0)" ::: "memory")
__device__ __forceinline__ unsigned f2bf(float f) { unsigned u = __builtin_bit_cast(unsigned, f); return (u + 0x7fffu + ((u >> 16) & 1u)) >> 16; }
__device__ __forceinline__ unsigned pk2(float lo, float hi) { return f2bf(lo) | (f2bf(hi) << 16); }
__device__ __forceinline__ float bflo(unsigned w) { return __uint_as_float(w << 16); }
__device__ __forceinline__ float bfhi(unsigned w) { return __uint_as_float(w & 0xffff0000u); }
__device__ __forceinline__ float bf2f(bf16 b) { return __uint_as_float(((unsigned)b) << 16); }
__device__ __forceinline__ float wave_sum(float v) {
#pragma unroll
    for (int o = 1; o < 64; o <<= 1) v += __shfl_xor(v, o);
    return v;
}
__device__ __forceinline__ void unpack8(const v4u w, float (&f)[8]) { f[0] = bflo(w.x); f[1] = bfhi(w.x); f[2] = bflo(w.y); f[3] = bfhi(w.y); f[4] = bflo(w.z); f[5] = bfhi(w.z); f[6] = bflo(w.w); f[7] = bfhi(w.w); }

namespace pg8 {
typedef unsigned long long ssq_t;
__device__ __forceinline__ float ss_get(const ssq_t* p) { const ssq_t v = *p; return ((float)(unsigned)(v >> 32) * 4294967296.0f + (float)(unsigned)v) * (1.0f / 65536.0f); }
__device__ __forceinline__ ssq_t ss_fix(float s) { return (ssq_t)(s * 65536.0f); }
__device__ __forceinline__ float ss_val(ssq_t v) { return ((float)(unsigned)(v >> 32) * 4294967296.0f + (float)(unsigned)v) * (1.0f / 65536.0f); }
struct EpiSwiGLU {
    static constexpr bool PERM = true, AFTER_DRAIN = false; static constexpr int NVM_MIN = 8;
    bf16_t* H; const ssq_t* ss; int pn8; float rsc; char* H8;
    __device__ __forceinline__ void operator()(const f32x4 (&acc)[2][2][4][2], const Unit& u, int wr, int wc, int fr, int fq) const {
        const int row0 = u.pm * BM + wr * 64 + fr, col0 = u.pn * HALF + wc * 32 + 8 * fq;
        ssq_t sv[2][4];
#pragma unroll
        for (int ai = 0; ai < 2; ++ai)
#pragma unroll
            for (int m = 0; m < 4; ++m) sv[ai][m] = ss[row0 + ai * HALF + m * 16];
#pragma unroll
        for (int ai = 0; ai < 2; ++ai)
#pragma unroll
            for (int m = 0; m < 4; ++m) { const int row = row0 + ai * HALF + m * 16; const float rs = rsqrtf(ss_val(sv[ai][m]) * (1.0f / 4096.0f) + 1e-6f) * rsc;
                float hv[8]; const float nlr = -1.4426950408889634f * rs, rs2 = rs * rs;
#pragma unroll
                for (int n = 0; n < 2; ++n)
#pragma unroll
                    for (int j = 0; j < 4; j += 2) { const f32x2 a2 = {acc[ai][0][m][n][j], acc[ai][0][m][n][j + 1]}, b2 = {acc[ai][1][m][n][j], acc[ai][1][m][n][j + 1]};
                        const f32x2 t = a2 * nlr; f32x2 e; e.x = __builtin_amdgcn_exp2f(t.x); e.y = __builtin_amdgcn_exp2f(t.y);
                        const f32x2 d = e + 1.0f; f32x2 s; s.x = __builtin_amdgcn_rcpf(d.x); s.y = __builtin_amdgcn_rcpf(d.y);
                        const f32x2 r = (a2 * b2) * (s * rs2); hv[4 * n + j] = r.x; hv[4 * n + j + 1] = r.y; }
                if (u.pn >= pn8) { int w0 = 0, w1 = 0; w0 = __builtin_amdgcn_cvt_pk_fp8_f32(hv[0], hv[1], w0, false); w0 = __builtin_amdgcn_cvt_pk_fp8_f32(hv[2], hv[3], w0, true);
                    w1 = __builtin_amdgcn_cvt_pk_fp8_f32(hv[4], hv[5], w1, false); w1 = __builtin_amdgcn_cvt_pk_fp8_f32(hv[6], hv[7], w1, true);
                    typedef int i32x2v __attribute__((ext_vector_type(2))); *(i32x2v*)(H8 + blk8_off(row, col0 - pn8 * HALF, 86 - pn8)) = (i32x2v){w0, w1}; }
                else { u32x4 w; w.x = cvt_pk_bf16(hv[0], hv[1]); w.y = cvt_pk_bf16(hv[2], hv[3]); w.z = cvt_pk_bf16(hv[4], hv[5]); w.w = cvt_pk_bf16(hv[6], hv[7]);
                    *(u32x4*)((char*)H + blk_off(row, col0, 172)) = w; } }
    }
};
struct EpiNull {
    static constexpr bool PERM = true, AFTER_DRAIN = false; static constexpr int NVM_MIN = 0;
    __device__ __forceinline__ void operator()(const f32x4 (&acc)[2][2][4][2], const Unit&, int, int, int, int) const {
#pragma unroll
        for (int a = 0; a < 2; ++a)
#pragma unroll
            for (int b = 0; b < 2; ++b)
#pragma unroll
                for (int m = 0; m < 4; ++m)
#pragma unroll
                    for (int n = 0; n < 2; ++n) asm volatile("" :: "v"(acc[a][b][m][n])); }
};
template <class E_> struct EpiTwice {
    static constexpr bool PERM = E_::PERM, AFTER_DRAIN = false; static constexpr int NVM_MIN = E_::NVM_MIN; E_ e;
    __device__ __forceinline__ void operator()(const f32x4 (&acc)[2][2][4][2], const Unit& u, int wr, int wc, int fr, int fq) const { e(acc, u, wr, wc, fr, fq); asm volatile("" ::: "memory"); e(acc, u, wr, wc, fr, fq); }
};
struct EpiResid {
    static constexpr bool PERM = true, AFTER_DRAIN = false; static constexpr int NVM_MIN = 16;
    bf16_t* xb; ssq_t* ssout; char* x8; float alpha;
    __device__ __forceinline__ void operator()(const f32x4 (&acc)[2][2][4][2], const Unit& u, int wr, int wc, int fr, int fq) const {
        const int row0 = u.pm * BM + wr * 64 + fr, col0 = u.pn * BM + wc * 32 + 8 * fq;
        bf16_t* xb = this->xb;
        if (!xb) {
            const unsigned lo_ = __builtin_amdgcn_readfirstlane(*(volatile PG8_LAS unsigned*)(PG8_LAS unsigned char*)(uintptr_t)XBPTR_LDS_OFF), hi_ = __builtin_amdgcn_readfirstlane(*(volatile PG8_LAS unsigned*)(PG8_LAS unsigned char*)(uintptr_t)(XBPTR_LDS_OFF + 4));
            xb = (bf16_t*)(((unsigned long long)hi_ << 32) | lo_); }
        u32x4 xv[2][4][2];
#pragma unroll
        for (int ai = 0; ai < 2; ++ai)
#pragma unroll
            for (int m = 0; m < 4; ++m)
#pragma unroll
                for (int bj = 0; bj < 2; ++bj) { unsigned long long o_ = blk_off(row0 + ai * HALF + m * 16, col0 + bj * HALF, 64); asm volatile("" : "+v"(o_)); xv[ai][m][bj] = *(const u32x4*)((const char*)xb + o_); }
#pragma unroll
        for (int ai = 0; ai < 2; ++ai)
#pragma unroll
            for (int m = 0; m < 4; ++m) { const int row = row0 + ai * HALF + m * 16; float sq = 0.f;
#pragma unroll
                for (int bj = 0; bj < 2; ++bj) { unsigned long long o_ = blk_off(row, col0 + bj * HALF, 64); asm volatile("" : "+v"(o_));
                    u32x4* p = (u32x4*)((char*)xb + o_); const u32x4 xi = xv[ai][m][bj];
                    const f32x4 a0 = acc[ai][bj][m][0] * alpha, a1 = acc[ai][bj][m][1] * alpha;
                    const float v0 = __uint_as_float(xi.x << 16) + a0[0], v1 = __uint_as_float(xi.x & 0xffff0000u) + a0[1], v2 = __uint_as_float(xi.y << 16) + a0[2], v3 = __uint_as_float(xi.y & 0xffff0000u) + a0[3];
                    const float v4 = __uint_as_float(xi.z << 16) + a1[0], v5 = __uint_as_float(xi.z & 0xffff0000u) + a1[1], v6 = __uint_as_float(xi.w << 16) + a1[2], v7 = __uint_as_float(xi.w & 0xffff0000u) + a1[3];
                    sq += ((v0 * v0 + v1 * v1) + (v2 * v2 + v3 * v3)) + ((v4 * v4 + v5 * v5) + (v6 * v6 + v7 * v7));
                    u32x4 w; w.x = cvt_pk_bf16(v0, v1); w.y = cvt_pk_bf16(v2, v3); w.z = cvt_pk_bf16(v4, v5); w.w = cvt_pk_bf16(v6, v7); *p = w;
                    if (x8) { int w0 = 0, w1 = 0; w0 = __builtin_amdgcn_cvt_pk_fp8_f32(v0, v1, w0, false); w0 = __builtin_amdgcn_cvt_pk_fp8_f32(v2, v3, w0, true); w1 = __builtin_amdgcn_cvt_pk_fp8_f32(v4, v5, w1, false); w1 = __builtin_amdgcn_cvt_pk_fp8_f32(v6, v7, w1, true);
                        typedef int i32x2v __attribute__((ext_vector_type(2))); *(i32x2v*)(x8 + blk8_off(row, col0 + bj * HALF, 32)) = (i32x2v){w0, w1}; } }
                { const int la_ = (fq * 16 + fr) << 2;
                  sq += __builtin_bit_cast(float, __builtin_amdgcn_ds_bpermute(la_ ^ 64, __builtin_bit_cast(int, sq))); sq += __builtin_bit_cast(float, __builtin_amdgcn_ds_bpermute(la_ ^ 128, __builtin_bit_cast(int, sq))); }
                if (fq == 0 && ssout) atomicAdd(ssout + row, ss_fix(sq)); }
    }
};
struct EpiScaleBf16 {
    static constexpr bool PERM = true, AFTER_DRAIN = false; static constexpr int NVM_MIN = 16;
    bf16_t* O; int ldc; const ssq_t* ss; float qscale; int qcols;
    __device__ __forceinline__ void operator()(const f32x4 (&acc)[2][2][4][2], const Unit& u, int wr, int wc, int fr, int fq) const {
        const int row0 = u.pm * BM + wr * 64 + fr, col0 = u.pn * BM + wc * 32 + 8 * fq;
        const float sc = (u.pn * BM < qcols) ? qscale : 1.0f;
        ssq_t sv[2][4];
#pragma unroll
        for (int ai = 0; ai < 2; ++ai)
#pragma unroll
            for (int m = 0; m < 4; ++m) sv[ai][m] = ss ? ss[row0 + ai * HALF + m * 16] : 0ull;
#pragma unroll
        for (int ai = 0; ai < 2; ++ai)
#pragma unroll
            for (int m = 0; m < 4; ++m) { const int row = row0 + ai * HALF + m * 16; const float rs = (ss ? rsqrtf(ss_val(sv[ai][m]) * (1.0f / 4096.0f) + 1e-6f) : 1.0f) * sc;
                bf16_t* rowp = O + (size_t)row * ldc + col0;
#pragma unroll
                for (int bj = 0; bj < 2; ++bj) { const f32x4 v0 = acc[ai][bj][m][0] * rs, v1 = acc[ai][bj][m][1] * rs;
                    u32x4 w; w.x = cvt_pk_bf16(v0[0], v0[1]); w.y = cvt_pk_bf16(v0[2], v0[3]); w.z = cvt_pk_bf16(v1[0], v1[1]); w.w = cvt_pk_bf16(v1[2], v1[3]);
                    *(u32x4*)(rowp + bj * HALF) = w; } }
    }
};
struct EpiProj {
    static constexpr bool PERM = true, AFTER_DRAIN = false; static constexpr int NVM_MIN = 16;
    bf16_t* QKVH; bf16_t* UG; const ssq_t* ss; float qscale;
    __device__ __forceinline__ void operator()(const f32x4 (&acc)[2][2][4][2], const Unit& u, int wr, int wc, int fr, int fq) const {
        const int row0 = u.pm * BM + wr * 64 + fr, dimoff = wc * 32 + 8 * fq;
        const int kind = u.pn >> 3; const float sc = (kind == 0) ? qscale : 1.0f;
        ssq_t sv[2][4];
#pragma unroll
        for (int ai = 0; ai < 2; ++ai)
#pragma unroll
            for (int m = 0; m < 4; ++m) sv[ai][m] = ss[row0 + ai * HALF + m * 16];
#pragma unroll
        for (int ai = 0; ai < 2; ++ai)
#pragma unroll
            for (int m = 0; m < 4; ++m) { const int row = row0 + ai * HALF + m * 16; const float rs = rsqrtf(ss_val(sv[ai][m]) * (1.0f / 4096.0f) + 1e-6f) * sc;
#pragma unroll
                for (int bj = 0; bj < 2; ++bj) { const f32x4 v0 = acc[ai][bj][m][0] * rs, v1 = acc[ai][bj][m][1] * rs;
                    u32x4 w; w.x = cvt_pk_bf16(v0[0], v0[1]); w.y = cvt_pk_bf16(v0[2], v0[3]); w.z = cvt_pk_bf16(v1[0], v1[1]); w.w = cvt_pk_bf16(v1[2], v1[3]);
                    bf16_t* p = (u.pn < 24) ? QKVH + ((size_t)(kind * 16 + 2 * (u.pn & 7) + bj) * 24576 + row) * 128 + dimoff
                                            : UG + (size_t)row * 4096 + (u.pn - 24) * 256 + bj * HALF + dimoff;
                    *(u32x4*)p = w; } }
    }
};
}

__device__ __forceinline__ void transpose_item(const float* W, int K, int N, bf16* WTd, int k0, int n0, LAS float* scr, int lane) {
#pragma unroll 8
    for (int i = 0; i < 32; ++i) { const int kk = 2 * i + (lane >> 5); scr[kk * 33 + (lane & 31)] = W[(size_t)(k0 + kk) * N + n0 + (lane & 31)]; }
    LDS_WAIT(); asm volatile("" ::: "memory");
    const int c = lane & 7;
#pragma unroll
    for (int j = 0; j < 4; ++j) { const int n = (lane >> 3) + 8 * j; const LAS float* s = scr + (8 * c) * 33 + n;
        v4u o; o.x = pk2(s[0 * 33], s[1 * 33]); o.y = pk2(s[2 * 33], s[3 * 33]); o.z = pk2(s[4 * 33], s[5 * 33]); o.w = pk2(s[6 * 33], s[7 * 33]);
        *(GAS v4u*)(WTd + (size_t)n * K + k0 + 8 * c) = o; }
    LDS_WAIT(); asm volatile("" ::: "memory");
}
__device__ __forceinline__ void transpose_item_blk(const float* W, int K, int N, char* tkb, int k0, int n0, int r0, bool perm, const float* gk, LAS float* scr, int lane) {
    f32x4 v[8];
#pragma unroll
    for (int i = 0; i < 8; ++i) v[i] = *(const f32x4*)(W + (size_t)(k0 + (lane >> 3) + 8 * i) * N + n0 + (lane & 7) * 4);
#pragma unroll
    for (int i = 0; i < 8; ++i) { LAS float* d = scr + ((lane >> 3) + 8 * i) * 33 + (lane & 7) * 4; d[0] = v[i][0]; d[1] = v[i][1]; d[2] = v[i][2]; d[3] = v[i][3]; }
    const int c = lane & 7;
    f32x4 g0 = {1.f, 1.f, 1.f, 1.f}, g1 = {1.f, 1.f, 1.f, 1.f};
    if (gk) { g0 = *(const f32x4*)(gk + k0 + 8 * c); g1 = *(const f32x4*)(gk + k0 + 8 * c + 4); }
    LDS_WAIT(); asm volatile("" ::: "memory");
#pragma unroll
    for (int j = 0; j < 4; ++j) { const int n = (lane >> 3) + 8 * j; const LAS float* s = scr + (8 * c) * 33 + n;
        v4u o; o.x = pk2(s[0 * 33] * g0[0], s[1 * 33] * g0[1]); o.y = pk2(s[2 * 33] * g0[2], s[3 * 33] * g0[3]); o.z = pk2(s[4 * 33] * g1[0], s[5 * 33] * g1[1]); o.w = pk2(s[6 * 33] * g1[2], s[7 * 33] * g1[3]);
        const int rt = r0 + (perm ? pg8::perm32inv(n) : n);
        *(GAS v4u*)(tkb + ((rt >> 7) << 14) + pg8::lds_byte(rt & 127, 8 * c)) = o; }
    LDS_WAIT(); asm volatile("" ::: "memory");
}
__device__ __forceinline__ void transpose_item_f8(const float* W, int K, int N, char* tkb, int k0, int n0, int r0, bool perm, float scale, const float* gk, LAS float* scr, int lane) {
    f32x4 v[8];
#pragma unroll
    for (int i = 0; i < 8; ++i) v[i] = *(const f32x4*)(W + (size_t)(k0 + (lane >> 3) + 8 * i) * N + n0 + (lane & 7) * 4);
#pragma unroll
    for (int i = 0; i < 8; ++i) { LAS float* d = scr + ((lane >> 3) + 8 * i) * 33 + (lane & 7) * 4; d[0] = v[i][0]; d[1] = v[i][1]; d[2] = v[i][2]; d[3] = v[i][3]; }
    LDS_WAIT(); asm volatile("" ::: "memory");
    const int n = lane & 31, rt = r0 + (perm ? pg8::perm32inv(n) : n), r = rt & 127;
#pragma unroll
    for (int e = 0; e < 2; ++e) { const int c = (lane >> 5) + 2 * e; const LAS float* s = scr + (16 * c) * 33 + n; int w[4];
#pragma unroll
        for (int q = 0; q < 4; ++q) { f32x4 gq = {scale, scale, scale, scale}; if (gk) gq = *(const f32x4*)(gk + k0 + 16 * c + 4 * q) * scale;
            int t = 0; t = __builtin_amdgcn_cvt_pk_fp8_f32(s[(4 * q) * 33] * gq[0], s[(4 * q + 1) * 33] * gq[1], t, false); t = __builtin_amdgcn_cvt_pk_fp8_f32(s[(4 * q + 2) * 33] * gq[2], s[(4 * q + 3) * 33] * gq[3], t, true); w[q] = t; }
        const int c8 = ((k0 & 127) >> 4) + c;
        *(GAS v4u*)(tkb + ((rt >> 7) << 14) + (r >> 4) * 2048 + (c8 & 1) * 1024 + ((c8 >> 1) * 16 + (r & 15)) * 16) = (v4u){(unsigned)w[0], (unsigned)w[1], (unsigned)w[2], (unsigned)w[3]}; }
    LDS_WAIT(); asm volatile("" ::: "memory");
}
__device__ __forceinline__ void transpose_matrix(const float* W, int K, int N, bf16* WT, int row_off, bool perm, const float* gk, LAS float* scr, int lane, int gw, int NGW) {
    const int nblk = N / 32, nkt = K / 64, nitems = nkt * nblk;
    for (int it = gw; it < nitems; it += NGW) { const int kb = it / nblk, nb = it % nblk, drow = row_off + 32 * nb;
        transpose_item_blk(W, K, N, (char*)WT + ((size_t)((drow >> 8) * nkt + kb) << 15), 64 * kb, 32 * nb, drow & 255, perm, gk, scr, lane); }
}
__device__ __forceinline__ void transpose_up(const float* W1, const float* W3, bf16* WT, const float* gk, LAS float* scr, int lane, int gw, int NGW) {
    const int nblk = DFF / 32, nkt = D / 64, per = nkt * nblk;
    for (int it = gw; it < 2 * per; it += NGW) { const int which = it >= per, r = which ? it - per : it; const int kb = r / nblk, nb = r % nblk, n0 = 32 * nb;
        transpose_item_blk(which ? W3 : W1, D, DFF, (char*)WT + ((size_t)((n0 >> 7) * nkt + kb) << 15), 64 * kb, n0, (n0 & 127) + (which ? 128 : 0), true, gk, scr, lane); }
}

__device__ __forceinline__ float gelu_tanh(float x) { return 0.5f * x * (1.0f + tanhf(0.7978845608028654f * (x + 0.044715f * x * x * x))); }


typedef short bf16x8s __attribute__((ext_vector_type(8)));
typedef short s16x4 __attribute__((ext_vector_type(4)));
__device__ __forceinline__ s16x4 tr_read16(unsigned addr) { s16x4 r; asm volatile("ds_read_b64_tr_b16 %0, %1" : "=&v"(r) : "v"(addr) : "memory"); return r; }
template <bool IS_NA>
__device__ __forceinline__ void attn_task(const bf16* qp, const bf16* kbase, const bf16* vbase, size_t stride, int irows, const float* brow0, int c, int cs, int c0,
                                          bf16* op, int orow, int ocol, LAS unsigned char* wl, int lane) {
    const int fr = lane & 15, fq = lane >> 4;
    bf16x8s qf[4];
#pragma unroll
    for (int ks = 0; ks < 4; ++ks) qf[ks] = *(const bf16x8s*)(qp + 32 * ks);
    f32x4 S[8][2];
    bf16x8s kr[3][2][4];
#define AT_LOADK(slot, i) do { _Pragma("unroll") for (int hh = 0; hh < 2; ++hh) _Pragma("unroll") for (int ks = 0; ks < 4; ++ks) \
        kr[slot][hh][ks] = *(const bf16x8s*)(kbase + (size_t)((i) * irows + 4 * hh) * stride + 32 * ks); } while (0)
#define AT_SCORE(slot, i) do { _Pragma("unroll") for (int hh = 0; hh < 2; ++hh) { f32x4 a_ = {0.f, 0.f, 0.f, 0.f}; \
        _Pragma("unroll") for (int ks = 0; ks < 4; ++ks) a_ = __builtin_amdgcn_mfma_f32_16x16x32_bf16(kr[slot][hh][ks], qf[ks], a_, 0, 0, 0); S[i][hh] = a_; } } while (0)
    v4u vr[3][8];
#define AT_LOADV(slot, i) do { _Pragma("unroll") for (int inst = 0; inst < 8; ++inst) vr[slot][inst] = *(const v4u*)(vbase + (size_t)((i) * irows + 4 * inst) * stride); } while (0)
    AT_LOADK(0, 0); AT_LOADK(1, 1); AT_LOADK(2, 2);
    __builtin_amdgcn_sched_barrier(0);
#pragma unroll
    for (int i = 0; i < 8; ++i) {
        AT_SCORE(i % 3, i); __builtin_amdgcn_sched_barrier(0);
        if (i + 3 < 8) { AT_LOADK(i % 3, i + 3); } else { AT_LOADV(i - 5, i - 5); }
        __builtin_amdgcn_sched_barrier(0);
    }
#undef AT_LOADK
#undef AT_SCORE
    float mx = -1e30f;
#pragma unroll
    for (int hh = 0; hh < 2; ++hh)
#pragma unroll
        for (int j = 0; j < 4; ++j) {
            bool ok = true; int bi = 0;
            if (IS_NA) { const int kc = c0 + 8 * fq + 4 * hh + j; ok = (kc >= cs) && (kc < cs + 16); bi = min(max(kc - c + 15, 0), 30); }
#pragma unroll
            for (int i = 0; i < 8; ++i) { float s = S[i][hh][j]; if (IS_NA) { s = ok ? s + brow0[i * 31 + bi] : -1e30f; S[i][hh][j] = s; } mx = fmaxf(mx, s); } }
    mx = fmaxf(mx, __shfl_xor(mx, 16)); mx = fmaxf(mx, __shfl_xor(mx, 32));
    float l = 0.f;
    v4u pw[8];
#pragma unroll
    for (int i = 0; i < 8; ++i) {
#pragma unroll
        for (int hh = 0; hh < 2; ++hh)
#pragma unroll
            for (int j = 0; j < 4; ++j) { const float p = __builtin_amdgcn_exp2f((S[i][hh][j] - mx) * 1.4426950408889634f); S[i][hh][j] = p; l += p; }
        pw[i].x = pg8::cvt_pk_bf16(S[i][0][0], S[i][0][1]); pw[i].y = pg8::cvt_pk_bf16(S[i][0][2], S[i][0][3]); pw[i].z = pg8::cvt_pk_bf16(S[i][1][0], S[i][1][1]); pw[i].w = pg8::cvt_pk_bf16(S[i][1][2], S[i][1][3]); }
    l += __shfl_xor(l, 16); l += __shfl_xor(l, 32);
    const int rho0 = lane >> 4, ch = lane & 15, q_ = (lane & 15) >> 2, p_ = lane & 3;
    const unsigned wbase = (unsigned)(uintptr_t)wl;
    unsigned rrow[2], rf[2];
#pragma unroll
    for (int h2 = 0; h2 < 2; ++h2) { const int row = 8 * fq + 4 * h2 + q_; rrow[h2] = wbase + 256u * row + 8u * (p_ & 1); rf[h2] = (unsigned)((q_ << 2) | ((2 * fq + h2) & 3)); }
    f32x4 O[8];
#pragma unroll
    for (int dt = 0; dt < 8; ++dt) O[dt] = (f32x4){0.f, 0.f, 0.f, 0.f};
#pragma unroll
    for (int i = 0; i < 8; ++i) {
#pragma unroll
        for (int inst = 0; inst < 8; ++inst) { const int rho = rho0 + 4 * inst; const int f = (rho0 << 2) | (inst & 3); *(LAS v4u*)(wl + 256 * rho + 16 * (ch ^ f)) = vr[i % 3][inst]; }
        if (i + 3 < 8) { AT_LOADV(i % 3, i + 3); }
        const bf16x8s pf = __builtin_bit_cast(bf16x8s, pw[i]);
        s16x4 lo[8], hi[8];
#pragma unroll
        for (int dt = 0; dt < 8; ++dt) { lo[dt] = tr_read16(rrow[0] + 16u * ((unsigned)(2 * dt + (p_ >> 1)) ^ rf[0])); hi[dt] = tr_read16(rrow[1] + 16u * ((unsigned)(2 * dt + (p_ >> 1)) ^ rf[1])); }
        asm volatile("s_waitcnt lgkmcnt(0)" ::: "memory"); __builtin_amdgcn_sched_barrier(0);
#pragma unroll
        for (int dt = 0; dt < 8; ++dt) { const bf16x8s vf = (bf16x8s){lo[dt][0], lo[dt][1], lo[dt][2], lo[dt][3], hi[dt][0], hi[dt][1], hi[dt][2], hi[dt][3]};
            O[dt] = __builtin_amdgcn_mfma_f32_16x16x32_bf16(vf, pf, O[dt], 0, 0, 0); }
    }
#undef AT_LOADV
    const float inv = 1.0f / l;
#pragma unroll
    for (int dt = 0; dt < 8; ++dt) { const f32x4 v = O[dt] * inv; v2u o; o.x = pg8::cvt_pk_bf16(v[0], v[1]); o.y = pg8::cvt_pk_bf16(v[2], v[3]);
        if (IS_NA) *(v2u*)(op + dt * 16) = o; else *(v2u*)((char*)op + pg8::blk_off(orow, ocol + dt * 16, 8)) = o; }
}
__device__ __forceinline__ void na_block_task(int t, const bf16* PROJ, const float* rpb, bf16* YA, LAS unsigned char* lds, int wave, int lane, int dup = 0) {
    const int hp = t / 384, R = t % 384, g = wave & 3, h = 2 * hp + (dup ? 0 : (wave >> 2));
    int r, rows, seq0; if (R < 256) { seq0 = (R >> 5) * 2048; r = R & 31; rows = 32; } else { seq0 = MP; r = R - 256; rows = 128; }
    const int fr = lane & 15, fq = lane >> 4;
    const int rst = min(max(r - 4, 0), rows - 8), c0 = min(max(16 * g - 8, 0), 32), c = 16 * g + fr, cs = min(max(c - 8, 0), 48);
    const size_t m = (size_t)R * 64 + c;
    const bf16* qp = PROJ + ((size_t)h * MTOK + m) * 128 + 8 * fq;
    const bf16* kbase = PROJ + ((size_t)(16 + h) * MTOK + seq0 + rst * 64 + c0 + 8 * (fr >> 2) + (fr & 3)) * 128 + 8 * fq;
    const bf16* vbase = PROJ + ((size_t)(32 + h) * MTOK + seq0 + rst * 64 + c0 + (lane >> 4)) * 128 + (lane & 15) * 8;
    const float* brow0 = rpb + (h * 15 + (rst - r + 7)) * 31;
    attn_task<true>(qp, kbase, vbase, (size_t)128, 64, brow0, c, cs, c0, YA + m * AW + h * 128 + 4 * fq, 0, 0, lds + RING_OFF + wave * 8192, lane);
}
__device__ __forceinline__ void wait_vmcnt_n(int n) {
    switch (n) { case 0: asm volatile("s_waitcnt vmcnt(0)" ::: "memory"); break; case 2: asm volatile("s_waitcnt vmcnt(2)" ::: "memory"); break; case 4: asm volatile("s_waitcnt vmcnt(4)" ::: "memory"); break;
                 case 6: asm volatile("s_waitcnt vmcnt(6)" ::: "memory"); break; case 8: asm volatile("s_waitcnt vmcnt(8)" ::: "memory"); break; case 10: asm volatile("s_waitcnt vmcnt(10)" ::: "memory"); break;
                 case 12: asm volatile("s_waitcnt vmcnt(12)" ::: "memory"); break; default: asm volatile("s_waitcnt vmcnt(0)" ::: "memory"); break; } }
template <int OFF>
__device__ __forceinline__ void na_coop_body(const bf16* kg, const bf16* vg, int nU, const bf16* qp, const LAS float* brow0, int c, int cs, int c0, bf16* op, LAS unsigned char* lds, int wave, int lane) {
    constexpr int NR = 8;
    const int fr = lane & 15, fq = lane >> 4;
    bf16x8s qf[4];
#pragma unroll
    for (int ks = 0; ks < 4; ++ks) qf[ks] = *(const bf16x8s*)(qp + 32 * ks);
    unsigned goff[2];
#pragma unroll
    for (int e = 0; e < 2; ++e) { const int key = wave * 8 + e * 4 + (lane >> 4), chp = lane & 15, f = ((key & 3) << 2) | ((key >> 2) & 3); goff[e] = (unsigned)((key * 128 + (chp ^ f) * 8) * 2); }
#define NC_ISSUE(it) do { const int j_ = ((it) % 9) < nU ? ((it) % 9) : nU - 1; const bf16* b_ = ((it) < 9 ? kg : vg) + (size_t)j_ * 64 * 128; \
        _Pragma("unroll") for (int e_ = 0; e_ < 2; ++e_) __builtin_amdgcn_global_load_lds((const unsigned*)((const char*)b_ + goff[e_]), (LAS unsigned*)(lds + ((it) % NR) * 16384 + wave * 2048 + e_ * 1024), 16, 0, 0); } while (0)
#define NC_NWAIT(it) (2 * (((it) + NR - 2 < 17 ? (it) + NR - 2 : 17) - (it)))
#pragma unroll
    for (int s_ = 0; s_ < NR - 1; ++s_) { NC_ISSUE(s_); }
    unsigned kro[2], krf[2];
#pragma unroll
    for (int hh = 0; hh < 2; ++hh) { const int key = c0 + 8 * (fr >> 2) + 4 * hh + (fr & 3); kro[hh] = (unsigned)(256 * key); krf[hh] = (unsigned)(((key & 3) << 2) | ((key >> 2) & 3)); }
    f32x4 S[8][2];
#pragma unroll
    for (int it = 0; it < 9; ++it) {
        unsigned rb_ = (unsigned)((it % NR) * 16384); asm volatile("" : "+s"(rb_));
        LAS unsigned char* buf = lds + rb_;
        wait_vmcnt_n(NC_NWAIT(it)); __builtin_amdgcn_s_barrier(); asm volatile("" ::: "memory");
        NC_ISSUE(it + NR - 1);
        if (it - OFF >= 0 && it - OFF < 8) {
#pragma unroll
            for (int hh = 0; hh < 2; ++hh) { f32x4 a_ = {0.f, 0.f, 0.f, 0.f};
#pragma unroll
                for (int ks = 0; ks < 4; ++ks) { const bf16x8s kf = *(const LAS bf16x8s*)(buf + kro[hh] + 16u * ((unsigned)(4 * ks + fq) ^ krf[hh]));
                    a_ = __builtin_amdgcn_mfma_f32_16x16x32_bf16(kf, qf[ks], a_, 0, 0, 0); }
                S[it - OFF][hh] = a_; } }
    }
    float mx = -1e30f;
#pragma unroll
    for (int hh = 0; hh < 2; ++hh)
#pragma unroll
        for (int j = 0; j < 4; ++j) { const int kc = c0 + 8 * fq + 4 * hh + j; const bool ok = (kc >= cs) && (kc < cs + 16); const int bi = min(max(kc - c + 15, 0), 30);
#pragma unroll
            for (int i = 0; i < 8; ++i) { float s = S[i][hh][j]; s = ok ? s + brow0[i * 31 + bi] : -1e30f; S[i][hh][j] = s; mx = fmaxf(mx, s); } }
    mx = fmaxf(mx, __shfl_xor(mx, 16)); mx = fmaxf(mx, __shfl_xor(mx, 32));
    float l = 0.f; v4u pw[8];
#pragma unroll
    for (int i = 0; i < 8; ++i) {
#pragma unroll
        for (int hh = 0; hh < 2; ++hh)
#pragma unroll
            for (int j = 0; j < 4; ++j) { const float p = __builtin_amdgcn_exp2f((S[i][hh][j] - mx) * 1.4426950408889634f); S[i][hh][j] = p; l += p; }
        pw[i].x = pg8::cvt_pk_bf16(S[i][0][0], S[i][0][1]); pw[i].y = pg8::cvt_pk_bf16(S[i][0][2], S[i][0][3]); pw[i].z = pg8::cvt_pk_bf16(S[i][1][0], S[i][1][1]); pw[i].w = pg8::cvt_pk_bf16(S[i][1][2], S[i][1][3]); }
    l += __shfl_xor(l, 16); l += __shfl_xor(l, 32);
    const int q_ = (lane & 15) >> 2, p_ = lane & 3;
    unsigned vro[2], vrf[2];
#pragma unroll
    for (int h2 = 0; h2 < 2; ++h2) { const int key = c0 + 8 * fq + 4 * h2 + q_; vro[h2] = (unsigned)(256 * key + 8 * (p_ & 1)); vrf[h2] = (unsigned)(((key & 3) << 2) | ((key >> 2) & 3)); }
    f32x4 O[8];
#pragma unroll
    for (int dt = 0; dt < 8; ++dt) O[dt] = (f32x4){0.f, 0.f, 0.f, 0.f};
#pragma unroll
    for (int it = 9; it < 18; ++it) {
        unsigned rb_ = (unsigned)((it % NR) * 16384); asm volatile("" : "+s"(rb_));
        LAS unsigned char* buf = lds + rb_; const unsigned bufa = (unsigned)(uintptr_t)buf;
        wait_vmcnt_n(NC_NWAIT(it)); __builtin_amdgcn_s_barrier(); asm volatile("" ::: "memory");
        if (it + NR - 1 < 18) { NC_ISSUE(it + NR - 1); }
        if (it - 9 - OFF >= 0 && it - 9 - OFF < 8) {
            const bf16x8s pf = __builtin_bit_cast(bf16x8s, pw[it - 9 - OFF]);
            s16x4 lo[8], hi[8];
#pragma unroll
            for (int dt = 0; dt < 8; ++dt) { lo[dt] = tr_read16(bufa + vro[0] + 16u * ((unsigned)(2 * dt + (p_ >> 1)) ^ vrf[0])); hi[dt] = tr_read16(bufa + vro[1] + 16u * ((unsigned)(2 * dt + (p_ >> 1)) ^ vrf[1])); }
            asm volatile("s_waitcnt lgkmcnt(0)" ::: "memory"); __builtin_amdgcn_sched_barrier(0);
#pragma unroll
            for (int dt = 0; dt < 8; ++dt) { const bf16x8s vf = (bf16x8s){lo[dt][0], lo[dt][1], lo[dt][2], lo[dt][3], hi[dt][0], hi[dt][1], hi[dt][2], hi[dt][3]};
                O[dt] = __builtin_amdgcn_mfma_f32_16x16x32_bf16(vf, pf, O[dt], 0, 0, 0); } }
    }
#undef NC_ISSUE
#undef NC_NWAIT
    const float inv = 1.0f / l;
#pragma unroll
    for (int dt = 0; dt < 8; ++dt) { const f32x4 v = O[dt] * inv; v2u o; o.x = pg8::cvt_pk_bf16(v[0], v[1]); o.y = pg8::cvt_pk_bf16(v[2], v[3]); *(v2u*)(op + dt * 16) = o; }
}
__device__ __forceinline__ void na_coop_task(int t, const bf16* PROJ, const float* rpb, bf16* YA, LAS unsigned char* lds, int tid, int wave, int lane) {
    const int h = t / 192, rp = t % 192, R0 = 2 * rp, q = wave >> 2, g = wave & 3, R = R0 + q;
    int r0, rows, seq0; if (R0 < 256) { seq0 = (R0 >> 5) * 2048; r0 = R0 & 31; rows = 32; } else { seq0 = MP; r0 = R0 - 256; rows = 128; }
    const int fr = lane & 15, fq = lane >> 4;
    const int rstA = min(max(r0 - 4, 0), rows - 8), rstB = min(max(r0 + 1 - 4, 0), rows - 8), d = rstB - rstA, nU = 8 + d;
    const int r = r0 + q, rst = q ? rstB : rstA, off = q ? d : 0;
    const int c0 = min(max(16 * g - 8, 0), 32), c = 16 * g + fr, cs = min(max(c - 8, 0), 48);
    const size_t m = (size_t)R * 64 + c;
    const bf16* qp = PROJ + ((size_t)h * MTOK + m) * 128 + 8 * fq;
    const bf16* kg = PROJ + ((size_t)(16 + h) * MTOK + seq0 + rstA * 64) * 128;
    const bf16* vg = PROJ + ((size_t)(32 + h) * MTOK + seq0 + rstA * 64) * 128;
    LAS float* btab = (LAS float*)(lds + NA_BIAS_OFF);
    if (tid < 465) btab[tid] = rpb[h * 465 + tid];
    asm volatile("s_waitcnt lgkmcnt(0)" ::: "memory");
    const LAS float* brow0 = btab + (rst - r + 7) * 31;
    bf16* op = YA + m * AW + h * 128 + 4 * fq;
    if (off) na_coop_body<1>(kg, vg, nU, qp, brow0, c, cs, c0, op, lds + RING_OFF, wave, lane);
    else     na_coop_body<0>(kg, vg, nU, qp, brow0, c, cs, c0, op, lds + RING_OFF, wave, lane);
}
__device__ __forceinline__ void xa_coop_task(int t, const bf16* XQ, const bf16* KVM, bf16* XO, LAS unsigned char* lds, int tid, int wave, int lane) {
    const int h = t & 3, qb = t >> 2;
    const int s = (qb < 128) ? (qb >> 4) : 8;
    const int fr = lane & 15, fq = lane >> 4;
    const size_t m = (size_t)qb * 128 + wave * 16 + fr;
    const bf16* qp = XQ + m * XAW + h * 128 + 8 * fq;
    bf16x8s qf[4];
#pragma unroll
    for (int ks = 0; ks < 4; ++ks) qf[ks] = *(const bf16x8s*)(qp + 32 * ks);
    LAS unsigned char* kbuf = lds + RING_OFF; LAS unsigned char* vbuf = lds + RING_OFF + 65536;
    const bf16* kg = KVM + (size_t)(s * 256) * 1024 + h * 128;
    {
        v4u rg[8];
#pragma unroll
        for (int e = 0; e < 8; ++e) { const int cidx = tid + 512 * e, key = cidx >> 4, ch = cidx & 15; rg[e] = *(const v4u*)(kg + (size_t)key * 1024 + ch * 8); }
#pragma unroll
        for (int e = 0; e < 8; ++e) { const int cidx = tid + 512 * e, key = cidx >> 4, ch = cidx & 15, f = ((key & 3) << 2) | ((key >> 2) & 3); *(LAS v4u*)(kbuf + 256 * key + 16 * (ch ^ f)) = rg[e]; }
#pragma unroll
        for (int e = 0; e < 8; ++e) { const int cidx = tid + 512 * e, key = cidx >> 4, ch = cidx & 15; rg[e] = *(const v4u*)(kg + 512 + (size_t)key * 1024 + ch * 8); }
#pragma unroll
        for (int e = 0; e < 8; ++e) { const int cidx = tid + 512 * e, key = cidx >> 4, ch = cidx & 15, f = ((key & 3) << 2) | ((key >> 2) & 3); *(LAS v4u*)(vbuf + 256 * key + 16 * (ch ^ f)) = rg[e]; }
    }
    asm volatile("s_waitcnt lgkmcnt(0)" ::: "memory"); __builtin_amdgcn_s_barrier(); asm volatile("" ::: "memory");
    unsigned kro[2], krf[2];
#pragma unroll
    for (int hh = 0; hh < 2; ++hh) { const int key = 8 * (fr >> 2) + 4 * hh + (fr & 3); kro[hh] = (unsigned)(256 * key); krf[hh] = (unsigned)(((key & 3) << 2) | ((key >> 2) & 3)); }
    f32x4 S[8][2];
#pragma unroll
    for (int i = 0; i < 8; ++i) { unsigned ib = (unsigned)(i * 8192); asm volatile("" : "+s"(ib));
#pragma unroll
        for (int hh = 0; hh < 2; ++hh) { f32x4 a_ = {0.f, 0.f, 0.f, 0.f};
#pragma unroll
            for (int ks = 0; ks < 4; ++ks) { const bf16x8s kf = *(const LAS bf16x8s*)(kbuf + ib + kro[hh] + 16u * ((unsigned)(4 * ks + fq) ^ krf[hh]));
                a_ = __builtin_amdgcn_mfma_f32_16x16x32_bf16(kf, qf[ks], a_, 0, 0, 0); }
            S[i][hh] = a_; } }
    float mx = -1e30f;
#pragma unroll
    for (int i = 0; i < 8; ++i)
#pragma unroll
        for (int hh = 0; hh < 2; ++hh)
#pragma unroll
            for (int j = 0; j < 4; ++j) mx = fmaxf(mx, S[i][hh][j]);
    mx = fmaxf(mx, __shfl_xor(mx, 16)); mx = fmaxf(mx, __shfl_xor(mx, 32));
    float l = 0.f; v4u pw[8];
#pragma unroll
    for (int i = 0; i < 8; ++i) {
#pragma unroll
        for (int hh = 0; hh < 2; ++hh)
#pragma unroll
            for (int j = 0; j < 4; ++j) { const float p = __builtin_amdgcn_exp2f((S[i][hh][j] - mx) * 1.4426950408889634f); S[i][hh][j] = p; l += p; }
        pw[i].x = pg8::cvt_pk_bf16(S[i][0][0], S[i][0][1]); pw[i].y = pg8::cvt_pk_bf16(S[i][0][2], S[i][0][3]); pw[i].z = pg8::cvt_pk_bf16(S[i][1][0], S[i][1][1]); pw[i].w = pg8::cvt_pk_bf16(S[i][1][2], S[i][1][3]); }
    l += __shfl_xor(l, 16); l += __shfl_xor(l, 32);
    const int q_ = (lane & 15) >> 2, p_ = lane & 3;
    const unsigned vba = (unsigned)(uintptr_t)vbuf;
    unsigned vro[2], vrf[2];
#pragma unroll
    for (int h2 = 0; h2 < 2; ++h2) { const int key = 8 * fq + 4 * h2 + q_; vro[h2] = (unsigned)(256 * key + 8 * (p_ & 1)); vrf[h2] = (unsigned)(((key & 3) << 2) | ((key >> 2) & 3)); }
    f32x4 O[8];
#pragma unroll
    for (int dt = 0; dt < 8; ++dt) O[dt] = (f32x4){0.f, 0.f, 0.f, 0.f};
#pragma unroll
    for (int i = 0; i < 8; ++i) { unsigned ib = (unsigned)(i * 8192); asm volatile("" : "+s"(ib));
        const bf16x8s pf = __builtin_bit_cast(bf16x8s, pw[i]);
        s16x4 lo[8], hi[8];
#pragma unroll
        for (int dt = 0; dt < 8; ++dt) { lo[dt] = tr_read16(vba + ib + vro[0] + 16u * ((unsigned)(2 * dt + (p_ >> 1)) ^ vrf[0])); hi[dt] = tr_read16(vba + ib + vro[1] + 16u * ((unsigned)(2 * dt + (p_ >> 1)) ^ vrf[1])); }
        asm volatile("s_waitcnt lgkmcnt(0)" ::: "memory"); __builtin_amdgcn_sched_barrier(0);
#pragma unroll
        for (int dt = 0; dt < 8; ++dt) { const bf16x8s vf = (bf16x8s){lo[dt][0], lo[dt][1], lo[dt][2], lo[dt][3], hi[dt][0], hi[dt][1], hi[dt][2], hi[dt][3]};
            O[dt] = __builtin_amdgcn_mfma_f32_16x16x32_bf16(vf, pf, O[dt], 0, 0, 0); } }
    const float inv = 1.0f / l;
#pragma unroll
    for (int dt = 0; dt < 8; ++dt) { const f32x4 v = O[dt] * inv; v2u o; o.x = pg8::cvt_pk_bf16(v[0], v[1]); o.y = pg8::cvt_pk_bf16(v[2], v[3]);
        *(v2u*)((char*)XO + pg8::blk_off((int)m, h * 128 + 4 * fq + dt * 16, 8)) = o; }
}
__device__ __forceinline__ void xa_wave_task(int wt, const bf16* XQ, const bf16* KVM, bf16* XO, LAS unsigned char* lds, int wave, int lane) {
    const int qg = wt >> 2, h = wt & 3;
    const int fr = lane & 15, fq = lane >> 4;
    const size_t m = (size_t)qg * 16 + fr;
    const int s = (qg < 1024) ? (qg >> 7) : 8;
    const bf16* qp = XQ + m * XAW + h * 128 + 8 * fq;
    const bf16* kbase = KVM + (size_t)(s * 256 + 8 * (fr >> 2) + (fr & 3)) * 1024 + h * 128 + 8 * fq;
    const bf16* vbase = KVM + (size_t)(s * 256 + (lane >> 4)) * 1024 + 512 + h * 128 + (lane & 15) * 8;
    attn_task<false>(qp, kbase, vbase, (size_t)1024, 32, nullptr, 0, 0, 0, XO, (int)m, h * 128 + 4 * fq, lds + RING_OFF + wave * 8192, lane);
}

template <int DIR, int PC>
__device__ __forceinline__ void lru_unit(int s, int n, int tbeg, int ntile, const bf16* PROJ, const bf16* WG, const float* conv_w, const float* conv_b, const float* ba, const float* bx, const float* lam,
                                         bf16* Hout, bf16* Pout, LAS unsigned char* lds, int tid, int wave, int lane) {
    constexpr int RS = 272;
    const int seq0 = s < 8 ? s * 2048 : MP, T = s < 8 ? 2048 : 8192;
    const int fr = lane & 15, fq = lane >> 4;
    bf16x8s wf[2][4];
    { const bf16* wp = WG + ((size_t)(n * 2 + DIR) * 256 + 16 * wave + fr) * 128 + 8 * fq;
#pragma unroll
      for (int gi = 0; gi < 2; ++gi)
#pragma unroll
          for (int ks = 0; ks < 4; ++ks) wf[gi][ks] = *(const bf16x8s*)(wp + gi * 128 * 128 + 32 * ks); }
    const int chw = n * 128 + 16 * wave + fr;
    const float bra = -1.4426950408889634f * ba[DIR * 2048 + chw], bxi = -1.4426950408889634f * bx[DIR * 2048 + chw], sp8 = -8.0f * 1.4426950408889634f * log1pf(expf(-lam[DIR * 2048 + chw]));
    const int cp = lane, tg = wave, chc = n * 128 + 2 * cp;
    const float cw00 = conv_w[chc], cw01 = conv_w[chc + 1], cw10 = conv_w[2048 + chc], cw11 = conv_w[2048 + chc + 1], cw20 = conv_w[4096 + chc], cw21 = conv_w[4096 + chc + 1],
                cw30 = conv_w[6144 + chc], cw31 = conv_w[6144 + chc + 1], cb0 = conv_b[chc], cb1 = conv_b[chc + 1];
    const bf16* ub = PROJ + (size_t)seq0 * 4096 + chc;
    unsigned ur[11];
    { const int t0 = (tbeg + (DIR ? ntile - 1 : 0)) * 64 + 8 * tg - 1;
#pragma unroll
      for (int k = 0; k < 11; ++k) { const int t = t0 + k; ur[k] = (t >= 0 && t < T) ? *(const unsigned*)(ub + (size_t)t * 4096) : 0u; } }
    float carry = 0.f, pcar = 1.0f;
    for (int ti = 0; ti < ntile; ++ti) {
        const int tb = (tbeg + (DIR ? ntile - 1 - ti : ti)) * 64;
        LAS unsigned char* xt = lds + (ti & 1) * (64 * RS);
#pragma unroll
        for (int tt = 0; tt < 8; ++tt) {
            const float x0 = cw00 * bflo(ur[tt]) + cw10 * bflo(ur[tt + 1]) + cw20 * bflo(ur[tt + 2]) + cw30 * bflo(ur[tt + 3]) + cb0;
            const float x1 = cw01 * bfhi(ur[tt]) + cw11 * bfhi(ur[tt + 1]) + cw21 * bfhi(ur[tt + 2]) + cw31 * bfhi(ur[tt + 3]) + cb1;
            *(LAS unsigned*)(xt + (8 * tg + tt) * RS + 4 * cp) = pg8::cvt_pk_bf16(x0, x1); }
        if (ti + 1 < ntile) { const int t0 = (tbeg + (DIR ? ntile - 2 - ti : ti + 1)) * 64 + 8 * tg - 1;
#pragma unroll
            for (int k = 0; k < 11; ++k) { const int t = t0 + k; ur[k] = (t >= 0 && t < T) ? *(const unsigned*)(ub + (size_t)t * 4096) : 0u; } }
        asm volatile("s_waitcnt lgkmcnt(0)" ::: "memory"); __builtin_amdgcn_s_barrier(); asm volatile("" ::: "memory");
        f32x4 accr[4], acci[4];
#pragma unroll
        for (int m = 0; m < 4; ++m) { accr[m] = (f32x4){0.f, 0.f, 0.f, 0.f}; acci[m] = (f32x4){0.f, 0.f, 0.f, 0.f};
#pragma unroll
            for (int ks = 0; ks < 4; ++ks) { const bf16x8s af = *(const LAS bf16x8s*)(xt + (16 * m + fr) * RS + (32 * ks + 8 * fq) * 2);
                accr[m] = __builtin_amdgcn_mfma_f32_16x16x32_bf16(af, wf[0][ks], accr[m], 0, 0, 0);
                acci[m] = __builtin_amdgcn_mfma_f32_16x16x32_bf16(af, wf[1][ks], acci[m], 0, 0, 0); } }
        float av[4][4], bv[4][4];
#pragma unroll
        for (int m = 0; m < 4; ++m)
#pragma unroll
            for (int j = 0; j < 4; ++j) { const float xc = bf2f(*(const LAS bf16*)(xt + (16 * m + 4 * fq + j) * RS + (16 * wave + fr) * 2));
                const float rg = __builtin_amdgcn_rcpf(1.0f + __builtin_amdgcn_exp2f(fmaf(accr[m][j], -1.4426950408889634f, bra)));
                const float ig = __builtin_amdgcn_rcpf(1.0f + __builtin_amdgcn_exp2f(fmaf(acci[m][j], -1.4426950408889634f, bxi)));
                const float a = __builtin_amdgcn_exp2f(rg * sp8); av[m][j] = a; bv[m][j] = __builtin_amdgcn_sqrtf(fmaxf(1.0f - a * a, 0.f)) * ig * xc; }
        float Ai[4], Bi[4], Ae[4], Be[4], At[4], Bt[4];
#pragma unroll
        for (int m = 0; m < 4; ++m) {
            float A, B;
            if (DIR == 0) { A = av[m][0]; B = bv[m][0];
#pragma unroll
                for (int j = 1; j < 4; ++j) { B = B * av[m][j] + bv[m][j]; A *= av[m][j]; } }
            else { A = av[m][3]; B = bv[m][3];
#pragma unroll
                for (int j = 2; j >= 0; --j) { B = B * av[m][j] + bv[m][j]; A *= av[m][j]; } }
            Ai[m] = A; Bi[m] = B; }
        { float A1[4], B1[4];
#pragma unroll
          for (int m = 0; m < 4; ++m) { A1[m] = DIR ? __shfl_down(Ai[m], 16) : __shfl_up(Ai[m], 16); B1[m] = DIR ? __shfl_down(Bi[m], 16) : __shfl_up(Bi[m], 16); }
          const bool has = DIR ? (fq < 3) : (fq > 0);
#pragma unroll
          for (int m = 0; m < 4; ++m) if (has) { Bi[m] = Ai[m] * B1[m] + Bi[m]; Ai[m] = A1[m] * Ai[m]; } }
        { float A2[4], B2[4];
#pragma unroll
          for (int m = 0; m < 4; ++m) { A2[m] = DIR ? __shfl_down(Ai[m], 32) : __shfl_up(Ai[m], 32); B2[m] = DIR ? __shfl_down(Bi[m], 32) : __shfl_up(Bi[m], 32); }
          const bool has = DIR ? (fq < 2) : (fq > 1);
#pragma unroll
          for (int m = 0; m < 4; ++m) if (has) { Bi[m] = Ai[m] * B2[m] + Bi[m]; Ai[m] = A2[m] * Ai[m]; } }
#pragma unroll
        for (int m = 0; m < 4; ++m) {
            Ae[m] = DIR ? __shfl_down(Ai[m], 16) : __shfl_up(Ai[m], 16); Be[m] = DIR ? __shfl_down(Bi[m], 16) : __shfl_up(Bi[m], 16);
            At[m] = __shfl(Ai[m], (DIR ? 0 : 48) + fr); Bt[m] = __shfl(Bi[m], (DIR ? 0 : 48) + fr); }
        bf16* hp = Hout + (size_t)(seq0 + tb) * LW + chw; bf16* pp = Pout + (size_t)tb * LW + chw;
#pragma unroll
        for (int mm = 0; mm < 4; ++mm) { const int m = DIR ? 3 - mm : mm;
            const bool first = DIR ? (fq == 3) : (fq == 0);
            float h = first ? carry : Ae[m] * carry + Be[m]; float pv = first ? pcar : Ae[m] * pcar;
            if (DIR == 0) {
#pragma unroll
                for (int j = 0; j < 4; ++j) { h = av[m][j] * h + bv[m][j]; hp[(size_t)(16 * m + 4 * fq + j) * LW] = (bf16)pg8::cvt_pk_bf16(h, h);
                    if (PC) { pv *= av[m][j]; pp[(size_t)(16 * m + 4 * fq + j) * LW] = (bf16)pg8::cvt_pk_bf16(pv, pv); } } }
            else {
#pragma unroll
                for (int j = 3; j >= 0; --j) { h = av[m][j] * h + bv[m][j]; hp[(size_t)(16 * m + 4 * fq + j) * LW] = (bf16)pg8::cvt_pk_bf16(h, h);
                    if (PC) { pv *= av[m][j]; pp[(size_t)(16 * m + 4 * fq + j) * LW] = (bf16)pg8::cvt_pk_bf16(pv, pv); } } }
            carry = At[m] * carry + Bt[m]; if (PC) pcar *= At[m]; }
    }
    __syncthreads();
}
__device__ __forceinline__ void lru_dispatch(int u, const bf16* PROJ, const bf16* WG, const float* const* in, bf16* HF, bf16* HBk, bf16* PCA, LAS unsigned char* lds, int tid, int wave, int lane) {
    if (u < 64) { const int n = (u >> 2) & 15, e = (u >> 1) & 1, half = u & 1;
        if (e == 0) { if (half == 0) lru_unit<0, 0>(8, n, 0, 64, PROJ, WG, in[11], in[12], in[14], in[16], in[17], HF, PCA, lds, tid, wave, lane);
                      else           lru_unit<0, 1>(8, n, 64, 64, PROJ, WG, in[11], in[12], in[14], in[16], in[17], HF, PCA, lds, tid, wave, lane); }
        else        { if (half == 0) lru_unit<1, 0>(8, n, 64, 64, PROJ, WG, in[11], in[12], in[14], in[16], in[17], HBk, PCA, lds, tid, wave, lane);
                      else           lru_unit<1, 1>(8, n, 0, 64, PROJ, WG, in[11], in[12], in[14], in[16], in[17], HBk, PCA, lds, tid, wave, lane); } }
    else { const int v = u - 64, s = v >> 5, n = (v >> 1) & 15, e = v & 1;
        if (e == 0) lru_unit<0, 0>(s, n, 0, 32, PROJ, WG, in[11], in[12], in[14], in[16], in[17], HF, PCA, lds, tid, wave, lane);
        else        lru_unit<1, 0>(s, n, 0, 32, PROJ, WG, in[11], in[12], in[14], in[16], in[17], HBk, PCA, lds, tid, wave, lane); }
}

#define XB_TMO      128
#define XB_XCNT(j)  (256  + 64 * (j))
#define XB_XSUB(j)  (1280 + 64 * (j))
#define XB_XGEN(j)  (2304 + 64 * (j))
#define XB_TOP      3328
#define XB_TOPGEN   3392
#define XCD_BAR_WORDS 3456
#define XB_SPIN_CAP (1u << 18)

__device__ __forceinline__ unsigned xb_ld(unsigned* p)              { return __hip_atomic_load(p, __ATOMIC_RELAXED, __HIP_MEMORY_SCOPE_AGENT); }
__device__ __forceinline__ unsigned xb_add(unsigned* p, unsigned v) { return __hip_atomic_fetch_add(p, v, __ATOMIC_RELAXED, __HIP_MEMORY_SCOPE_AGENT); }
__device__ __forceinline__ unsigned xb_xcc_id() { return (unsigned)__builtin_amdgcn_s_getreg((3 << 11) | 20) & 0xFu; }
#define XB_SPIN(cond, bar) do { unsigned _sp = 0; while (cond) { __builtin_amdgcn_s_sleep(1); \
    if ((++_sp & 255u) == 0u) { if (xb_ld(&(bar)[XB_TMO])) break; if (_sp > XB_SPIN_CAP) { atomicAdd(&(bar)[XB_TMO], 1u); break; } } } } while (0)

struct XcdBarrier {
    unsigned* bar; unsigned x;
    volatile LAS unsigned* st;
};

__device__ __forceinline__ XcdBarrier xcd_barrier_post(unsigned* bar, volatile LAS unsigned* st) {
    XcdBarrier b; b.bar = bar; b.x = xb_xcc_id(); b.st = st;
    if (threadIdx.x == 0) (void)xb_add(&bar[XB_XCNT(b.x)], 1u);
    return b;
}
__device__ __forceinline__ void xcd_barrier_complete(unsigned* bar, unsigned x, unsigned& nloc, unsigned& nx) {
    const unsigned G = gridDim.x * gridDim.y * gridDim.z;
    unsigned sum, cnt, mine, sp = 0u;
    for (;;) {
        sum = 0u; cnt = 0u; mine = 0u;
#pragma unroll
        for (unsigned j = 0; j < 16; ++j) { const unsigned c = xb_ld(&bar[XB_XCNT(j)]); sum += c; cnt += (c > 0u) ? 1u : 0u; mine = (j == x) ? c : mine; }
        if (sum == G) break;
        __builtin_amdgcn_s_sleep(1);
        if ((++sp & 255u) == 0u) { if (xb_ld(&bar[XB_TMO])) break; if (sp > XB_SPIN_CAP) { atomicAdd(&bar[XB_TMO], 1u); break; } }
    }
    nloc = mine > 0u ? mine : 1u; nx = cnt > 0u ? cnt : 1u;
}

__device__ __forceinline__ void xcd_barrier(const XcdBarrier& b, bool wave0 = true) {
    asm volatile("s_waitcnt vmcnt(0)" ::: "memory");
    __syncthreads();
    unsigned bl_; asm volatile("v_mbcnt_lo_u32_b32 %0, -1, 0\n\tv_mbcnt_hi_u32_b32 %0, -1, %0" : "=&v"(bl_));
    if (wave0 && bl_ == 0u) {
        unsigned* bar = b.bar;
        __builtin_amdgcn_s_waitcnt(0);
        unsigned nloc = b.st[0], nx = b.st[1];
        if (nloc == 0u) { xcd_barrier_complete(bar, b.x, nloc, nx); b.st[0] = nloc; b.st[1] = nx; }
        const unsigned old = xb_add(&bar[XB_XSUB(b.x)], 1u);
        const unsigned gen = old / nloc;
        if (old + 1u == (gen + 1u) * nloc) {
            __builtin_amdgcn_fence(__ATOMIC_RELEASE, "agent");
            asm volatile("s_waitcnt vmcnt(0)" ::: "memory");
            const unsigned og = xb_add(&bar[XB_TOP], 1u);
            const unsigned tg = og / nx;
            if (og + 1u == (tg + 1u) * nx) xb_add(&bar[XB_TOPGEN], 1u);
            else XB_SPIN(xb_ld(&bar[XB_TOPGEN]) == tg, bar);
            __builtin_amdgcn_fence(__ATOMIC_ACQUIRE, "agent");
            xb_add(&bar[XB_XGEN(b.x)], 1u);
            asm volatile("s_waitcnt vmcnt(0)" ::: "memory");
        } else {
            XB_SPIN(xb_ld(&bar[XB_XGEN(b.x)]) == gen, bar);
            __builtin_amdgcn_fence(__ATOMIC_ACQUIRE, "agent");
            asm volatile("s_waitcnt vmcnt(0)" ::: "memory");
        }
    }
    __syncthreads();
}


constexpr int CI_UP = 2 * (D / 64) * (DFF / 32), CI_DN = (DFF / 64) * (D / 32), CI_IN = (D / 64) * (NIN / 32), CI_OUT = (D / 64) * (D / 32), CI_Q = (D / 64) * (XAW / 32), CI_O = (XAW / 64) * (D / 32), CI_G = 512;
constexpr int CI_TOTAL = CI_DN + CI_IN + CI_OUT + 3 * CI_Q + CI_O + CI_G + CI_UP + CI_DN;
constexpr int CI_P1 = CI_TOTAL - CI_DN, CI_P10 = CI_TOTAL;
constexpr int CONV_CHUNK = 128;
__device__ __forceinline__ void deferred_item(int g, const float* const* in, unsigned char* ws, LAS float* scr, int lane) {
    const float* W; int K, N, row_off = 0, up = 0; bf16* WT; const float* gk = nullptr;
    if (g < CI_DN) { W = in[7]; K = DFF; N = D; WT = (bf16*)(ws + WS_WDN1); }
    else if ((g -= CI_DN) < CI_OUT) { W = in[20]; K = D; N = D; WT = (bf16*)(ws + WS_WOUT); }
    else if ((g -= CI_OUT) < CI_IN) { W = in[9]; K = D; N = NIN; WT = (bf16*)(ws + WS_WIN); gk = in[8]; }
    else if ((g -= CI_IN) < CI_Q) { W = in[23]; K = D; N = XAW; WT = (bf16*)(ws + WS_WQ); gk = in[21]; }
    else if ((g -= CI_Q) < CI_Q) { W = in[24]; K = D; N = XAW; WT = (bf16*)(ws + WS_WKV); }
    else if ((g -= CI_Q) < CI_Q) { W = in[25]; K = D; N = XAW; WT = (bf16*)(ws + WS_WKV); row_off = XAW; }
    else if ((g -= CI_Q) < CI_O) { W = in[26]; K = XAW; N = D; WT = (bf16*)(ws + WS_WO); }
    else if ((g -= CI_O) < CI_G) { const int mat = g >> 3, sub = g & 7, gi = mat & 1, e = (mat >> 1) & 1, nn = mat >> 2;
        const float* Wsrc = (gi ? in[15] : in[13]) + ((size_t)(e * 16 + nn) << 14); const int k0 = (sub >> 2) * 64, n0 = (sub & 3) * 32;
        transpose_item(Wsrc, 128, 128, (bf16*)(ws + WS_WG) + ((size_t)(nn * 2 + e) * 256 + gi * 128 + n0) * 128, k0, n0, scr, lane); return; }
    else if ((g -= CI_G) < CI_UP) { const int which = g >= CI_UP / 2; if (which) g -= CI_UP / 2;
        const int nblk = DFF / 32, kb = g / nblk, nb = g % nblk, n0 = 32 * nb, k0 = 64 * kb, drow = 256 * (n0 >> 7) + (n0 & 127) + (which ? 128 : 0);
        transpose_item_f8(which ? in[29] : in[28], D, DFF, (char*)(ws + WS_WUP2) + ((size_t)((drow >> 8) * (D / 128) + (k0 >> 7)) << 15), k0, n0, drow & 255, true, 128.0f, in[27], scr, lane); return; }
    else { g -= CI_UP; W = in[30]; K = DFF; N = D; WT = (bf16*)(ws + WS_WDN2);
        const int nblk_ = D / 32, kb_ = g / nblk_, nb_ = g % nblk_, n0_ = 32 * nb_, k0_ = 64 * kb_;
        if (k0_ >= DN8_PN * 128) {
            transpose_item_f8(W, DFF, D, (char*)(ws + WS_WUP1) + ((size_t)((n0_ >> 8) * DN8_KT + ((k0_ - DN8_PN * 128) >> 7)) << 15), k0_, n0_, n0_ & 255, true, 128.0f, nullptr, scr, lane); return; } }
    const int nblk = N / 32, nkt = K / 64, kb = g / nblk, nb = g % nblk, n0 = 32 * nb;
    const int drow = up ? 256 * (n0 >> 7) + (n0 & 127) + (up == 2 ? 128 : 0) : row_off + n0;
    transpose_item_blk(W, K, N, (char*)WT + ((size_t)((drow >> 8) * nkt + kb) << 15), 64 * kb, n0, drow & 255, true, gk, scr, lane);
}
__device__ __forceinline__ void phase_prologue(const float* const* in, unsigned char* ws, LAS unsigned char* lds, pg8::ssq_t* ss0, int lane, int wave, int gw, int NGW) {
    bf16* W_G = (bf16*)(ws + WS_WG); bf16* W_Q = (bf16*)(ws + WS_WQ); bf16* W_KV = (bf16*)(ws + WS_WKV); bf16* W_O = (bf16*)(ws + WS_WO); bf16* MEMN = (bf16*)(ws + WS_MEMN);
    bf16* W_OUT = (bf16*)(ws + WS_WOUT); bf16* W_IN = (bf16*)(ws + WS_WIN); bf16* W_UP1 = (bf16*)(ws + WS_WUP1); bf16* W_DN1 = (bf16*)(ws + WS_WDN1);
    bf16* W_UP2 = (bf16*)(ws + WS_WUP2); bf16* W_DN2 = (bf16*)(ws + WS_WDN2); bf16* XN = (bf16*)(ws + WS_XN);
            for (int m = gw; m < MTOK; m += NGW) {
            const float* xr = (m < MP) ? in[0] + (size_t)m * D : in[1] + (size_t)(m - MP) * D;
            float s = 0.f;
#pragma unroll 4
            for (int j = 0; j < 16; ++j) { const f32x4 v = *(const f32x4*)(xr + (j * 64 + lane) * 4);
                s += (v[0] * v[0] + v[1] * v[1]) + (v[2] * v[2] + v[3] * v[3]);
                v2u o; o.x = pk2(v[0], v[1]); o.y = pk2(v[2], v[3]); *(v2u*)((char*)XN + pg8::blk_off(m, (j * 64 + lane) * 4, 64)) = o; }
            s = wave_sum(s); if (lane == 0) ss0[m] = pg8::ss_fix(s);
        }
        const float* gm = in[22];
        for (int m = gw; m < NMEM; m += NGW) {
            const float* xr = (m < 2048) ? in[2] + (size_t)m * D : in[3] + (size_t)(m - 2048) * D;
            f32x4 v[16]; float s = 0.f;
#pragma unroll
            for (int j = 0; j < 16; ++j) { v[j] = *(const f32x4*)(xr + (j * 64 + lane) * 4); s += (v[j][0] * v[j][0] + v[j][1] * v[j][1]) + (v[j][2] * v[j][2] + v[j][3] * v[j][3]); }
            s = wave_sum(s); const float rs = rsqrtf(s * (1.0f / D) + EPS);
#pragma unroll
            for (int j = 0; j < 16; ++j) { const f32x4 g = *(const f32x4*)(gm + (j * 64 + lane) * 4);
                v2u o; o.x = pk2(v[j][0] * rs * g[0], v[j][1] * rs * g[1]); o.y = pk2(v[j][2] * rs * g[2], v[j][3] * rs * g[3]); *(v2u*)((char*)MEMN + pg8::blk_off(m, (j * 64 + lane) * 4, 64)) = o; }
        }
        LAS float* scr = (LAS float*)(lds + RING_OFF + wave * 16384);
        transpose_up(in[5], in[6], W_UP1, in[4], scr, lane, gw, NGW);
        for (int g = CI_P10 + gw; g < CI_TOTAL; g += NGW) deferred_item(g, in, ws, scr, lane);
}
__device__ __forceinline__ void phase_mixer(const float* const* in, const bf16* PROJ, const bf16* UG, const bf16* W_G, bf16* HF, bf16* HBK, bf16* PCA, bf16* YA, unsigned* ctr, volatile LAS unsigned* MISC, LAS unsigned char* lds, int G, int bx, int tid, int wave, int lane, int mode = 3) {
        if (mode & 1) {
        for (int u = bx; u < 320; u += (u < 256 ? (bx >= 64 && bx < 128 ? 256 - 64 : 1024) : 1024)) lru_dispatch(u, UG, W_G, in, HF, HBK, PCA, lds, tid, wave, lane);
        }
        if (mode & 6)
        for (;;) {
            __syncthreads();
            if (tid == 0) MISC[0] = atomicAdd(ctr, 1u);
            __syncthreads();
            const int it = __builtin_amdgcn_readfirstlane((int)MISC[0]);
            if (it >= 3072) break;
            na_coop_task(it, PROJ, in[10], YA, lds, tid, wave, lane);
        }
}
__device__ __forceinline__ void phase_finalize(const float* const* in, const bf16* PROJ, const bf16* HF, const bf16* HBK, const bf16* PCA, const bf16* YA, bf16* Y, int lane, int gw, int NGW) {
        const float* ga = in[18]; const float* gl = in[19];
        for (int m = gw; m < MTOK; m += NGW) {
            float y[32]; float s = 0.f;
#pragma unroll
            for (int j = 0; j < 4; ++j) { const int c0 = (j * 64 + lane) * 8; float a[8], b[8], gt[8];
                unpack8(*(const v4u*)(HF + (size_t)m * LW + c0), a); unpack8(*(const v4u*)(HBK + (size_t)m * LW + c0), b); unpack8(*(const v4u*)(PROJ + (size_t)m * 4096 + 2048 + c0), gt);
                if (m >= MP) { const int t = m - MP; float pc[8], bd[8]; unpack8(*(const v4u*)(PCA + (size_t)t * LW + c0), pc);
                    if (t >= 4096) { unpack8(*(const v4u*)(HF + (size_t)(MP + 4095) * LW + c0), bd);
#pragma unroll
                        for (int k = 0; k < 8; ++k) a[k] += pc[k] * bd[k]; }
                    else { unpack8(*(const v4u*)(HBK + (size_t)(MP + 4096) * LW + c0), bd);
#pragma unroll
                        for (int k = 0; k < 8; ++k) b[k] += pc[k] * bd[k]; } }
#pragma unroll
                for (int k = 0; k < 8; ++k) { const float v = (a[k] + b[k]) * gelu_tanh(gt[k]); y[8 * j + k] = v; s += v * v; } }
            s = wave_sum(s); float rs = rsqrtf(s * (1.0f / LW) + EPS);
#pragma unroll
            for (int j = 0; j < 4; ++j) { const int c0 = (j * 64 + lane) * 8; const f32x4 g0 = *(const f32x4*)(gl + c0), g1 = *(const f32x4*)(gl + c0 + 4);
                v4u o; o.x = pk2(y[8 * j] * rs * g0[0], y[8 * j + 1] * rs * g0[1]); o.y = pk2(y[8 * j + 2] * rs * g0[2], y[8 * j + 3] * rs * g0[3]);
                o.z = pk2(y[8 * j + 4] * rs * g1[0], y[8 * j + 5] * rs * g1[1]); o.w = pk2(y[8 * j + 6] * rs * g1[2], y[8 * j + 7] * rs * g1[3]);
                *(v4u*)((char*)Y + pg8::blk_off(m, AW + c0, 64)) = o; }
            s = 0.f;
#pragma unroll
            for (int j = 0; j < 4; ++j) { const int c0 = (j * 64 + lane) * 8; float a[8]; unpack8(*(const v4u*)(YA + (size_t)m * AW + c0), a);
#pragma unroll
                for (int k = 0; k < 8; ++k) { y[8 * j + k] = a[k]; s += a[k] * a[k]; } }
            s = wave_sum(s); rs = rsqrtf(s * (1.0f / AW) + EPS);
#pragma unroll
            for (int j = 0; j < 4; ++j) { const int c0 = (j * 64 + lane) * 8; const f32x4 g0 = *(const f32x4*)(ga + c0), g1 = *(const f32x4*)(ga + c0 + 4);
                v4u o; o.x = pk2(y[8 * j] * rs * g0[0], y[8 * j + 1] * rs * g0[1]); o.y = pk2(y[8 * j + 2] * rs * g0[2], y[8 * j + 3] * rs * g0[3]);
                o.z = pk2(y[8 * j + 4] * rs * g1[0], y[8 * j + 5] * rs * g1[1]); o.w = pk2(y[8 * j + 6] * rs * g1[2], y[8 * j + 7] * rs * g1[3]);
                *(v4u*)((char*)Y + pg8::blk_off(m, c0, 64)) = o; }
        }
}
__device__ __forceinline__ void phase_xattn(const bf16* XQ, const bf16* KVM, bf16* XO, LAS unsigned char* lds, int wave, int lane, int gw, int NGW) {
        for (int t = blockIdx.x; t < (MTOK / 128) * 4; t += gridDim.x) { __syncthreads(); xa_coop_task(t, XQ, KVM, XO, lds, wave * 64 + lane, wave, lane); }
}

struct Args { const float* in[32]; float* out; unsigned char* ws; int ph_lo, ph_hi; };
static_assert(sizeof(Args) == 32 * 8 + 8 + 8 + 8, "Args has no padding");

__global__ void __launch_bounds__(NWAVES * 64, 2) mk_fwd(Args args) {
    extern __shared__ __attribute__((aligned(16))) unsigned char lds_raw[];
    LAS unsigned char* lds = (LAS unsigned char*)lds_raw;
    volatile LAS unsigned* MISC = (volatile LAS unsigned*)(lds + MISC_OFF);
    const int tid = threadIdx.x, lane = tid & 63, wave = __builtin_amdgcn_readfirstlane(tid >> 6);
    const int G = gridDim.x, bx = blockIdx.x;
    const int gw = bx * NWAVES + wave, NGW = G * NWAVES;
    unsigned char* ws = args.ws;
    unsigned* ctl = (unsigned*)(ws + WS_CTL);
    pg8::ssq_t* ss0 = (pg8::ssq_t*)(ctl + CW_SS); pg8::ssq_t* ss1 = ss0 + MTOK; pg8::ssq_t* ss2 = ss1 + MTOK; pg8::ssq_t* ss3 = ss2 + MTOK; pg8::ssq_t* ss4 = ss3 + MTOK;
    bf16* W_G = (bf16*)(ws + WS_WG); bf16* W_Q = (bf16*)(ws + WS_WQ); bf16* W_KV = (bf16*)(ws + WS_WKV); bf16* W_O = (bf16*)(ws + WS_WO); bf16* MEMN = (bf16*)(ws + WS_MEMN);
    bf16* W_OUT = (bf16*)(ws + WS_WOUT); bf16* W_IN = (bf16*)(ws + WS_WIN); bf16* W_UP1 = (bf16*)(ws + WS_WUP1); bf16* W_DN1 = (bf16*)(ws + WS_WDN1);
    bf16* W_UP2 = (bf16*)(ws + WS_WUP2); bf16* W_DN2 = (bf16*)(ws + WS_WDN2);
    bf16* XN = (bf16*)(ws + WS_XN); bf16* HBK = (bf16*)(ws + WS_HBK);
    bf16* PCA = (bf16*)args.out + (size_t)2 * MTOK * AW;
    bf16* YA = (bf16*)args.out; bf16* HF = (bf16*)args.out + (size_t)MTOK * AW;
    bf16* Y = (bf16*)(ws + WS_Y); bf16* HB = (bf16*)(ws + WS_HB); bf16* PROJ = (bf16*)(ws + WS_PROJ); bf16* UG = PROJ + (size_t)48 * MTOK * 128;
    bf16* XQ = (bf16*)(ws + WS_XQ); bf16* XO = (bf16*)(ws + WS_XO); bf16* KVM = (bf16*)(ws + WS_KVM);
    float* out = args.out;

    for (int i = tid; i < (LDS_BYTES - LDSCTL_OFF) / 4; i += NWAVES * 64) ((LAS unsigned*)(lds + LDSCTL_OFF))[i] = 0u;
    __syncthreads();
    if (tid == 0) { const unsigned long long xp_ = (unsigned long long)XN; MISC[20] = (unsigned)xp_; MISC[21] = (unsigned)(xp_ >> 32); }
    __syncthreads();
    const int lo = args.ph_lo, hi = args.ph_hi;
    XcdBarrier bar; bar.bar = ctl + CW_BAR; bar.x = 0; bar.st = nullptr;
    if (hi - lo > 1) bar = xcd_barrier_post(ctl + CW_BAR, MISC + 8);
#define IN(k) (lo <= (k) && (k) < hi)
#define LANE_NOW() ({ int l_; asm volatile("v_mbcnt_lo_u32_b32 %0, -1, 0\n\tv_mbcnt_hi_u32_b32 %0, -1, %0" : "=&v"(l_)); l_; })
#define SEAM(k) do { if (IN(k) && IN((k) + 1)) { xcd_barrier(bar, wave == 0); if (PROBE_MASK & 32768) xcd_barrier(bar, wave == 0); } } while (0)

    if (IN(0)) { phase_prologue(args.in, ws, lds, ss0, lane, wave, gw, NGW);
        if (PROBE_MASK & 1) { xcd_barrier(bar); phase_prologue(args.in, ws, lds, ss0, lane, wave, gw, NGW); } }
    SEAM(0);
    if (IN(1)) {
        pg8::Gemm g{XN, W_UP1, MTOK, NUP, D}; pg8::StaticOrder S; S.init(MTOK, NUP, G, bx);
        pg8::EpiSwiGLU E{HB, ss0, 1 << 30, 1.0f, nullptr};
        if (PROBE_MASK & 4096) { pg8::EpiTwice<pg8::EpiSwiGLU> ET{E}; pg8::gemm_phase<pg8::EpiTwice<pg8::EpiSwiGLU>, pg8::StaticOrder, PG8_ALIGN, PG8_SP2>(lds + RING_OFF, g, S, ET, wave); } else
        pg8::gemm_phase<pg8::EpiSwiGLU, pg8::StaticOrder, PG8_ALIGN, PG8_SP2>(lds + RING_OFF, g, S, E, wave);
        if (PROBE_MASK & 2) { xcd_barrier(bar); pg8::gemm_phase<pg8::EpiSwiGLU, pg8::StaticOrder, PG8_ALIGN, PG8_SP2>(lds + RING_OFF, g, S, E, wave); }
        const int lane = LANE_NOW(), tid = wave * 64 + lane;
        for (;;) {
            __syncthreads();
            if (tid == 0) MISC[0] = atomicAdd(ctl + CW_CONVCTR, 1u);
            __syncthreads();
            const int chunk = (int)MISC[0];
            if (chunk * CONV_CHUNK >= CI_P1) break;
            LAS float* scr = (LAS float*)(lds + RING_OFF + wave * 16384);
            for (int j = 0; j < CONV_CHUNK / NWAVES; ++j) { const int gi = chunk * CONV_CHUNK + wave * (CONV_CHUNK / NWAVES) + j; if (gi < CI_P1) deferred_item(gi, args.in, ws, scr, lane); }
        }
        if (PROBE_MASK & 65536) { xcd_barrier(bar);
            for (;;) {
                __syncthreads();
                if (tid == 0) MISC[0] = atomicAdd(ctl + CW_CONVCTR + 128, 1u);
                __syncthreads();
                const int chunk = (int)MISC[0];
                if (chunk * CONV_CHUNK >= CI_P1) break;
                LAS float* scr = (LAS float*)(lds + RING_OFF + wave * 16384);
                for (int j = 0; j < CONV_CHUNK / NWAVES; ++j) { const int gi = chunk * CONV_CHUNK + wave * (CONV_CHUNK / NWAVES) + j; if (gi < CI_P1) deferred_item(gi, args.in, ws, scr, lane); }
            } }
    }
    SEAM(1);
    if (IN(2)) {
        pg8::Gemm g{HB, W_DN1, MTOK, D, DFF}; pg8::StaticOrder S; S.init(MTOK, D, G, bx, WGM_DOWN, 1);
        pg8::EpiResid E{XN, ss1, nullptr, 0.5f};
        pg8::gemm_phase<pg8::EpiResid, pg8::StaticOrder, PG8_ALIGN, PG8_SP2>(lds + RING_OFF, g, S, E, wave);
        if (PROBE_MASK & 8192) { xcd_barrier(bar); pg8::Gemm gl{XN, W_UP1, MTOK, NUP, D}; pg8::StaticOrder Sl; Sl.init(MTOK, NUP, G, bx); pg8::EpiNull EN;
            pg8::gemm_phase<pg8::EpiNull, pg8::StaticOrder, PG8_ALIGN, PG8_SP2, PROBE_VAR>(lds + RING_OFF, gl, Sl, EN, wave); }
        if (PROBE_MASK & 4) { xcd_barrier(bar); pg8::EpiResid E2{XN, ss4 + MTOK, nullptr, 0.0f}; pg8::gemm_phase<pg8::EpiResid, pg8::StaticOrder, PG8_ALIGN, PG8_SP2>(lds + RING_OFF, g, S, E2, wave); }
    }
    SEAM(2);
    if (IN(3)) {
        pg8::Gemm g{XN, W_IN, MTOK, NIN, D}; pg8::StaticOrder S; S.init(MTOK, NIN, G, bx);
        pg8::EpiProj E{PROJ, UG, ss1, 0.08838834764831845f};
        pg8::gemm_phase<pg8::EpiProj, pg8::StaticOrder, PG8_ALIGN, PG8_SP2>(lds + RING_OFF, g, S, E, wave);
        if (PROBE_MASK & 8) { xcd_barrier(bar); pg8::gemm_phase<pg8::EpiProj, pg8::StaticOrder, PG8_ALIGN, PG8_SP2>(lds + RING_OFF, g, S, E, wave); }
    }
    SEAM(3);
    if (IN(4)) { const int lane = LANE_NOW(), tid = wave * 64 + lane; phase_mixer(args.in, PROJ, UG, W_G, HF, HBK, PCA, YA, ctl + CW_NACTR, MISC, lds, G, bx, tid, wave, lane);
        if (PROBE_MASK & 16) { xcd_barrier(bar); phase_mixer(args.in, PROJ, UG, W_G, HF, HBK, PCA, YA, ctl + CW_NACTR + 64, MISC, lds, G, bx, tid, wave, lane); }
        if (PROBE_MASK & 1024) { xcd_barrier(bar); phase_mixer(args.in, PROJ, UG, W_G, HF, HBK, PCA, YA, ctl + CW_NACTR + 64, MISC, lds, G, bx, tid, wave, lane, 1); }
        if (PROBE_MASK & 16384) { xcd_barrier(bar); phase_mixer(args.in, PROJ, UG, W_G, HF, HBK, PCA, YA, ctl + CW_NACTR + 64, MISC, lds, G, bx, tid, wave, lane, 4); }
        if (PROBE_MASK & 2048) { xcd_barrier(bar); phase_mixer(args.in, PROJ, UG, W_G, HF, HBK, PCA, YA, ctl + CW_NACTR + 64, MISC, lds, G, bx, tid, wave, lane, 2); } }
    SEAM(4);
    if (IN(5)) { const int lane = LANE_NOW(); phase_finalize(args.in, UG, HF, HBK, PCA, YA, Y, lane, gw, NGW);
        if (PROBE_MASK & 32) { xcd_barrier(bar); phase_finalize(args.in, UG, HF, HBK, PCA, YA, Y, lane, gw, NGW); } }
    SEAM(5);
    if (IN(6)) {
        pg8::Gemm g{Y, W_OUT, MTOK, D, D}; pg8::StaticOrder S; S.init(MTOK, D, G, bx);
        pg8::EpiResid E{XN, ss2, nullptr, 1.0f};
        pg8::gemm_phase<pg8::EpiResid, pg8::StaticOrder, PG8_ALIGN, PG8_SP2>(lds + RING_OFF, g, S, E, wave);
        if (PROBE_MASK & 64) { xcd_barrier(bar); pg8::EpiResid E2{XN, ss4 + MTOK, nullptr, 0.0f}; pg8::gemm_phase<pg8::EpiResid, pg8::StaticOrder, PG8_ALIGN, PG8_SP2>(lds + RING_OFF, g, S, E2, wave); }
    }
    SEAM(6);
    if (IN(7)) {
        if (bx < 192 || G < 228) {
            pg8::Gemm g{XN, W_Q, MTOK, XAW, D}; pg8::StaticOrder S; S.init(MTOK, XAW, G < 228 ? G : 192, bx);
            pg8::EpiScaleBf16 E{XQ, XAW, ss2, 0.08838834764831845f, XAW};
            pg8::gemm_phase<pg8::EpiScaleBf16, pg8::StaticOrder, PG8_ALIGN, PG8_SP2>(lds + RING_OFF, g, S, E, wave);
        }
        if ((bx >= 192 && bx < 228) || G < 228) {
            pg8::Gemm g{MEMN, W_KV, NMEM, 2 * XAW, D}; pg8::StaticOrder S; S.init(NMEM, 2 * XAW, G < 228 ? G : 36, G < 228 ? bx : bx - 192);
            pg8::EpiScaleBf16 E{KVM, 2 * XAW, nullptr, 1.0f, 0};
            pg8::gemm_phase<pg8::EpiScaleBf16, pg8::StaticOrder, PG8_ALIGN, PG8_SP2>(lds + RING_OFF, g, S, E, wave);
        }
    }
    SEAM(7);
    if (IN(8)) { const int lane = LANE_NOW(); phase_xattn(XQ, KVM, XO, lds, wave, lane, gw, NGW);
        if (PROBE_MASK & 256) { xcd_barrier(bar); phase_xattn(XQ, KVM, XO, lds, wave, lane, gw, NGW); } }
    SEAM(8);
    if (IN(9)) {
        pg8::Gemm g{XO, W_O, MTOK, D, XAW}; pg8::StaticOrder S; S.init(MTOK, D, G, bx);
        pg8::EpiResid E{XN, ss3, (char*)(ws + WS_Y), 1.0f};
        pg8::gemm_phase<pg8::EpiResid, pg8::StaticOrder, PG8_ALIGN, PG8_SP2>(lds + RING_OFF, g, S, E, wave);
        if (PROBE_MASK & 512) { xcd_barrier(bar); pg8::EpiResid E2{XN, ss4 + MTOK, nullptr, 0.0f}; pg8::gemm_phase<pg8::EpiResid, pg8::StaticOrder, PG8_ALIGN, PG8_SP2>(lds + RING_OFF, g, S, E2, wave); }
    }
    SEAM(9);
    if (IN(10)) {
        pg8::Gemm g{(const pg8::bf16_t*)(ws + WS_Y), W_UP2, MTOK, NUP, D}; pg8::StaticOrder S; S.init(MTOK, NUP, G, bx);
        pg8::EpiSwiGLU E{HB, ss3, DN8_PN, 1.0f / 128.0f, (char*)out};
        pg8::gemm_phase<pg8::EpiSwiGLU, pg8::StaticOrder, PG8_ALIGN, PG8_SP2, 0, true>(lds + RING_OFF, g, S, E, wave);
        const int lane = LANE_NOW(), tid = wave * 64 + lane;
        for (;;) {
            __syncthreads();
            if (tid == 0) MISC[0] = atomicAdd(ctl + CW_CONVCTR + 64, 1u);
            __syncthreads();
            const int chunk = (int)MISC[0];
            if (CI_P1 + chunk * CONV_CHUNK >= CI_P10) break;
            LAS float* scr = (LAS float*)(lds + RING_OFF + wave * 16384);
            for (int j = 0; j < CONV_CHUNK / NWAVES; ++j) { const int gi = CI_P1 + chunk * CONV_CHUNK + wave * (CONV_CHUNK / NWAVES) + j; if (gi < CI_P10) deferred_item(gi, args.in, ws, scr, lane); }
        }
    }
    SEAM(10);
    if (IN(11)) {
        pg8::StaticOrder S; S.init(MTOK, D, G, bx, 8, 1);
        pg8::Gemm2 g{HB, W_DN2, MTOK, D, DN8_PN * 128, DFF, (const pg8::bf16_t*)out, (const pg8::bf16_t*)(ws + WS_WUP1), DFF - DN8_PN * 128};
        pg8::EpiResid E{XN, ss4, nullptr, 0.5f};
        pg8::gemm_phase_tail8<pg8::EpiResid, pg8::StaticOrder>(lds + RING_OFF, g, S, E, wave);
    }
    SEAM(11);
    if (IN(12)) {
        const float* gf = args.in[31];
        int ln12; asm volatile("v_mbcnt_lo_u32_b32 %0, -1, 0\n\tv_mbcnt_hi_u32_b32 %0, -1, %0" : "=&v"(ln12));
        const int lane = ln12;
        const int gq = lane >> 3, rb = (lane >> 2) & 1, chk = lane & 3;
        for (int p = gw; p < MTOK / 2; p += NGW) {
            const int m = 2 * p + rb; const float rs = rsqrtf(pg8::ss_get(ss4 + m) * (1.0f / D) + EPS); float* orow = out + (size_t)m * D;
#pragma unroll 4
            for (int j = 0; j < 16; ++j) { const int c0 = (j * 8 + gq) * 32 + chk * 8; float a[8]; unpack8(*(const v4u*)((const char*)XN + pg8::blk_off(m, c0, 64)), a);
                const f32x4 g0 = *(const f32x4*)(gf + c0), g1 = *(const f32x4*)(gf + c0 + 4);
                *(f32x4*)(orow + c0) = (f32x4){a[0] * rs * g0[0], a[1] * rs * g0[1], a[2] * rs * g0[2], a[3] * rs * g0[3]};
                *(f32x4*)(orow + c0 + 4) = (f32x4){a[4] * rs * g1[0], a[5] * rs * g1[1], a[6] * rs * g1[2], a[7] * rs * g1[3]}; }
        }
    }
#undef IN
#undef LANE_NOW
#undef SEAM
}

extern "C" void kernel_launch(void* const* d_in, const int* in_sizes, int n_in, void* d_out, int out_size, void* d_ws, size_t ws_size, hipStream_t stream) {
    static int grid = 0;
    if (grid == 0) {
        if (n_in != 32 || in_sizes[0] != MP * D || in_sizes[1] != MS * D || out_size != MTOK * D || ws_size < WS_END) {
            fprintf(stderr, "kernel_launch: shape/workspace mismatch: n_in %d in0 %d in1 %d out %d ws %zu (need %zu); nothing launched\n", n_in, n_in > 0 ? in_sizes[0] : -1, n_in > 1 ? in_sizes[1] : -1, out_size, ws_size, (size_t)WS_END);
            grid = -1; return; }
        int dev = 0, cus = 0, per_cu = 0;
        if (hipGetDevice(&dev) != hipSuccess || hipDeviceGetAttribute(&cus, hipDeviceAttributeMultiprocessorCount, dev) != hipSuccess) { grid = -1; return; }
        if (hipFuncSetAttribute((const void*)mk_fwd, hipFuncAttributeMaxDynamicSharedMemorySize, LDS_BYTES) != hipSuccess) { fprintf(stderr, "kernel_launch: hipFuncSetAttribute failed\n"); grid = -1; return; }
        if (hipOccupancyMaxActiveBlocksPerMultiprocessor(&per_cu, (const void*)mk_fwd, NWAVES * 64, LDS_BYTES) != hipSuccess || per_cu < 1)
            fprintf(stderr, "kernel_launch: note: occupancy query reports %d workgroups per CU\n", per_cu);
        (void)hipGetLastError();
        grid = cus;
    }
    if (grid < 0) return;
    if (hipMemsetAsync((char*)d_ws + WS_CTL, 0, CTL_ZERO_BYTES, stream) != hipSuccess) return;
    Args a{};
    for (int i = 0; i < 32; ++i) a.in[i] = (const float*)d_in[i];
    a.out = (float*)d_out; a.ws = (unsigned char*)d_ws;
#if MK_N_LAUNCHES == 1
    a.ph_lo = 0; a.ph_hi = N_PHASES;
    hipLaunchKernelGGL(mk_fwd, dim3(grid), dim3(NWAVES * 64), LDS_BYTES, stream, a);
#else
    for (int p = 0; p < N_PHASES; ++p) { a.ph_lo = p; a.ph_hi = p + 1; hipLaunchKernelGGL(mk_fwd, dim3(grid), dim3(NWAVES * 64), LDS_BYTES, stream, a); }
#endif
    const hipError_t le = hipPeekAtLastError();
    if (le != hipSuccess) fprintf(stderr, "kernel_launch: launch failed: %s\n", hipGetErrorName(le));
}
```

```cpp
#include <hip/hip_runtime.h>
#include <cstdio>
#include <cstdint>
namespace pg8 {
#define PG8_LAS __attribute__((address_space(3)))
typedef unsigned short bf16_t;
typedef short bf16x8 __attribute__((ext_vector_type(8)));
typedef float f32x4 __attribute__((ext_vector_type(4)));
typedef unsigned u32x4 __attribute__((ext_vector_type(4)));
constexpr int BM = 256, BK = 64, HALF = 128, HTB = HALF * BK * 2  , STAGE_BYTES = 8 * HTB, NXCD = 8, WGM = 8;

__host__ __device__ __forceinline__ int lds_byte(int r, int c) { const int st = (r >> 4) * 2 + (c >> 5), rr = r & 15, cc = c & 31, ob = rr * 64 + cc * 2; return st * 1024 + (ob ^ (((ob >> 9) & 1) << 5)); }
__host__ __device__ __forceinline__ void stage_rc(int b, int& R, int& C) { const int st = b / 1024, sb = b % 1024, swz = sb ^ (((sb >> 9) & 1) << 5); R = (st >> 1) * 16 + swz / 64; C = (st & 1) * 32 + (swz % 64) / 2; }
__host__ __device__ __forceinline__ int perm32(int rho) { const int n = rho >> 4, i = rho & 15; return 8 * (i >> 2) + 4 * n + (i & 3); }

__host__ __device__ __forceinline__ int perm32inv(int v) { return 16 * ((v >> 2) & 1) + 4 * (v >> 3) + (v & 3); }
__host__ __device__ __forceinline__ size_t blk_off(int row, int col, int nkt) { const int p = row >> 8, h = (row >> 7) & 1, r = row & 127, kt = col >> 6, c = col & 63; return ((size_t)((p * nkt + kt) * 2 + h) << 14) + (size_t)lds_byte(r, c); }
typedef int i32x4v __attribute__((ext_vector_type(4)));
typedef int i32x8v __attribute__((ext_vector_type(8)));
typedef short bf16x16v __attribute__((ext_vector_type(16)));
__host__ __device__ __forceinline__ size_t blk8_off(int row, int col, int nkt8) { const int p = row >> 8, h = (row >> 7) & 1, r = row & 127, kt = col >> 7, cb = col & 127, c8 = cb >> 4;
    return ((size_t)((p * nkt8 + kt) * 2 + h) << 14) + (size_t)((r >> 4) * 2048 + (c8 & 1) * 1024 + ((c8 >> 1) * 16 + (r & 15)) * 16 + (cb & 15)); }
struct Unit { int pm, pn; };
struct Gemm { const bf16_t* A; const bf16_t* Bt; int M, N, K; int Ks = 0; };

#ifndef PG8_XCDROWS
#define PG8_XCDROWS 1
#endif
struct StaticOrder {
    int nM, nN, nwg, G, c, wgm, rev;
    __host__ __device__ void init(int M, int N, int G_, int c_, int wgm_ = WGM, int rev_ = 0) { nM = M / BM; nN = N / BM; nwg = nM * nN; G = G_; c = c_; wgm = wgm_; rev = rev_; }
    __host__ __device__ bool next(int i, Unit& u) const {
        const long L = (long)i * G + c; if (L >= nwg) return false;
        if (PG8_XCDROWS && nM % NXCD == 0 && G % NXCD == 0) {
            const int xcd = (int)(L % NXCD), off = (int)(L / NXCD), nMl = nM / NXCD, nig = wgm * nN, gid = off / nig, fm = gid * wgm, gsz = (nMl - fm) < wgm ? (nMl - fm) : wgm, w = off % nig;
            u.pm = xcd * nMl + fm + w % gsz; u.pn = w / gsz; if (rev) u.pm = nM - 1 - u.pm; return true; }
        int wgid = (int)L; { const int q = nwg / NXCD, r = nwg % NXCD, xcd = wgid % NXCD, off = wgid / NXCD; wgid = (xcd < r ? xcd * (q + 1) : r * (q + 1) + (xcd - r) * q) + off; }
        const int nig = wgm * nN, gid = wgid / nig, fm = gid * wgm, gsz = (nM - fm) < wgm ? (nM - fm) : wgm;
        u.pm = fm + ((wgid % nig) % gsz); u.pn = (wgid % nig) / gsz; if (rev) u.pm = nM - 1 - u.pm; return true;
    }
    __device__ __forceinline__ void a_ready(const Unit&) const {}
    __device__ __forceinline__ void done(const Unit&) const {}
};
__device__ __forceinline__ unsigned cvt_pk_bf16(float lo, float hi) { unsigned r; asm volatile("v_cvt_pk_bf16_f32 %0, %1, %2" : "=v"(r) : "v"(lo), "v"(hi)); return r; }
typedef float f32x2 __attribute__((ext_vector_type(2)));
template <class Epi, class Sched, bool ALIGN_EPI = false, bool SP2 = false, int VAR = 0, bool FP8 = false>
__device__ __forceinline__ void gemm_phase(PG8_LAS unsigned char* lds, const Gemm g, const Sched& S, const Epi& E, const int wid) {
    int lane_; asm volatile("v_mbcnt_lo_u32_b32 %0, -1, 0\n\tv_mbcnt_hi_u32_b32 %0, -1, %0" : "=&v"(lane_));
    const int lane = lane_, tid = wid * 64 + lane, wr = wid >> 2, wc = wid & 3, fr = lane & 15, fq = lane >> 4;
    const int K = g.K, nt = K / (FP8 ? 2 * BK : BK);
    unsigned voffA[2], voffB[2];
#pragma unroll
    for (int i = 0; i < 2; ++i) { voffA[i] = (unsigned)(tid * 16 + i * 8192); voffB[i] = voffA[i]; }
    const size_t kstep = 32768;
    const size_t hstep = 16384;
    const size_t tstep = (size_t)((g.Ks ? g.Ks : K) / (FP8 ? 2 * BK : BK)) * 32768;
    const unsigned ldsw = (unsigned)wid * 1024u; const unsigned ldsb_ = (unsigned)(uintptr_t)lds + ldsw;
    const int aoff = FP8 ? (wr * 8192 + lane * 16) : lds_byte(wr * 64 + fr, fq * 8), boff = FP8 ? (wc * 4096 + lane * 16) : lds_byte(wc * 32 + fr, fq * 8);
#define PG8_SA(b, h) (((b) * 2 + (h)) * HTB)
#define PG8_SB(b, h) ((4 + (b) * 2 + (h)) * HTB)
#define PG8_STAGE(bufoff, gbase, voff) do { _Pragma("unroll") for (int _i = 0; _i < 2; ++_i) { const char* gb_ = (const char*)(gbase) + _i * 8192;     \
        asm volatile("s_mov_b32 m0, %0\n\ts_nop 0\n\tglobal_load_lds_dwordx4 %1, %2" :: "s"(ldsb_ + (unsigned)((bufoff) + _i * 8192)), "v"((voff)[0]), "s"(gb_) : "memory", "m0"); } } while (0)
#define PG8_LDA(dst, b, h) do { if constexpr (FP8) { _Pragma("unroll") for (int m = 0; m < 4; ++m) { const bf16x8 lo_ = *(const PG8_LAS bf16x8*)(lds + PG8_SA(b, h) + aoff + m * 2048), hi_ = *(const PG8_LAS bf16x8*)(lds + PG8_SA(b, h) + aoff + m * 2048 + 1024); \
        dst##8[m] = __builtin_shufflevector(lo_, hi_, 0, 1, 2, 3, 4, 5, 6, 7, 8, 9, 10, 11, 12, 13, 14, 15); } } \
      else { _Pragma("unroll") for (int m = 0; m < 4; ++m) _Pragma("unroll") for (int k = 0; k < 2; ++k) dst[m][k] = *(const PG8_LAS bf16x8*)(lds + PG8_SA(b, h) + aoff + m * 2048 + k * 1024); } } while (0)
#define PG8_LDB(dst, b, h) do { if constexpr (FP8) { _Pragma("unroll") for (int n = 0; n < 2; ++n) { const bf16x8 lo_ = *(const PG8_LAS bf16x8*)(lds + PG8_SB(b, h) + boff + n * 2048), hi_ = *(const PG8_LAS bf16x8*)(lds + PG8_SB(b, h) + boff + n * 2048 + 1024); \
        dst##8[n] = __builtin_shufflevector(lo_, hi_, 0, 1, 2, 3, 4, 5, 6, 7, 8, 9, 10, 11, 12, 13, 14, 15); } } \
      else { _Pragma("unroll") for (int n = 0; n < 2; ++n) _Pragma("unroll") for (int k = 0; k < 2; ++k) dst[n][k] = *(const PG8_LAS bf16x8*)(lds + PG8_SB(b, h) + boff + n * 2048 + k * 1024); } } while (0)
#define PG8_CAT8(x0, x1) __builtin_shufflevector(__builtin_bit_cast(i32x4v, x0), __builtin_bit_cast(i32x4v, x1), 0, 1, 2, 3, 4, 5, 6, 7)
#define PG8_MMA(ai, bj, At, Bt) do { __builtin_amdgcn_s_setprio(1); if constexpr (FP8) { _Pragma("unroll") for (int m = 0; m < 4; ++m) _Pragma("unroll") for (int n = 0; n < 2; ++n) \
        acc[ai][bj][m][n] = __builtin_amdgcn_mfma_scale_f32_16x16x128_f8f6f4(__builtin_bit_cast(i32x8v, Bt##8[n]), __builtin_bit_cast(i32x8v, At##8[m]), acc[ai][bj][m][n], 0, 0, 0, 0x7f7f7f7f, 0, 0x7f7f7f7f); } \
      else { _Pragma("unroll") for (int m = 0; m < 4; ++m) _Pragma("unroll") for (int n = 0; n < 2; ++n) _Pragma("unroll") for (int k = 0; k < 2; ++k) \
        acc[ai][bj][m][n] = __builtin_amdgcn_mfma_f32_16x16x32_bf16(Bt[n][k], At[m][k], acc[ai][bj][m][n], 0, 0, 0); } __builtin_amdgcn_s_setprio(0); } while (0)
#define PG8_WAIT_V(n) asm volatile("s_waitcnt vmcnt(" #n ")" ::: "memory")
#define PG8_WAIT_L(n) asm volatile("s_waitcnt lgkmcnt(" #n ")" ::: "memory")
#define PG8_BAR __builtin_amdgcn_s_barrier()
#define PG8_SCHED __builtin_amdgcn_sched_barrier(0)
    Unit cur, nxt; int ui = 0;
    if (!S.next(0, cur)) return;
    f32x4 acc[2][2][4][2];
#pragma unroll
    for (int a = 0; a < 2; ++a)
#pragma unroll
        for (int b = 0; b < 2; ++b)
#pragma unroll
            for (int m = 0; m < 4; ++m)
#pragma unroll
                for (int n = 0; n < 2; ++n) acc[a][b][m][n] = (f32x4){0.f, 0.f, 0.f, 0.f};
    bf16x8 At[4][2], B0[2][2], B1[2][2];
    bf16x16v At8[4], B08[2], B18[2];
    u32x4 bx[8]; if constexpr (VAR == 2) { _Pragma("unroll") for (int j_ = 0; j_ < 8; ++j_) bx[j_] = (u32x4){0u, 0u, 0u, 0u}; }
    const char* cA = (const char*)g.A + (size_t)cur.pm * tstep; const char* cB = (const char*)g.Bt + (size_t)cur.pn * tstep;
    S.a_ready(cur);
    if constexpr (SP2) {
        PG8_STAGE(PG8_SB(0, 0), cB, voffB); PG8_STAGE(PG8_SB(0, 1), cB + hstep, voffB); PG8_STAGE(PG8_SA(0, 0), cA, voffA); PG8_STAGE(PG8_SA(0, 1), cA + hstep, voffA);
        if (wr == 1) PG8_BAR;
        PG8_WAIT_V(2); PG8_BAR;
        PG8_STAGE(PG8_SB(1, 0), cB + kstep, voffB); PG8_STAGE(PG8_SA(1, 0), cA + kstep, voffA); PG8_STAGE(PG8_SB(1, 1), cB + hstep + kstep, voffB);
        PG8_WAIT_V(6); PG8_BAR;
    } else {
        PG8_STAGE(PG8_SB(0, 0), cB, voffB); PG8_STAGE(PG8_SA(0, 0), cA, voffA); PG8_STAGE(PG8_SB(0, 1), cB + hstep, voffB); PG8_STAGE(PG8_SA(0, 1), cA + hstep, voffA);
        if (wr == 1) PG8_BAR;
        PG8_WAIT_V(4); PG8_BAR;
        PG8_STAGE(PG8_SB(1, 0), cB + kstep, voffB); PG8_STAGE(PG8_SA(1, 0), cA + kstep, voffA); PG8_STAGE(PG8_SB(1, 1), cB + hstep + kstep, voffB);
        PG8_WAIT_V(6); PG8_BAR;
    }
    for (;;) {
        const bool has_next = S.next(ui + 1, nxt);
        const char* nA = has_next ? (const char*)g.A + (size_t)nxt.pm * tstep : cA; const char* nB = has_next ? (const char*)g.Bt + (size_t)nxt.pn * tstep : cB;
        for (int t = 0; t < nt; t += 2) {
            const bool last = (t == nt - 2);
            const char* a1 = cA + (size_t)(t + 1) * kstep;
            const char* a2 = last ? nA : cA + (size_t)(t + 2) * kstep; const char* b2 = last ? nB : cB + (size_t)(t + 2) * kstep;
            const char* a3 = a2 + kstep; const char* b3 = b2 + kstep;
            if (last && has_next) S.a_ready(nxt);
            if constexpr (SP2) {
#define PG8_STB(bufoff, gbase) do { if constexpr (VAR == 0) { PG8_STAGE(bufoff, gbase, voffB); } } while (0)
#define PG8_WV() do { if constexpr (VAR == 0) { PG8_WAIT_V(8); } else if constexpr (VAR == 1) { PG8_WAIT_V(4); } else { PG8_WAIT_V(12); } } while (0)
#define PG8_WV0() do { if constexpr (FP8) { PG8_WV(); } else if constexpr (VAR == 0 && Epi::NVM_MIN == 16) { if (t == 0 && ui > 0) { PG8_WAIT_V(24); } else { PG8_WAIT_V(8); } } else if constexpr (VAR == 0 && Epi::NVM_MIN == 8) { if (t == 0 && ui > 0) { PG8_WAIT_V(16); } else { PG8_WAIT_V(8); } } else { PG8_WV(); } } while (0)
#define PG8_BREG(gbase) do { if constexpr (VAR == 2) { _Pragma("unroll") for (int j_ = 0; j_ < 8; ++j_) asm volatile("" :: "v"(bx[j_])); \
        _Pragma("unroll") for (int j_ = 0; j_ < 8; ++j_) bx[j_] = *(const u32x4*)((gbase) + wc * 8192 + j_ * 1024 + lane * 16); } } while (0)
            PG8_LDB(B0, 0, 0); PG8_LDB(B1, 0, 1); PG8_SCHED; PG8_LDA(At, 0, 0); PG8_STAGE(PG8_SA(1, 1), a1 + hstep, voffA); PG8_BREG(b2);
            PG8_WV0(); PG8_WAIT_L(0); PG8_BAR; PG8_MMA(0, 0, At, B0); PG8_MMA(0, 1, At, B1); PG8_BAR; PG8_SCHED;
            PG8_LDA(At, 0, 1); PG8_STB(PG8_SB(0, 0), b2); PG8_STB(PG8_SB(0, 1), b2 + hstep); PG8_STAGE(PG8_SA(0, 0), a2, voffA);
            PG8_WV0(); PG8_WAIT_L(0); PG8_BAR; PG8_MMA(1, 0, At, B0); PG8_MMA(1, 1, At, B1); PG8_BAR; PG8_SCHED;
            PG8_LDB(B0, 1, 0); PG8_LDB(B1, 1, 1); PG8_SCHED; PG8_LDA(At, 1, 0); PG8_STAGE(PG8_SA(0, 1), a2 + hstep, voffA); PG8_BREG(b3);
            PG8_WV(); PG8_WAIT_L(0); PG8_BAR; PG8_MMA(0, 0, At, B0); PG8_MMA(0, 1, At, B1); PG8_BAR; PG8_SCHED;
            PG8_LDA(At, 1, 1); PG8_STB(PG8_SB(1, 0), b3); PG8_STB(PG8_SB(1, 1), b3 + hstep); PG8_STAGE(PG8_SA(1, 0), a3, voffA);
            PG8_WV(); PG8_WAIT_L(0); PG8_BAR; PG8_MMA(1, 0, At, B0); PG8_MMA(1, 1, At, B1); PG8_BAR; PG8_SCHED;
#undef PG8_STB
#undef PG8_WV
#undef PG8_WV0
#undef PG8_BREG
            } else {
            PG8_LDB(B0, 0, 0); PG8_SCHED; PG8_LDA(At, 0, 0); PG8_STAGE(PG8_SA(1, 1), a1 + hstep, voffA);
            PG8_WAIT_L(8); PG8_BAR; PG8_WAIT_L(0); PG8_MMA(0, 0, At, B0); PG8_BAR; PG8_SCHED;
            PG8_LDB(B1, 0, 1); PG8_STAGE(PG8_SB(0, 0), b2, voffB);
            PG8_BAR; PG8_WAIT_L(0); PG8_MMA(0, 1, At, B1); PG8_BAR;
            PG8_LDA(At, 0, 1); PG8_STAGE(PG8_SA(0, 0), a2, voffA);
            PG8_BAR; PG8_WAIT_L(0); PG8_MMA(1, 0, At, B0); PG8_BAR; PG8_SCHED;
            PG8_STAGE(PG8_SB(0, 1), b2 + hstep, voffB);
            PG8_WAIT_V(6); PG8_BAR; PG8_MMA(1, 1, At, B1); PG8_BAR;
            PG8_LDB(B0, 1, 0); PG8_SCHED; PG8_LDA(At, 1, 0); PG8_STAGE(PG8_SA(0, 1), a2 + hstep, voffA);
            PG8_WAIT_L(8); PG8_BAR; PG8_WAIT_L(0); PG8_MMA(0, 0, At, B0); PG8_BAR; PG8_SCHED;
            PG8_LDB(B1, 1, 1); PG8_STAGE(PG8_SB(1, 0), b3, voffB);
            PG8_BAR; PG8_WAIT_L(0); PG8_MMA(0, 1, At, B1); PG8_BAR;
            PG8_LDA(At, 1, 1); PG8_STAGE(PG8_SA(1, 0), a3, voffA);
            PG8_BAR; PG8_WAIT_L(0); PG8_MMA(1, 0, At, B0); PG8_BAR; PG8_SCHED;
            PG8_STAGE(PG8_SB(1, 1), b3 + hstep, voffB);
            PG8_WAIT_V(6); PG8_BAR; PG8_MMA(1, 1, At, B1); PG8_BAR;
            }
        }
        if constexpr (ALIGN_EPI) { if (wr == 0) PG8_BAR; }
        if constexpr (!Epi::AFTER_DRAIN) {
            { int ln_; asm volatile("v_mbcnt_lo_u32_b32 %0, -1, 0\n\tv_mbcnt_hi_u32_b32 %0, -1, %0" : "=&v"(ln_)); E(acc, cur, wr, wc, ln_ & 15, ln_ >> 4); }
            S.done(cur); }
        if (!has_next) break;
#pragma unroll
        for (int a = 0; a < 2; ++a)
#pragma unroll
            for (int b = 0; b < 2; ++b)
#pragma unroll
                for (int m = 0; m < 4; ++m)
#pragma unroll
                    for (int n = 0; n < 2; ++n) acc[a][b][m][n] = (f32x4){0.f, 0.f, 0.f, 0.f};
        cur = nxt; cA = nA; cB = nB; ++ui;
        if constexpr (ALIGN_EPI) { if (wr == 1) PG8_BAR; }
    }
    PG8_WAIT_V(0);
    if constexpr (!ALIGN_EPI) { if (wr == 0) PG8_BAR; }
    PG8_BAR;
    if constexpr (Epi::AFTER_DRAIN) { E.fused(acc, cur, wr, wc, fr, fq, lds, wid, lane); S.done(cur); }
#undef PG8_SA
#undef PG8_SB
#undef PG8_STAGE
#undef PG8_LDA
#undef PG8_LDB
#undef PG8_MMA
#undef PG8_CAT8
#undef PG8_WAIT_V
#undef PG8_WAIT_L
#undef PG8_BAR
#undef PG8_SCHED
}
struct Gemm2 { const bf16_t* A; const bf16_t* Bt; int M, N, K, Ks; const bf16_t* A8; const bf16_t* B8; int K8; };
template <class Epi, class Sched>
__device__ __forceinline__ void gemm_phase_tail8(PG8_LAS unsigned char* lds, const Gemm2 g, const Sched& S, const Epi& E, const int wid) {
    int lane_; asm volatile("v_mbcnt_lo_u32_b32 %0, -1, 0\n\tv_mbcnt_hi_u32_b32 %0, -1, %0" : "=&v"(lane_));
    const int tid = wid * 64 + lane_, wr = wid >> 2, wc = wid & 3;
    const int ntA = g.K / BK, ntB = g.K8 / (2 * BK);
    unsigned voff[1]; voff[0] = (unsigned)(tid * 16);
    const size_t kstep = 32768, hstep = 16384, tstepA = (size_t)(g.Ks / BK) * 32768, tstepB = (size_t)ntB * 32768;
    const unsigned ldsw = (unsigned)wid * 1024u; const unsigned ldsb_ = (unsigned)(uintptr_t)lds + ldsw;
#define PT_SA(b, h) (((b) * 2 + (h)) * HTB)
#define PT_SB(b, h) ((4 + (b) * 2 + (h)) * HTB)
#define PT_STAGE(bufoff, gbase) do { _Pragma("unroll") for (int _i = 0; _i < 2; ++_i) { const char* gb_ = (const char*)(gbase) + _i * 8192; \
        asm volatile("s_mov_b32 m0, %0\n\ts_nop 0\n\tglobal_load_lds_dwordx4 %1, %2" :: "s"(ldsb_ + (unsigned)((bufoff) + _i * 8192)), "v"(voff[0]), "s"(gb_) : "memory", "m0"); } } while (0)
#define PT_LDA(F8, b, h) do { if constexpr (F8) { _Pragma("unroll") for (int m = 0; m < 4; ++m) { const bf16x8 lo_ = *(const PG8_LAS bf16x8*)(lds + PT_SA(b, h) + aoff + m * 2048), hi_ = *(const PG8_LAS bf16x8*)(lds + PT_SA(b, h) + aoff + m * 2048 + 1024); \
        At8[m] = __builtin_shufflevector(lo_, hi_, 0, 1, 2, 3, 4, 5, 6, 7, 8, 9, 10, 11, 12, 13, 14, 15); } } \
      else { _Pragma("unroll") for (int m = 0; m < 4; ++m) _Pragma("unroll") for (int k = 0; k < 2; ++k) At[m][k] = *(const PG8_LAS bf16x8*)(lds + PT_SA(b, h) + aoff + m * 2048 + k * 1024); } } while (0)
#define PT_LDB(F8, dst, b, h) do { if constexpr (F8) { _Pragma("unroll") for (int n = 0; n < 2; ++n) { const bf16x8 lo_ = *(const PG8_LAS bf16x8*)(lds + PT_SB(b, h) + boff + n * 2048), hi_ = *(const PG8_LAS bf16x8*)(lds + PT_SB(b, h) + boff + n * 2048 + 1024); \
        dst##8[n] = __builtin_shufflevector(lo_, hi_, 0, 1, 2, 3, 4, 5, 6, 7, 8, 9, 10, 11, 12, 13, 14, 15); } } \
      else { _Pragma("unroll") for (int n = 0; n < 2; ++n) _Pragma("unroll") for (int k = 0; k < 2; ++k) dst[n][k] = *(const PG8_LAS bf16x8*)(lds + PT_SB(b, h) + boff + n * 2048 + k * 1024); } } while (0)
#define PT_MMA(F8, ai, bj, Bt) do { __builtin_amdgcn_s_setprio(1); if constexpr (F8) { _Pragma("unroll") for (int m = 0; m < 4; ++m) _Pragma("unroll") for (int n = 0; n < 2; ++n) \
        acc[ai][bj][m][n] = __builtin_amdgcn_mfma_scale_f32_16x16x128_f8f6f4(__builtin_bit_cast(i32x8v, Bt##8[n]), __builtin_bit_cast(i32x8v, At8[m]), acc[ai][bj][m][n], 0, 0, 0, 0x78787878, 0, 0x7f7f7f7f); } \
      else { _Pragma("unroll") for (int m = 0; m < 4; ++m) _Pragma("unroll") for (int n = 0; n < 2; ++n) _Pragma("unroll") for (int k = 0; k < 2; ++k) \
        acc[ai][bj][m][n] = __builtin_amdgcn_mfma_f32_16x16x32_bf16(Bt[n][k], At[m][k], acc[ai][bj][m][n], 0, 0, 0); } __builtin_amdgcn_s_setprio(0); } while (0)
#define PT_WV asm volatile("s_waitcnt vmcnt(8)" ::: "memory")
#define PT_WL asm volatile("s_waitcnt lgkmcnt(0)" ::: "memory")
#define PT_BAR __builtin_amdgcn_s_barrier()
#define PT_SCHED __builtin_amdgcn_sched_barrier(0)
#define PT_BODY(F8) do { \
            PT_LDB(F8, B0, 0, 0); PT_LDB(F8, B1, 0, 1); PT_SCHED; PT_LDA(F8, 0, 0); PT_STAGE(PT_SA(1, 1), a1 + hstep); \
            PT_WV; PT_WL; PT_BAR; PT_MMA(F8, 0, 0, B0); PT_MMA(F8, 0, 1, B1); PT_BAR; PT_SCHED; \
            PT_LDA(F8, 0, 1); PT_STAGE(PT_SB(0, 0), b2); PT_STAGE(PT_SB(0, 1), b2 + hstep); PT_STAGE(PT_SA(0, 0), a2); \
            PT_WV; PT_WL; PT_BAR; PT_MMA(F8, 1, 0, B0); PT_MMA(F8, 1, 1, B1); PT_BAR; PT_SCHED; \
            PT_LDB(F8, B0, 1, 0); PT_LDB(F8, B1, 1, 1); PT_SCHED; PT_LDA(F8, 1, 0); PT_STAGE(PT_SA(0, 1), a2 + hstep); \
            PT_WV; PT_WL; PT_BAR; PT_MMA(F8, 0, 0, B0); PT_MMA(F8, 0, 1, B1); PT_BAR; PT_SCHED; \
            PT_LDA(F8, 1, 1); PT_STAGE(PT_SB(1, 0), b3); PT_STAGE(PT_SB(1, 1), b3 + hstep); PT_STAGE(PT_SA(1, 0), a3); \
            PT_WV; PT_WL; PT_BAR; PT_MMA(F8, 1, 0, B0); PT_MMA(F8, 1, 1, B1); PT_BAR; PT_SCHED; } while (0)
    Unit cur, nxt; int ui = 0;
    if (!S.next(0, cur)) return;
    f32x4 acc[2][2][4][2];
#pragma unroll
    for (int a = 0; a < 2; ++a)
#pragma unroll
        for (int b = 0; b < 2; ++b)
#pragma unroll
            for (int m = 0; m < 4; ++m)
#pragma unroll
                for (int n = 0; n < 2; ++n) acc[a][b][m][n] = (f32x4){0.f, 0.f, 0.f, 0.f};
    bf16x8 At[4][2], B0[2][2], B1[2][2];
    bf16x16v At8[4], B08[2], B18[2];
    const char* cA = (const char*)g.A + (size_t)cur.pm * tstepA; const char* cB = (const char*)g.Bt + (size_t)cur.pn * tstepA;
    const char* cA8 = (const char*)g.A8 + (size_t)cur.pm * tstepB; const char* cB8 = (const char*)g.B8 + (size_t)cur.pn * tstepB;
    PT_STAGE(PT_SB(0, 0), cB); PT_STAGE(PT_SB(0, 1), cB + hstep); PT_STAGE(PT_SA(0, 0), cA); PT_STAGE(PT_SA(0, 1), cA + hstep);
    if (wr == 1) PT_BAR;
    asm volatile("s_waitcnt vmcnt(2)" ::: "memory"); PT_BAR;
    PT_STAGE(PT_SB(1, 0), cB + kstep); PT_STAGE(PT_SA(1, 0), cA + kstep); PT_STAGE(PT_SB(1, 1), cB + hstep + kstep);
    asm volatile("s_waitcnt vmcnt(6)" ::: "memory"); PT_BAR;
    for (;;) {
        const bool has_next = S.next(ui + 1, nxt);
        const char* nA = has_next ? (const char*)g.A + (size_t)nxt.pm * tstepA : cA; const char* nB = has_next ? (const char*)g.Bt + (size_t)nxt.pn * tstepA : cB;
        {
            int ln_; asm volatile("v_mbcnt_lo_u32_b32 %0, -1, 0\n\tv_mbcnt_hi_u32_b32 %0, -1, %0" : "=&v"(ln_));
            const int aoff = lds_byte(wr * 64 + (ln_ & 15), (ln_ >> 4) * 8), boff = lds_byte(wc * 32 + (ln_ & 15), (ln_ >> 4) * 8);
            for (int t = 0; t < ntA; t += 2) { const bool last = (t == ntA - 2);
                const char* a1 = cA + (size_t)(t + 1) * kstep;
                const char* a2 = last ? cA8 : cA + (size_t)(t + 2) * kstep; const char* b2 = last ? cB8 : cB + (size_t)(t + 2) * kstep;
                const char* a3 = a2 + kstep; const char* b3 = b2 + kstep;
                PT_BODY(false); } }
        {
            int ln_; asm volatile("v_mbcnt_lo_u32_b32 %0, -1, 0\n\tv_mbcnt_hi_u32_b32 %0, -1, %0" : "=&v"(ln_));
            const int aoff = wr * 8192 + ln_ * 16, boff = wc * 4096 + ln_ * 16;
            for (int t = 0; t < ntB; t += 2) { const bool last = (t == ntB - 2);
                const char* a1 = cA8 + (size_t)(t + 1) * kstep;
                const char* a2 = last ? nA : cA8 + (size_t)(t + 2) * kstep; const char* b2 = last ? nB : cB8 + (size_t)(t + 2) * kstep;
                const char* a3 = a2 + kstep; const char* b3 = b2 + kstep;
                PT_BODY(true); } }
        if (wr == 0) PT_BAR;
        { int ln_; asm volatile("v_mbcnt_lo_u32_b32 %0, -1, 0\n\tv_mbcnt_hi_u32_b32 %0, -1, %0" : "=&v"(ln_)); E(acc, cur, wr, wc, ln_ & 15, ln_ >> 4); }
        if (!has_next) break;
#pragma unroll
        for (int a = 0; a < 2; ++a)
#pragma unroll
            for (int b = 0; b < 2; ++b)
#pragma unroll
                for (int m = 0; m < 4; ++m)
#pragma unroll
                    for (int n = 0; n < 2; ++n) acc[a][b][m][n] = (f32x4){0.f, 0.f, 0.f, 0.f};
        cur = nxt; cA = nA; cB = nB; cA8 = (const char*)g.A8 + (size_t)cur.pm * tstepB; cB8 = (const char*)g.B8 + (size_t)cur.pn * tstepB; ++ui;
        if (wr == 1) PT_BAR;
    }
    asm volatile("s_waitcnt vmcnt(0)" ::: "memory");
    PT_BAR;
#undef PT_SA
#undef PT_SB
#undef PT_STAGE
#undef PT_LDA
#undef PT_LDB
#undef PT_MMA
#undef PT_WV
#undef PT_WL
#undef PT_BAR
#undef PT_SCHED
#undef PT_BODY
}
}

#ifndef PG8_SP2
#define PG8_SP2 true
#endif
#ifndef PG8_ALIGN
#define PG8_ALIGN true
#endif
#ifndef PROBE_MASK
#define PROBE_MASK 0
#endif
#ifndef WGM_DOWN
#define WGM_DOWN 4
#endif
#ifndef PROBE_VAR
#define PROBE_VAR 0
#endif
constexpr int DN8_PN = 6;
constexpr int DN8_KT = 86 - DN8_PN;
#ifndef MK_N_LAUNCHES
#define MK_N_LAUNCHES 1
#endif

constexpr int D = 4096, DFF = 11008, NUP = 2 * DFF, NIN = 10240, AW = 2048, LW = 2048;
constexpr int MP = 16384, MS = 8192, MTOK = MP + MS;
constexpr int NMEM = 9 * 256;
constexpr int XAW = 512;
constexpr float EPS = 1e-6f;
constexpr int NWAVES = 8;
constexpr int N_PHASES = 13;

constexpr size_t MiB = 1u << 20;
constexpr size_t WS_CTL = 0, CTL_ZERO_BYTES = 2 * MiB;
constexpr size_t WS_WG = 2 * MiB, WS_WQ = 4 * MiB, WS_WKV = 8 * MiB, WS_WO = 16 * MiB, WS_MEMN = 20 * MiB;
constexpr size_t WS_WOUT = 38 * MiB, WS_WIN = 70 * MiB, WS_WUP1 = 150 * MiB, WS_WDN1 = 322 * MiB, WS_WUP2 = 408 * MiB, WS_WDN2 = 580 * MiB;
constexpr size_t WS_XN = 666 * MiB, WS_YA = WS_XN, WS_HF = WS_XN + 96 * MiB;
constexpr size_t WS_Y = 858 * MiB, WS_HB = 1050 * MiB, WS_PROJ = WS_HB, WS_XQ = WS_HB, WS_XO = WS_HB + 24 * MiB, WS_KVM = WS_HB + 48 * MiB;
constexpr size_t WS_HBK = 1566 * MiB, WS_END = 1662 * MiB;
static_assert(WS_WUP1 + (size_t)NUP * D * 2 <= WS_WDN1 && WS_WDN1 + (size_t)D * DFF * 2 <= WS_WUP2 && WS_WUP2 + (size_t)NUP * D * 2 <= WS_WDN2 && WS_WDN2 + (size_t)D * DFF * 2 <= WS_XN, "ws map (ffn weights)");
static_assert(WS_XN + (size_t)MTOK * D * 2 <= WS_Y && WS_Y + (size_t)MTOK * D * 2 <= WS_HB && WS_HB + (size_t)MTOK * DFF * 2 <= WS_HBK && WS_HBK + (size_t)MTOK * LW * 2 <= WS_END, "ws map (activations)");
static_assert(WS_MEMN + (size_t)NMEM * D * 2 <= WS_WOUT && WS_WOUT + (size_t)D * D * 2 <= WS_WIN && WS_WIN + (size_t)NIN * D * 2 <= WS_WUP1, "ws map (small)");
constexpr int CW_NACTR = 64;
constexpr int CW_CONVCTR = 256;
constexpr int CW_BAR = 4096;
constexpr int CW_SS = 16384;
static_assert((CW_SS + 6 * MTOK * 2) * 4 <= (int)CTL_ZERO_BYTES, "CTL words inside the memset region");

constexpr int RING_OFF = 0, RING_BYTES = 131072;
constexpr int LDSCTL_OFF = RING_BYTES, MISC_OFF = LDSCTL_OFF + 320;
constexpr int LDS_BYTES = 147456;
constexpr int XBPTR_LDS_OFF = RING_BYTES + 320 + 80;
constexpr int NA_BIAS_OFF = RING_BYTES + 1024;

#define GAS __attribute__((address_space(1)))
#define LAS __attribute__((address_space(3)))
typedef unsigned short bf16;
typedef unsigned v4u __attribute__((ext_vector_type(4)));
typedef unsigned v2u __attribute__((ext_vector_type(2)));
typedef float f32x4 __attribute__((ext_vector_type(4)));
typedef GAS unsigned gu32;
#define LDS_WAIT() asm volatile("s_waitcnt lgkmcnt(0)" ::: "memory")
#define VM_WAIT() asm volatile("s_waitcnt vmcnt(0)" ::: "memory")
__device__ __forceinline__ unsigned f2bf(float f) { unsigned u = __builtin_bit_cast(unsigned, f); return (u + 0x7fffu + ((u >> 16) & 1u)) >> 16; }
__device__ __forceinline__ unsigned pk2(float lo, float hi) { return f2bf(lo) | (f2bf(hi) << 16); }
__device__ __forceinline__ float bflo(unsigned w) { return __uint_as_float(w << 16); }
__device__ __forceinline__ float bfhi(unsigned w) { return __uint_as_float(w & 0xffff0000u); }
__device__ __forceinline__ float bf2f(bf16 b) { return __uint_as_float(((unsigned)b) << 16); }
__device__ __forceinline__ float wave_sum(float v) {
#pragma unroll
    for (int o = 1; o < 64; o <<= 1) v += __shfl_xor(v, o);
    return v;
}
__device__ __forceinline__ void unpack8(const v4u w, float (&f)[8]) { f[0] = bflo(w.x); f[1] = bfhi(w.x); f[2] = bflo(w.y); f[3] = bfhi(w.y); f[4] = bflo(w.z); f[5] = bfhi(w.z); f[6] = bflo(w.w); f[7] = bfhi(w.w); }

namespace pg8 {
typedef unsigned long long ssq_t;
__device__ __forceinline__ float ss_get(const ssq_t* p) { const ssq_t v = *p; return ((float)(unsigned)(v >> 32) * 4294967296.0f + (float)(unsigned)v) * (1.0f / 65536.0f); }
__device__ __forceinline__ ssq_t ss_fix(float s) { return (ssq_t)(s * 65536.0f); }
__device__ __forceinline__ float ss_val(ssq_t v) { return ((float)(unsigned)(v >> 32) * 4294967296.0f + (float)(unsigned)v) * (1.0f / 65536.0f); }
struct EpiSwiGLU {
    static constexpr bool PERM = true, AFTER_DRAIN = false; static constexpr int NVM_MIN = 8;
    bf16_t* H; const ssq_t* ss; int pn8; float rsc; char* H8;
    __device__ __forceinline__ void operator()(const f32x4 (&acc)[2][2][4][2], const Unit& u, int wr, int wc, int fr, int fq) const {
        const int row0 = u.pm * BM + wr * 64 + fr, col0 = u.pn * HALF + wc * 32 + 8 * fq;
        ssq_t sv[2][4];
#pragma unroll
        for (int ai = 0; ai < 2; ++ai)
#pragma unroll
            for (int m = 0; m < 4; ++m) sv[ai][m] = ss[row0 + ai * HALF + m * 16];
#pragma unroll
        for (int ai = 0; ai < 2; ++ai)
#pragma unroll
            for (int m = 0; m < 4; ++m) { const int row = row0 + ai * HALF + m * 16; const float rs = rsqrtf(ss_val(sv[ai][m]) * (1.0f / 4096.0f) + 1e-6f) * rsc;
                float hv[8]; const float nlr = -1.4426950408889634f * rs, rs2 = rs * rs;
#pragma unroll
                for (int n = 0; n < 2; ++n)
#pragma unroll
                    for (int j = 0; j < 4; j += 2) { const f32x2 a2 = {acc[ai][0][m][n][j], acc[ai][0][m][n][j + 1]}, b2 = {acc[ai][1][m][n][j], acc[ai][1][m][n][j + 1]};
                        const f32x2 t = a2 * nlr; f32x2 e; e.x = __builtin_amdgcn_exp2f(t.x); e.y = __builtin_amdgcn_exp2f(t.y);
                        const f32x2 d = e + 1.0f; f32x2 s; s.x = __builtin_amdgcn_rcpf(d.x); s.y = __builtin_amdgcn_rcpf(d.y);
                        const f32x2 r = (a2 * b2) * (s * rs2); hv[4 * n + j] = r.x; hv[4 * n + j + 1] = r.y; }
                if (u.pn >= pn8) { int w0 = 0, w1 = 0; w0 = __builtin_amdgcn_cvt_pk_fp8_f32(hv[0], hv[1], w0, false); w0 = __builtin_amdgcn_cvt_pk_fp8_f32(hv[2], hv[3], w0, true);
                    w1 = __builtin_amdgcn_cvt_pk_fp8_f32(hv[4], hv[5], w1, false); w1 = __builtin_amdgcn_cvt_pk_fp8_f32(hv[6], hv[7], w1, true);
                    typedef int i32x2v __attribute__((ext_vector_type(2))); *(i32x2v*)(H8 + blk8_off(row, col0 - pn8 * HALF, 86 - pn8)) = (i32x2v){w0, w1}; }
                else { u32x4 w; w.x = cvt_pk_bf16(hv[0], hv[1]); w.y = cvt_pk_bf16(hv[2], hv[3]); w.z = cvt_pk_bf16(hv[4], hv[5]); w.w = cvt_pk_bf16(hv[6], hv[7]);
                    *(u32x4*)((char*)H + blk_off(row, col0, 172)) = w; } }
    }
};
struct EpiNull {
    static constexpr bool PERM = true, AFTER_DRAIN = false; static constexpr int NVM_MIN = 0;
    __device__ __forceinline__ void operator()(const f32x4 (&acc)[2][2][4][2], const Unit&, int, int, int, int) const {
#pragma unroll
        for (int a = 0; a < 2; ++a)
#pragma unroll
            for (int b = 0; b < 2; ++b)
#pragma unroll
                for (int m = 0; m < 4; ++m)
#pragma unroll
                    for (int n = 0; n < 2; ++n) asm volatile("" :: "v"(acc[a][b][m][n])); }
};
template <class E_> struct EpiTwice {
    static constexpr bool PERM = E_::PERM, AFTER_DRAIN = false; static constexpr int NVM_MIN = E_::NVM_MIN; E_ e;
    __device__ __forceinline__ void operator()(const f32x4 (&acc)[2][2][4][2], const Unit& u, int wr, int wc, int fr, int fq) const { e(acc, u, wr, wc, fr, fq); asm volatile("" ::: "memory"); e(acc, u, wr, wc, fr, fq); }
};
struct EpiResid {
    static constexpr bool PERM = true, AFTER_DRAIN = false; static constexpr int NVM_MIN = 16;
    bf16_t* xb; ssq_t* ssout; char* x8; float alpha;
    __device__ __forceinline__ void operator()(const f32x4 (&acc)[2][2][4][2], const Unit& u, int wr, int wc, int fr, int fq) const {
        const int row0 = u.pm * BM + wr * 64 + fr, col0 = u.pn * BM + wc * 32 + 8 * fq;
        bf16_t* xb = this->xb;
        if (!xb) {
            const unsigned lo_ = __builtin_amdgcn_readfirstlane(*(volatile PG8_LAS unsigned*)(PG8_LAS unsigned char*)(uintptr_t)XBPTR_LDS_OFF), hi_ = __builtin_amdgcn_readfirstlane(*(volatile PG8_LAS unsigned*)(PG8_LAS unsigned char*)(uintptr_t)(XBPTR_LDS_OFF + 4));
            xb = (bf16_t*)(((unsigned long long)hi_ << 32) | lo_); }
        u32x4 xv[2][4][2];
#pragma unroll
        for (int ai = 0; ai < 2; ++ai)
#pragma unroll
            for (int m = 0; m < 4; ++m)
#pragma unroll
                for (int bj = 0; bj < 2; ++bj) { unsigned long long o_ = blk_off(row0 + ai * HALF + m * 16, col0 + bj * HALF, 64); asm volatile("" : "+v"(o_)); xv[ai][m][bj] = *(const u32x4*)((const char*)xb + o_); }
#pragma unroll
        for (int ai = 0; ai < 2; ++ai)
#pragma unroll
            for (int m = 0; m < 4; ++m) { const int row = row0 + ai * HALF + m * 16; float sq = 0.f;
#pragma unroll
                for (int bj = 0; bj < 2; ++bj) { unsigned long long o_ = blk_off(row, col0 + bj * HALF, 64); asm volatile("" : "+v"(o_));
                    u32x4* p = (u32x4*)((char*)xb + o_); const u32x4 xi = xv[ai][m][bj];
                    const f32x4 a0 = acc[ai][bj][m][0] * alpha, a1 = acc[ai][bj][m][1] * alpha;
                    const float v0 = __uint_as_float(xi.x << 16) + a0[0], v1 = __uint_as_float(xi.x & 0xffff0000u) + a0[1], v2 = __uint_as_float(xi.y << 16) + a0[2], v3 = __uint_as_float(xi.y & 0xffff0000u) + a0[3];
                    const float v4 = __uint_as_float(xi.z << 16) + a1[0], v5 = __uint_as_float(xi.z & 0xffff0000u) + a1[1], v6 = __uint_as_float(xi.w << 16) + a1[2], v7 = __uint_as_float(xi.w & 0xffff0000u) + a1[3];
                    sq += ((v0 * v0 + v1 * v1) + (v2 * v2 + v3 * v3)) + ((v4 * v4 + v5 * v5) + (v6 * v6 + v7 * v7));
                    u32x4 w; w.x = cvt_pk_bf16(v0, v1); w.y = cvt_pk_bf16(v2, v3); w.z = cvt_pk_bf16(v4, v5); w.w = cvt_pk_bf16(v6, v7); *p = w;
                    if (x8) { int w0 = 0, w1 = 0; w0 = __builtin_amdgcn_cvt_pk_fp8_f32(v0, v1, w0, false); w0 = __builtin_amdgcn_cvt_pk_fp8_f32(v2, v3, w0, true); w1 = __builtin_amdgcn_cvt_pk_fp8_f32(v4, v5, w1, false); w1 = __builtin_amdgcn_cvt_pk_fp8_f32(v6, v7, w1, true);
                        typedef int i32x2v __attribute__((ext_vector_type(2))); *(i32x2v*)(x8 + blk8_off(row, col0 + bj * HALF, 32)) = (i32x2v){w0, w1}; } }
                { const int la_ = (fq * 16 + fr) << 2;
                  sq += __builtin_bit_cast(float, __builtin_amdgcn_ds_bpermute(la_ ^ 64, __builtin_bit_cast(int, sq))); sq += __builtin_bit_cast(float, __builtin_amdgcn_ds_bpermute(la_ ^ 128, __builtin_bit_cast(int, sq))); }
                if (fq == 0 && ssout) atomicAdd(ssout + row, ss_fix(sq)); }
    }
};
struct EpiScaleBf16 {
    static constexpr bool PERM = true, AFTER_DRAIN = false; static constexpr int NVM_MIN = 16;
    bf16_t* O; int ldc; const ssq_t* ss; float qscale; int qcols;
    __device__ __forceinline__ void operator()(const f32x4 (&acc)[2][2][4][2], const Unit& u, int wr, int wc, int fr, int fq) const {
        const int row0 = u.pm * BM + wr * 64 + fr, col0 = u.pn * BM + wc * 32 + 8 * fq;
        const float sc = (u.pn * BM < qcols) ? qscale : 1.0f;
        ssq_t sv[2][4];
#pragma unroll
        for (int ai = 0; ai < 2; ++ai)
#pragma unroll
            for (int m = 0; m < 4; ++m) sv[ai][m] = ss ? ss[row0 + ai * HALF + m * 16] : 0ull;
#pragma unroll
        for (int ai = 0; ai < 2; ++ai)
#pragma unroll
            for (int m = 0; m < 4; ++m) { const int row = row0 + ai * HALF + m * 16; const float rs = (ss ? rsqrtf(ss_val(sv[ai][m]) * (1.0f / 4096.0f) + 1e-6f) : 1.0f) * sc;
                bf16_t* rowp = O + (size_t)row * ldc + col0;
#pragma unroll
                for (int bj = 0; bj < 2; ++bj) { const f32x4 v0 = acc[ai][bj][m][0] * rs, v1 = acc[ai][bj][m][1] * rs;
                    u32x4 w; w.x = cvt_pk_bf16(v0[0], v0[1]); w.y = cvt_pk_bf16(v0[2], v0[3]); w.z = cvt_pk_bf16(v1[0], v1[1]); w.w = cvt_pk_bf16(v1[2], v1[3]);
                    *(u32x4*)(rowp + bj * HALF) = w; } }
    }
};
struct EpiProj {
    static constexpr bool PERM = true, AFTER_DRAIN = false; static constexpr int NVM_MIN = 16;
    bf16_t* QKVH; bf16_t* UG; const ssq_t* ss; float qscale;
    __device__ __forceinline__ void operator()(const f32x4 (&acc)[2][2][4][2], const Unit& u, int wr, int wc, int fr, int fq) const {
        const int row0 = u.pm * BM + wr * 64 + fr, dimoff = wc * 32 + 8 * fq;
        const int kind = u.pn >> 3; const float sc = (kind == 0) ? qscale : 1.0f;
        ssq_t sv[2][4];
#pragma unroll
        for (int ai = 0; ai < 2; ++ai)
#pragma unroll
            for (int m = 0; m < 4; ++m) sv[ai][m] = ss[row0 + ai * HALF + m * 16];
#pragma unroll
        for (int ai = 0; ai < 2; ++ai)
#pragma unroll
            for (int m = 0; m < 4; ++m) { const int row = row0 + ai * HALF + m * 16; const float rs = rsqrtf(ss_val(sv[ai][m]) * (1.0f / 4096.0f) + 1e-6f) * sc;
#pragma unroll
                for (int bj = 0; bj < 2; ++bj) { const f32x4 v0 = acc[ai][bj][m][0] * rs, v1 = acc[ai][bj][m][1] * rs;
                    u32x4 w; w.x = cvt_pk_bf16(v0[0], v0[1]); w.y = cvt_pk_bf16(v0[2], v0[3]); w.z = cvt_pk_bf16(v1[0], v1[1]); w.w = cvt_pk_bf16(v1[2], v1[3]);
                    bf16_t* p = (u.pn < 24) ? QKVH + ((size_t)(kind * 16 + 2 * (u.pn & 7) + bj) * 24576 + row) * 128 + dimoff
                                            : UG + (size_t)row * 4096 + (u.pn - 24) * 256 + bj * HALF + dimoff;
                    *(u32x4*)p = w; } }
    }
};
}

__device__ __forceinline__ void transpose_item(const float* W, int K, int N, bf16* WTd, int k0, int n0, LAS float* scr, int lane) {
#pragma unroll 8
    for (int i = 0; i < 32; ++i) { const int kk = 2 * i + (lane >> 5); scr[kk * 33 + (lane & 31)] = W[(size_t)(k0 + kk) * N + n0 + (lane & 31)]; }
    LDS_WAIT(); asm volatile("" ::: "memory");
    const int c = lane & 7;
#pragma unroll
    for (int j = 0; j < 4; ++j) { const int n = (lane >> 3) + 8 * j; const LAS float* s = scr + (8 * c) * 33 + n;
        v4u o; o.x = pk2(s[0 * 33], s[1 * 33]); o.y = pk2(s[2 * 33], s[3 * 33]); o.z = pk2(s[4 * 33], s[5 * 33]); o.w = pk2(s[6 * 33], s[7 * 33]);
        *(GAS v4u*)(WTd + (size_t)n * K + k0 + 8 * c) = o; }
    LDS_WAIT(); asm volatile("" ::: "memory");
}
__device__ __forceinline__ void transpose_item_blk(const float* W, int K, int N, char* tkb, int k0, int n0, int r0, bool perm, const float* gk, LAS float* scr, int lane) {
    f32x4 v[8];
#pragma unroll
    for (int i = 0; i < 8; ++i) v[i] = *(const f32x4*)(W + (size_t)(k0 + (lane >> 3) + 8 * i) * N + n0 + (lane & 7) * 4);
#pragma unroll
    for (int i = 0; i < 8; ++i) { LAS float* d = scr + ((lane >> 3) + 8 * i) * 33 + (lane & 7) * 4; d[0] = v[i][0]; d[1] = v[i][1]; d[2] = v[i][2]; d[3] = v[i][3]; }
    const int c = lane & 7;
    f32x4 g0 = {1.f, 1.f, 1.f, 1.f}, g1 = {1.f, 1.f, 1.f, 1.f};
    if (gk) { g0 = *(const f32x4*)(gk + k0 + 8 * c); g1 = *(const f32x4*)(gk + k0 + 8 * c + 4); }
    LDS_WAIT(); asm volatile("" ::: "memory");
#pragma unroll
    for (int j = 0; j < 4; ++j) { const int n = (lane >> 3) + 8 * j; const LAS float* s = scr + (8 * c) * 33 + n;
        v4u o; o.x = pk2(s[0 * 33] * g0[0], s[1 * 33] * g0[1]); o.y = pk2(s[2 * 33] * g0[2], s[3 * 33] * g0[3]); o.z = pk2(s[4 * 33] * g1[0], s[5 * 33] * g1[1]); o.w = pk2(s[6 * 33] * g1[2], s[7 * 33] * g1[3]);
        const int rt = r0 + (perm ? pg8::perm32inv(n) : n);
        *(GAS v4u*)(tkb + ((rt >> 7) << 14) + pg8::lds_byte(rt & 127, 8 * c)) = o; }
    LDS_WAIT(); asm volatile("" ::: "memory");
}
__device__ __forceinline__ void transpose_item_f8(const float* W, int K, int N, char* tkb, int k0, int n0, int r0, bool perm, float scale, const float* gk, LAS float* scr, int lane) {
    f32x4 v[8];
#pragma unroll
    for (int i = 0; i < 8; ++i) v[i] = *(const f32x4*)(W + (size_t)(k0 + (lane >> 3) + 8 * i) * N + n0 + (lane & 7) * 4);
#pragma unroll
    for (int i = 0; i < 8; ++i) { LAS float* d = scr + ((lane >> 3) + 8 * i) * 33 + (lane & 7) * 4; d[0] = v[i][0]; d[1] = v[i][1]; d[2] = v[i][2]; d[3] = v[i][3]; }
    LDS_WAIT(); asm volatile("" ::: "memory");
    const int n = lane & 31, rt = r0 + (perm ? pg8::perm32inv(n) : n), r = rt & 127;
#pragma unroll
    for (int e = 0; e < 2; ++e) { const int c = (lane >> 5) + 2 * e; const LAS float* s = scr + (16 * c) * 33 + n; int w[4];
#pragma unroll
        for (int q = 0; q < 4; ++q) { f32x4 gq = {scale, scale, scale, scale}; if (gk) gq = *(const f32x4*)(gk + k0 + 16 * c + 4 * q) * scale;
            int t = 0; t = __builtin_amdgcn_cvt_pk_fp8_f32(s[(4 * q) * 33] * gq[0], s[(4 * q + 1) * 33] * gq[1], t, false); t = __builtin_amdgcn_cvt_pk_fp8_f32(s[(4 * q + 2) * 33] * gq[2], s[(4 * q + 3) * 33] * gq[3], t, true); w[q] = t; }
        const int c8 = ((k0 & 127) >> 4) + c;
        *(GAS v4u*)(tkb + ((rt >> 7) << 14) + (r >> 4) * 2048 + (c8 & 1) * 1024 + ((c8 >> 1) * 16 + (r & 15)) * 16) = (v4u){(unsigned)w[0], (unsigned)w[1], (unsigned)w[2], (unsigned)w[3]}; }
    LDS_WAIT(); asm volatile("" ::: "memory");
}
__device__ __forceinline__ void transpose_matrix(const float* W, int K, int N, bf16* WT, int row_off, bool perm, const float* gk, LAS float* scr, int lane, int gw, int NGW) {
    const int nblk = N / 32, nkt = K / 64, nitems = nkt * nblk;
    for (int it = gw; it < nitems; it += NGW) { const int kb = it / nblk, nb = it % nblk, drow = row_off + 32 * nb;
        transpose_item_blk(W, K, N, (char*)WT + ((size_t)((drow >> 8) * nkt + kb) << 15), 64 * kb, 32 * nb, drow & 255, perm, gk, scr, lane); }
}
__device__ __forceinline__ void transpose_up(const float* W1, const float* W3, bf16* WT, const float* gk, LAS float* scr, int lane, int gw, int NGW) {
    const int nblk = DFF / 32, nkt = D / 64, per = nkt * nblk;
    for (int it = gw; it < 2 * per; it += NGW) { const int which = it >= per, r = which ? it - per : it; const int kb = r / nblk, nb = r % nblk, n0 = 32 * nb;
        transpose_item_blk(which ? W3 : W1, D, DFF, (char*)WT + ((size_t)((n0 >> 7) * nkt + kb) << 15), 64 * kb, n0, (n0 & 127) + (which ? 128 : 0), true, gk, scr, lane); }
}

__device__ __forceinline__ float gelu_tanh(float x) { return 0.5f * x * (1.0f + tanhf(0.7978845608028654f * (x + 0.044715f * x * x * x))); }


typedef short bf16x8s __attribute__((ext_vector_type(8)));
typedef short s16x4 __attribute__((ext_vector_type(4)));
__device__ __forceinline__ s16x4 tr_read16(unsigned addr) { s16x4 r; asm volatile("ds_read_b64_tr_b16 %0, %1" : "=&v"(r) : "v"(addr) : "memory"); return r; }
template <bool IS_NA>
__device__ __forceinline__ void attn_task(const bf16* qp, const bf16* kbase, const bf16* vbase, size_t stride, int irows, const float* brow0, int c, int cs, int c0,
                                          bf16* op, int orow, int ocol, LAS unsigned char* wl, int lane) {
    const int fr = lane & 15, fq = lane >> 4;
    bf16x8s qf[4];
#pragma unroll
    for (int ks = 0; ks < 4; ++ks) qf[ks] = *(const bf16x8s*)(qp + 32 * ks);
    f32x4 S[8][2];
    bf16x8s kr[3][2][4];
#define AT_LOADK(slot, i) do { _Pragma("unroll") for (int hh = 0; hh < 2; ++hh) _Pragma("unroll") for (int ks = 0; ks < 4; ++ks) \
        kr[slot][hh][ks] = *(const bf16x8s*)(kbase + (size_t)((i) * irows + 4 * hh) * stride + 32 * ks); } while (0)
#define AT_SCORE(slot, i) do { _Pragma("unroll") for (int hh = 0; hh < 2; ++hh) { f32x4 a_ = {0.f, 0.f, 0.f, 0.f}; \
        _Pragma("unroll") for (int ks = 0; ks < 4; ++ks) a_ = __builtin_amdgcn_mfma_f32_16x16x32_bf16(kr[slot][hh][ks], qf[ks], a_, 0, 0, 0); S[i][hh] = a_; } } while (0)
    v4u vr[3][8];
#define AT_LOADV(slot, i) do { _Pragma("unroll") for (int inst = 0; inst < 8; ++inst) vr[slot][inst] = *(const v4u*)(vbase + (size_t)((i) * irows + 4 * inst) * stride); } while (0)
    AT_LOADK(0, 0); AT_LOADK(1, 1); AT_LOADK(2, 2);
    __builtin_amdgcn_sched_barrier(0);
#pragma unroll
    for (int i = 0; i < 8; ++i) {
        AT_SCORE(i % 3, i); __builtin_amdgcn_sched_barrier(0);
        if (i + 3 < 8) { AT_LOADK(i % 3, i + 3); } else { AT_LOADV(i - 5, i - 5); }
        __builtin_amdgcn_sched_barrier(0);
    }
#undef AT_LOADK
#undef AT_SCORE
    float mx = -1e30f;
#pragma unroll
    for (int hh = 0; hh < 2; ++hh)
#pragma unroll
        for (int j = 0; j < 4; ++j) {
            bool ok = true; int bi = 0;
            if (IS_NA) { const int kc = c0 + 8 * fq + 4 * hh + j; ok = (kc >= cs) && (kc < cs + 16); bi = min(max(kc - c + 15, 0), 30); }
#pragma unroll
            for (int i = 0; i < 8; ++i) { float s = S[i][hh][j]; if (IS_NA) { s = ok ? s + brow0[i * 31 + bi] : -1e30f; S[i][hh][j] = s; } mx = fmaxf(mx, s); } }
    mx = fmaxf(mx, __shfl_xor(mx, 16)); mx = fmaxf(mx, __shfl_xor(mx, 32));
    float l = 0.f;
    v4u pw[8];
#pragma unroll
    for (int i = 0; i < 8; ++i) {
#pragma unroll
        for (int hh = 0; hh < 2; ++hh)
#pragma unroll
            for (int j = 0; j < 4; ++j) { const float p = __builtin_amdgcn_exp2f((S[i][hh][j] - mx) * 1.4426950408889634f); S[i][hh][j] = p; l += p; }
        pw[i].x = pg8::cvt_pk_bf16(S[i][0][0], S[i][0][1]); pw[i].y = pg8::cvt_pk_bf16(S[i][0][2], S[i][0][3]); pw[i].z = pg8::cvt_pk_bf16(S[i][1][0], S[i][1][1]); pw[i].w = pg8::cvt_pk_bf16(S[i][1][2], S[i][1][3]); }
    l += __shfl_xor(l, 16); l += __shfl_xor(l, 32);
    const int rho0 = lane >> 4, ch = lane & 15, q_ = (lane & 15) >> 2, p_ = lane & 3;
    const unsigned wbase = (unsigned)(uintptr_t)wl;
    unsigned rrow[2], rf[2];
#pragma unroll
    for (int h2 = 0; h2 < 2; ++h2) { const int row = 8 * fq + 4 * h2 + q_; rrow[h2] = wbase + 256u * row + 8u * (p_ & 1); rf[h2] = (unsigned)((q_ << 2) | ((2 * fq + h2) & 3)); }
    f32x4 O[8];
#pragma unroll
    for (int dt = 0; dt < 8; ++dt) O[dt] = (f32x4){0.f, 0.f, 0.f, 0.f};
#pragma unroll
    for (int i = 0; i < 8; ++i) {
#pragma unroll
        for (int inst = 0; inst < 8; ++inst) { const int rho = rho0 + 4 * inst; const int f = (rho0 << 2) | (inst & 3); *(LAS v4u*)(wl + 256 * rho + 16 * (ch ^ f)) = vr[i % 3][inst]; }
        if (i + 3 < 8) { AT_LOADV(i % 3, i + 3); }
        const bf16x8s pf = __builtin_bit_cast(bf16x8s, pw[i]);
        s16x4 lo[8], hi[8];
#pragma unroll
        for (int dt = 0; dt < 8; ++dt) { lo[dt] = tr_read16(rrow[0] + 16u * ((unsigned)(2 * dt + (p_ >> 1)) ^ rf[0])); hi[dt] = tr_read16(rrow[1] + 16u * ((unsigned)(2 * dt + (p_ >> 1)) ^ rf[1])); }
        asm volatile("s_waitcnt lgkmcnt(0)" ::: "memory"); __builtin_amdgcn_sched_barrier(0);
#pragma unroll
        for (int dt = 0; dt < 8; ++dt) { const bf16x8s vf = (bf16x8s){lo[dt][0], lo[dt][1], lo[dt][2], lo[dt][3], hi[dt][0], hi[dt][1], hi[dt][2], hi[dt][3]};
            O[dt] = __builtin_amdgcn_mfma_f32_16x16x32_bf16(vf, pf, O[dt], 0, 0, 0); }
    }
#undef AT_LOADV
    const float inv = 1.0f / l;
#pragma unroll
    for (int dt = 0; dt < 8; ++dt) { const f32x4 v = O[dt] * inv; v2u o; o.x = pg8::cvt_pk_bf16(v[0], v[1]); o.y = pg8::cvt_pk_bf16(v[2], v[3]);
        if (IS_NA) *(v2u*)(op + dt * 16) = o; else *(v2u*)((char*)op + pg8::blk_off(orow, ocol + dt * 16, 8)) = o; }
}
__device__ __forceinline__ void na_block_task(int t, const bf16* PROJ, const float* rpb, bf16* YA, LAS unsigned char* lds, int wave, int lane, int dup = 0) {
    const int hp = t / 384, R = t % 384, g = wave & 3, h = 2 * hp + (dup ? 0 : (wave >> 2));
    int r, rows, seq0; if (R < 256) { seq0 = (R >> 5) * 2048; r = R & 31; rows = 32; } else { seq0 = MP; r = R - 256; rows = 128; }
    const int fr = lane & 15, fq = lane >> 4;
    const int rst = min(max(r - 4, 0), rows - 8), c0 = min(max(16 * g - 8, 0), 32), c = 16 * g + fr, cs = min(max(c - 8, 0), 48);
    const size_t m = (size_t)R * 64 + c;
    const bf16* qp = PROJ + ((size_t)h * MTOK + m) * 128 + 8 * fq;
    const bf16* kbase = PROJ + ((size_t)(16 + h) * MTOK + seq0 + rst * 64 + c0 + 8 * (fr >> 2) + (fr & 3)) * 128 + 8 * fq;
    const bf16* vbase = PROJ + ((size_t)(32 + h) * MTOK + seq0 + rst * 64 + c0 + (lane >> 4)) * 128 + (lane & 15) * 8;
    const float* brow0 = rpb + (h * 15 + (rst - r + 7)) * 31;
    attn_task<true>(qp, kbase, vbase, (size_t)128, 64, brow0, c, cs, c0, YA + m * AW + h * 128 + 4 * fq, 0, 0, lds + RING_OFF + wave * 8192, lane);
}
__device__ __forceinline__ void wait_vmcnt_n(int n) {
    switch (n) { case 0: asm volatile("s_waitcnt vmcnt(0)" ::: "memory"); break; case 2: asm volatile("s_waitcnt vmcnt(2)" ::: "memory"); break; case 4: asm volatile("s_waitcnt vmcnt(4)" ::: "memory"); break;
                 case 6: asm volatile("s_waitcnt vmcnt(6)" ::: "memory"); break; case 8: asm volatile("s_waitcnt vmcnt(8)" ::: "memory"); break; case 10: asm volatile("s_waitcnt vmcnt(10)" ::: "memory"); break;
                 case 12: asm volatile("s_waitcnt vmcnt(12)" ::: "memory"); break; default: asm volatile("s_waitcnt vmcnt(0)" ::: "memory"); break; } }
template <int OFF>
__device__ __forceinline__ void na_coop_body(const bf16* kg, const bf16* vg, int nU, const bf16* qp, const LAS float* brow0, int c, int cs, int c0, bf16* op, LAS unsigned char* lds, int wave, int lane) {
    constexpr int NR = 8;
    const int fr = lane & 15, fq = lane >> 4;
    bf16x8s qf[4];
#pragma unroll
    for (int ks = 0; ks < 4; ++ks) qf[ks] = *(const bf16x8s*)(qp + 32 * ks);
    unsigned goff[2];
#pragma unroll
    for (int e = 0; e < 2; ++e) { const int key = wave * 8 + e * 4 + (lane >> 4), chp = lane & 15, f = ((key & 3) << 2) | ((key >> 2) & 3); goff[e] = (unsigned)((key * 128 + (chp ^ f) * 8) * 2); }
#define NC_ISSUE(it) do { const int j_ = ((it) % 9) < nU ? ((it) % 9) : nU - 1; const bf16* b_ = ((it) < 9 ? kg : vg) + (size_t)j_ * 64 * 128; \
        _Pragma("unroll") for (int e_ = 0; e_ < 2; ++e_) __builtin_amdgcn_global_load_lds((const unsigned*)((const char*)b_ + goff[e_]), (LAS unsigned*)(lds + ((it) % NR) * 16384 + wave * 2048 + e_ * 1024), 16, 0, 0); } while (0)
#define NC_NWAIT(it) (2 * (((it) + NR - 2 < 17 ? (it) + NR - 2 : 17) - (it)))
#pragma unroll
    for (int s_ = 0; s_ < NR - 1; ++s_) { NC_ISSUE(s_); }
    unsigned kro[2], krf[2];
#pragma unroll
    for (int hh = 0; hh < 2; ++hh) { const int key = c0 + 8 * (fr >> 2) + 4 * hh + (fr & 3); kro[hh] = (unsigned)(256 * key); krf[hh] = (unsigned)(((key & 3) << 2) | ((key >> 2) & 3)); }
    f32x4 S[8][2];
#pragma unroll
    for (int it = 0; it < 9; ++it) {
        unsigned rb_ = (unsigned)((it % NR) * 16384); asm volatile("" : "+s"(rb_));
        LAS unsigned char* buf = lds + rb_;
        wait_vmcnt_n(NC_NWAIT(it)); __builtin_amdgcn_s_barrier(); asm volatile("" ::: "memory");
        NC_ISSUE(it + NR - 1);
        if (it - OFF >= 0 && it - OFF < 8) {
#pragma unroll
            for (int hh = 0; hh < 2; ++hh) { f32x4 a_ = {0.f, 0.f, 0.f, 0.f};
#pragma unroll
                for (int ks = 0; ks < 4; ++ks) { const bf16x8s kf = *(const LAS bf16x8s*)(buf + kro[hh] + 16u * ((unsigned)(4 * ks + fq) ^ krf[hh]));
                    a_ = __builtin_amdgcn_mfma_f32_16x16x32_bf16(kf, qf[ks], a_, 0, 0, 0); }
                S[it - OFF][hh] = a_; } }
    }
    float mx = -1e30f;
#pragma unroll
    for (int hh = 0; hh < 2; ++hh)
#pragma unroll
        for (int j = 0; j < 4; ++j) { const int kc = c0 + 8 * fq + 4 * hh + j; const bool ok = (kc >= cs) && (kc < cs + 16); const int bi = min(max(kc - c + 15, 0), 30);
#pragma unroll
            for (int i = 0; i < 8; ++i) { float s = S[i][hh][j]; s = ok ? s + brow0[i * 31 + bi] : -1e30f; S[i][hh][j] = s; mx = fmaxf(mx, s); } }
    mx = fmaxf(mx, __shfl_xor(mx, 16)); mx = fmaxf(mx, __shfl_xor(mx, 32));
    float l = 0.f; v4u pw[8];
#pragma unroll
    for (int i = 0; i < 8; ++i) {
#pragma unroll
        for (int hh = 0; hh < 2; ++hh)
#pragma unroll
            for (int j = 0; j < 4; ++j) { const float p = __builtin_amdgcn_exp2f((S[i][hh][j] - mx) * 1.4426950408889634f); S[i][hh][j] = p; l += p; }
        pw[i].x = pg8::cvt_pk_bf16(S[i][0][0], S[i][0][1]); pw[i].y = pg8::cvt_pk_bf16(S[i][0][2], S[i][0][3]); pw[i].z = pg8::cvt_pk_bf16(S[i][1][0], S[i][1][1]); pw[i].w = pg8::cvt_pk_bf16(S[i][1][2], S[i][1][3]); }
    l += __shfl_xor(l, 16); l += __shfl_xor(l, 32);
    const int q_ = (lane & 15) >> 2, p_ = lane & 3;
    unsigned vro[2], vrf[2];
#pragma unroll
    for (int h2 = 0; h2 < 2; ++h2) { const int key = c0 + 8 * fq + 4 * h2 + q_; vro[h2] = (unsigned)(256 * key + 8 * (p_ & 1)); vrf[h2] = (unsigned)(((key & 3) << 2) | ((key >> 2) & 3)); }
    f32x4 O[8];
#pragma unroll
    for (int dt = 0; dt < 8; ++dt) O[dt] = (f32x4){0.f, 0.f, 0.f, 0.f};
#pragma unroll
    for (int it = 9; it < 18; ++it) {
        unsigned rb_ = (unsigned)((it % NR) * 16384); asm volatile("" : "+s"(rb_));
        LAS unsigned char* buf = lds + rb_; const unsigned bufa = (unsigned)(uintptr_t)buf;
        wait_vmcnt_n(NC_NWAIT(it)); __builtin_amdgcn_s_barrier(); asm volatile("" ::: "memory");
        if (it + NR - 1 < 18) { NC_ISSUE(it + NR - 1); }
        if (it - 9 - OFF >= 0 && it - 9 - OFF < 8) {
            const bf16x8s pf = __builtin_bit_cast(bf16x8s, pw[it - 9 - OFF]);
            s16x4 lo[8], hi[8];
#pragma unroll
            for (int dt = 0; dt < 8; ++dt) { lo[dt] = tr_read16(bufa + vro[0] + 16u * ((unsigned)(2 * dt + (p_ >> 1)) ^ vrf[0])); hi[dt] = tr_read16(bufa + vro[1] + 16u * ((unsigned)(2 * dt + (p_ >> 1)) ^ vrf[1])); }
            asm volatile("s_waitcnt lgkmcnt(0)" ::: "memory"); __builtin_amdgcn_sched_barrier(0);
#pragma unroll
            for (int dt = 0; dt < 8; ++dt) { const bf16x8s vf = (bf16x8s){lo[dt][0], lo[dt][1], lo[dt][2], lo[dt][3], hi[dt][0], hi[dt][1], hi[dt][2], hi[dt][3]};
                O[dt] = __builtin_amdgcn_mfma_f32_16x16x32_bf16(vf, pf, O[dt], 0, 0, 0); } }
    }
#undef NC_ISSUE
#undef NC_NWAIT
    const float inv = 1.0f / l;
#pragma unroll
    for (int dt = 0; dt < 8; ++dt) { const f32x4 v = O[dt] * inv; v2u o; o.x = pg8::cvt_pk_bf16(v[0], v[1]); o.y = pg8::cvt_pk_bf16(v[2], v[3]); *(v2u*)(op + dt * 16) = o; }
}
__device__ __forceinline__ void na_coop_task(int t, const bf16* PROJ, const float* rpb, bf16* YA, LAS unsigned char* lds, int tid, int wave, int lane) {
    const int h = t / 192, rp = t % 192, R0 = 2 * rp, q = wave >> 2, g = wave & 3, R = R0 + q;
    int r0, rows, seq0; if (R0 < 256) { seq0 = (R0 >> 5) * 2048; r0 = R0 & 31; rows = 32; } else { seq0 = MP; r0 = R0 - 256; rows = 128; }
    const int fr = lane & 15, fq = lane >> 4;
    const int rstA = min(max(r0 - 4, 0), rows - 8), rstB = min(max(r0 + 1 - 4, 0), rows - 8), d = rstB - rstA, nU = 8 + d;
    const int r = r0 + q, rst = q ? rstB : rstA, off = q ? d : 0;
    const int c0 = min(max(16 * g - 8, 0), 32), c = 16 * g + fr, cs = min(max(c - 8, 0), 48);
    const size_t m = (size_t)R * 64 + c;
    const bf16* qp = PROJ + ((size_t)h * MTOK + m) * 128 + 8 * fq;
    const bf16* kg = PROJ + ((size_t)(16 + h) * MTOK + seq0 + rstA * 64) * 128;
    const bf16* vg = PROJ + ((size_t)(32 + h) * MTOK + seq0 + rstA * 64) * 128;
    LAS float* btab = (LAS float*)(lds + NA_BIAS_OFF);
    if (tid < 465) btab[tid] = rpb[h * 465 + tid];
    asm volatile("s_waitcnt lgkmcnt(0)" ::: "memory");
    const LAS float* brow0 = btab + (rst - r + 7) * 31;
    bf16* op = YA + m * AW + h * 128 + 4 * fq;
    if (off) na_coop_body<1>(kg, vg, nU, qp, brow0, c, cs, c0, op, lds + RING_OFF, wave, lane);
    else     na_coop_body<0>(kg, vg, nU, qp, brow0, c, cs, c0, op, lds + RING_OFF, wave, lane);
}
__device__ __forceinline__ void xa_coop_task(int t, const bf16* XQ, const bf16* KVM, bf16* XO, LAS unsigned char* lds, int tid, int wave, int lane) {
    const int h = t & 3, qb = t >> 2;
    const int s = (qb < 128) ? (qb >> 4) : 8;
    const int fr = lane & 15, fq = lane >> 4;
    const size_t m = (size_t)qb * 128 + wave * 16 + fr;
    const bf16* qp = XQ + m * XAW + h * 128 + 8 * fq;
    bf16x8s qf[4];
#pragma unroll
    for (int ks = 0; ks < 4; ++ks) qf[ks] = *(const bf16x8s*)(qp + 32 * ks);
    LAS unsigned char* kbuf = lds + RING_OFF; LAS unsigned char* vbuf = lds + RING_OFF + 65536;
    const bf16* kg = KVM + (size_t)(s * 256) * 1024 + h * 128;
    {
        v4u rg[8];
#pragma unroll
        for (int e = 0; e < 8; ++e) { const int cidx = tid + 512 * e, key = cidx >> 4, ch = cidx & 15; rg[e] = *(const v4u*)(kg + (size_t)key * 1024 + ch * 8); }
#pragma unroll
        for (int e = 0; e < 8; ++e) { const int cidx = tid + 512 * e, key = cidx >> 4, ch = cidx & 15, f = ((key & 3) << 2) | ((key >> 2) & 3); *(LAS v4u*)(kbuf + 256 * key + 16 * (ch ^ f)) = rg[e]; }
#pragma unroll
        for (int e = 0; e < 8; ++e) { const int cidx = tid + 512 * e, key = cidx >> 4, ch = cidx & 15; rg[e] = *(const v4u*)(kg + 512 + (size_t)key * 1024 + ch * 8); }
#pragma unroll
        for (int e = 0; e < 8; ++e) { const int cidx = tid + 512 * e, key = cidx >> 4, ch = cidx & 15, f = ((key & 3) << 2) | ((key >> 2) & 3); *(LAS v4u*)(vbuf + 256 * key + 16 * (ch ^ f)) = rg[e]; }
    }
    asm volatile("s_waitcnt lgkmcnt(0)" ::: "memory"); __builtin_amdgcn_s_barrier(); asm volatile("" ::: "memory");
    unsigned kro[2], krf[2];
#pragma unroll
    for (int hh = 0; hh < 2; ++hh) { const int key = 8 * (fr >> 2) + 4 * hh + (fr & 3); kro[hh] = (unsigned)(256 * key); krf[hh] = (unsigned)(((key & 3) << 2) | ((key >> 2) & 3)); }
    f32x4 S[8][2];
#pragma unroll
    for (int i = 0; i < 8; ++i) { unsigned ib = (unsigned)(i * 8192); asm volatile("" : "+s"(ib));
#pragma unroll
        for (int hh = 0; hh < 2; ++hh) { f32x4 a_ = {0.f, 0.f, 0.f, 0.f};
#pragma unroll
            for (int ks = 0; ks < 4; ++ks) { const bf16x8s kf = *(const LAS bf16x8s*)(kbuf + ib + kro[hh] + 16u * ((unsigned)(4 * ks + fq) ^ krf[hh]));
                a_ = __builtin_amdgcn_mfma_f32_16x16x32_bf16(kf, qf[ks], a_, 0, 0, 0); }
            S[i][hh] = a_; } }
    float mx = -1e30f;
#pragma unroll
    for (int i = 0; i < 8; ++i)
#pragma unroll
        for (int hh = 0; hh < 2; ++hh)
#pragma unroll
            for (int j = 0; j < 4; ++j) mx = fmaxf(mx, S[i][hh][j]);
    mx = fmaxf(mx, __shfl_xor(mx, 16)); mx = fmaxf(mx, __shfl_xor(mx, 32));
    float l = 0.f; v4u pw[8];
#pragma unroll
    for (int i = 0; i < 8; ++i) {
#pragma unroll
        for (int hh = 0; hh < 2; ++hh)
#pragma unroll
            for (int j = 0; j < 4; ++j) { const float p = __builtin_amdgcn_exp2f((S[i][hh][j] - mx) * 1.4426950408889634f); S[i][hh][j] = p; l += p; }
        pw[i].x = pg8::cvt_pk_bf16(S[i][0][0], S[i][0][1]); pw[i].y = pg8::cvt_pk_bf16(S[i][0][2], S[i][0][3]); pw[i].z = pg8::cvt_pk_bf16(S[i][1][0], S[i][1][1]); pw[i].w = pg8::cvt_pk_bf16(S[i][1][2], S[i][1][3]); }
    l += __shfl_xor(l, 16); l += __shfl_xor(l, 32);
    const int q_ = (lane & 15) >> 2, p_ = lane & 3;
    const unsigned vba = (unsigned)(uintptr_t)vbuf;
    unsigned vro[2], vrf[2];
#pragma unroll
    for (int h2 = 0; h2 < 2; ++h2) { const int key = 8 * fq + 4 * h2 + q_; vro[h2] = (unsigned)(256 * key + 8 * (p_ & 1)); vrf[h2] = (unsigned)(((key & 3) << 2) | ((key >> 2) & 3)); }
    f32x4 O[8];
#pragma unroll
    for (int dt = 0; dt < 8; ++dt) O[dt] = (f32x4){0.f, 0.f, 0.f, 0.f};
#pragma unroll
    for (int i = 0; i < 8; ++i) { unsigned ib = (unsigned)(i * 8192); asm volatile("" : "+s"(ib));
        const bf16x8s pf = __builtin_bit_cast(bf16x8s, pw[i]);
        s16x4 lo[8], hi[8];
#pragma unroll
        for (int dt = 0; dt < 8; ++dt) { lo[dt] = tr_read16(vba + ib + vro[0] + 16u * ((unsigned)(2 * dt + (p_ >> 1)) ^ vrf[0])); hi[dt] = tr_read16(vba + ib + vro[1] + 16u * ((unsigned)(2 * dt + (p_ >> 1)) ^ vrf[1])); }
        asm volatile("s_waitcnt lgkmcnt(0)" ::: "memory"); __builtin_amdgcn_sched_barrier(0);
#pragma unroll
        for (int dt = 0; dt < 8; ++dt) { const bf16x8s vf = (bf16x8s){lo[dt][0], lo[dt][1], lo[dt][2], lo[dt][3], hi[dt][0], hi[dt][1], hi[dt][2], hi[dt][3]};
            O[dt] = __builtin_amdgcn_mfma_f32_16x16x32_bf16(vf, pf, O[dt], 0, 0, 0); } }
    const float inv = 1.0f / l;
#pragma unroll
    for (int dt = 0; dt < 8; ++dt) { const f32x4 v = O[dt] * inv; v2u o; o.x = pg8::cvt_pk_bf16(v[0], v[1]); o.y = pg8::cvt_pk_bf16(v[2], v[3]);
        *(v2u*)((char*)XO + pg8::blk_off((int)m, h * 128 + 4 * fq + dt * 16, 8)) = o; }
}
__device__ __forceinline__ void xa_wave_task(int wt, const bf16* XQ, const bf16* KVM, bf16* XO, LAS unsigned char* lds, int wave, int lane) {
    const int qg = wt >> 2, h = wt & 3;
    const int fr = lane & 15, fq = lane >> 4;
    const size_t m = (size_t)qg * 16 + fr;
    const int s = (qg < 1024) ? (qg >> 7) : 8;
    const bf16* qp = XQ + m * XAW + h * 128 + 8 * fq;
    const bf16* kbase = KVM + (size_t)(s * 256 + 8 * (fr >> 2) + (fr & 3)) * 1024 + h * 128 + 8 * fq;
    const bf16* vbase = KVM + (size_t)(s * 256 + (lane >> 4)) * 1024 + 512 + h * 128 + (lane & 15) * 8;
    attn_task<false>(qp, kbase, vbase, (size_t)1024, 32, nullptr, 0, 0, 0, XO, (int)m, h * 128 + 4 * fq, lds + RING_OFF + wave * 8192, lane);
}

template <int DIR, int PC>
__device__ __forceinline__ void lru_unit(int s, int n, int tbeg, int ntile, const bf16* PROJ, const bf16* WG, const float* conv_w, const float* conv_b, const float* ba, const float* bx, const float* lam,
                                         bf16* Hout, bf16* Pout, LAS unsigned char* lds, int tid, int wave, int lane) {
    constexpr int RS = 272;
    const int seq0 = s < 8 ? s * 2048 : MP, T = s < 8 ? 2048 : 8192;
    const int fr = lane & 15, fq = lane >> 4;
    bf16x8s wf[2][4];
    { const bf16* wp = WG + ((size_t)(n * 2 + DIR) * 256 + 16 * wave + fr) * 128 + 8 * fq;
#pragma unroll
      for (int gi = 0; gi < 2; ++gi)
#pragma unroll
          for (int ks = 0; ks < 4; ++ks) wf[gi][ks] = *(const bf16x8s*)(wp + gi * 128 * 128 + 32 * ks); }
    const int chw = n * 128 + 16 * wave + fr;
    const float bra = -1.4426950408889634f * ba[DIR * 2048 + chw], bxi = -1.4426950408889634f * bx[DIR * 2048 + chw], sp8 = -8.0f * 1.4426950408889634f * log1pf(expf(-lam[DIR * 2048 + chw]));
    const int cp = lane, tg = wave, chc = n * 128 + 2 * cp;
    const float cw00 = conv_w[chc], cw01 = conv_w[chc + 1], cw10 = conv_w[2048 + chc], cw11 = conv_w[2048 + chc + 1], cw20 = conv_w[4096 + chc], cw21 = conv_w[4096 + chc + 1],
                cw30 = conv_w[6144 + chc], cw31 = conv_w[6144 + chc + 1], cb0 = conv_b[chc], cb1 = conv_b[chc + 1];
    const bf16* ub = PROJ + (size_t)seq0 * 4096 + chc;
    unsigned ur[11];
    { const int t0 = (tbeg + (DIR ? ntile - 1 : 0)) * 64 + 8 * tg - 1;
#pragma unroll
      for (int k = 0; k < 11; ++k) { const int t = t0 + k; ur[k] = (t >= 0 && t < T) ? *(const unsigned*)(ub + (size_t)t * 4096) : 0u; } }
    float carry = 0.f, pcar = 1.0f;
    for (int ti = 0; ti < ntile; ++ti) {
        const int tb = (tbeg + (DIR ? ntile - 1 - ti : ti)) * 64;
        LAS unsigned char* xt = lds + (ti & 1) * (64 * RS);
#pragma unroll
        for (int tt = 0; tt < 8; ++tt) {
            const float x0 = cw00 * bflo(ur[tt]) + cw10 * bflo(ur[tt + 1]) + cw20 * bflo(ur[tt + 2]) + cw30 * bflo(ur[tt + 3]) + cb0;
            const float x1 = cw01 * bfhi(ur[tt]) + cw11 * bfhi(ur[tt + 1]) + cw21 * bfhi(ur[tt + 2]) + cw31 * bfhi(ur[tt + 3]) + cb1;
            *(LAS unsigned*)(xt + (8 * tg + tt) * RS + 4 * cp) = pg8::cvt_pk_bf16(x0, x1); }
        if (ti + 1 < ntile) { const int t0 = (tbeg + (DIR ? ntile - 2 - ti : ti + 1)) * 64 + 8 * tg - 1;
#pragma unroll
            for (int k = 0; k < 11; ++k) { const int t = t0 + k; ur[k] = (t >= 0 && t < T) ? *(const unsigned*)(ub + (size_t)t * 4096) : 0u; } }
        asm volatile("s_waitcnt lgkmcnt(0)" ::: "memory"); __builtin_amdgcn_s_barrier(); asm volatile("" ::: "memory");
        f32x4 accr[4], acci[4];
#pragma unroll
        for (int m = 0; m < 4; ++m) { accr[m] = (f32x4){0.f, 0.f, 0.f, 0.f}; acci[m] = (f32x4){0.f, 0.f, 0.f, 0.f};
#pragma unroll
            for (int ks = 0; ks < 4; ++ks) { const bf16x8s af = *(const LAS bf16x8s*)(xt + (16 * m + fr) * RS + (32 * ks + 8 * fq) * 2);
                accr[m] = __builtin_amdgcn_mfma_f32_16x16x32_bf16(af, wf[0][ks], accr[m], 0, 0, 0);
                acci[m] = __builtin_amdgcn_mfma_f32_16x16x32_bf16(af, wf[1][ks], acci[m], 0, 0, 0); } }
        float av[4][4], bv[4][4];
#pragma unroll
        for (int m = 0; m < 4; ++m)
#pragma unroll
            for (int j = 0; j < 4; ++j) { const float xc = bf2f(*(const LAS bf16*)(xt + (16 * m + 4 * fq + j) * RS + (16 * wave + fr) * 2));
                const float rg = __builtin_amdgcn_rcpf(1.0f + __builtin_amdgcn_exp2f(fmaf(accr[m][j], -1.4426950408889634f, bra)));
                const float ig = __builtin_amdgcn_rcpf(1.0f + __builtin_amdgcn_exp2f(fmaf(acci[m][j], -1.4426950408889634f, bxi)));
                const float a = __builtin_amdgcn_exp2f(rg * sp8); av[m][j] = a; bv[m][j] = __builtin_amdgcn_sqrtf(fmaxf(1.0f - a * a, 0.f)) * ig * xc; }
        float Ai[4], Bi[4], Ae[4], Be[4], At[4], Bt[4];
#pragma unroll
        for (int m = 0; m < 4; ++m) {
            float A, B;
            if (DIR == 0) { A = av[m][0]; B = bv[m][0];
#pragma unroll
                for (int j = 1; j < 4; ++j) { B = B * av[m][j] + bv[m][j]; A *= av[m][j]; } }
            else { A = av[m][3]; B = bv[m][3];
#pragma unroll
                for (int j = 2; j >= 0; --j) { B = B * av[m][j] + bv[m][j]; A *= av[m][j]; } }
            Ai[m] = A; Bi[m] = B; }
        { float A1[4], B1[4];
#pragma unroll
          for (int m = 0; m < 4; ++m) { A1[m] = DIR ? __shfl_down(Ai[m], 16) : __shfl_up(Ai[m], 16); B1[m] = DIR ? __shfl_down(Bi[m], 16) : __shfl_up(Bi[m], 16); }
          const bool has = DIR ? (fq < 3) : (fq > 0);
#pragma unroll
          for (int m = 0; m < 4; ++m) if (has) { Bi[m] = Ai[m] * B1[m] + Bi[m]; Ai[m] = A1[m] * Ai[m]; } }
        { float A2[4], B2[4];
#pragma unroll
          for (int m = 0; m < 4; ++m) { A2[m] = DIR ? __shfl_down(Ai[m], 32) : __shfl_up(Ai[m], 32); B2[m] = DIR ? __shfl_down(Bi[m], 32) : __shfl_up(Bi[m], 32); }
          const bool has = DIR ? (fq < 2) : (fq > 1);
#pragma unroll
          for (int m = 0; m < 4; ++m) if (has) { Bi[m] = Ai[m] * B2[m] + Bi[m]; Ai[m] = A2[m] * Ai[m]; } }
#pragma unroll
        for (int m = 0; m < 4; ++m) {
            Ae[m] = DIR ? __shfl_down(Ai[m], 16) : __shfl_up(Ai[m], 16); Be[m] = DIR ? __shfl_down(Bi[m], 16) : __shfl_up(Bi[m], 16);
            At[m] = __shfl(Ai[m], (DIR ? 0 : 48) + fr); Bt[m] = __shfl(Bi[m], (DIR ? 0 : 48) + fr); }
        bf16* hp = Hout + (size_t)(seq0 + tb) * LW + chw; bf16* pp = Pout + (size_t)tb * LW + chw;
#pragma unroll
        for (int mm = 0; mm < 4; ++mm) { const int m = DIR ? 3 - mm : mm;
            const bool first = DIR ? (fq == 3) : (fq == 0);
            float h = first ? carry : Ae[m] * carry + Be[m]; float pv = first ? pcar : Ae[m] * pcar;
            if (DIR == 0) {
#pragma unroll
                for (int j = 0; j < 4; ++j) { h = av[m][j] * h + bv[m][j]; hp[(size_t)(16 * m + 4 * fq + j) * LW] = (bf16)pg8::cvt_pk_bf16(h, h);
                    if (PC) { pv *= av[m][j]; pp[(size_t)(16 * m + 4 * fq + j) * LW] = (bf16)pg8::cvt_pk_bf16(pv, pv); } } }
            else {
#pragma unroll
                for (int j = 3; j >= 0; --j) { h = av[m][j] * h + bv[m][j]; hp[(size_t)(16 * m + 4 * fq + j) * LW] = (bf16)pg8::cvt_pk_bf16(h, h);
                    if (PC) { pv *= av[m][j]; pp[(size_t)(16 * m + 4 * fq + j) * LW] = (bf16)pg8::cvt_pk_bf16(pv, pv); } } }
            carry = At[m] * carry + Bt[m]; if (PC) pcar *= At[m]; }
    }
    __syncthreads();
}
__device__ __forceinline__ void lru_dispatch(int u, const bf16* PROJ, const bf16* WG, const float* const* in, bf16* HF, bf16* HBk, bf16* PCA, LAS unsigned char* lds, int tid, int wave, int lane) {
    if (u < 64) { const int n = (u >> 2) & 15, e = (u >> 1) & 1, half = u & 1;
        if (e == 0) { if (half == 0) lru_unit<0, 0>(8, n, 0, 64, PROJ, WG, in[11], in[12], in[14], in[16], in[17], HF, PCA, lds, tid, wave, lane);
                      else           lru_unit<0, 1>(8, n, 64, 64, PROJ, WG, in[11], in[12], in[14], in[16], in[17], HF, PCA, lds, tid, wave, lane); }
        else        { if (half == 0) lru_unit<1, 0>(8, n, 64, 64, PROJ, WG, in[11], in[12], in[14], in[16], in[17], HBk, PCA, lds, tid, wave, lane);
                      else           lru_unit<1, 1>(8, n, 0, 64, PROJ, WG, in[11], in[12], in[14], in[16], in[17], HBk, PCA, lds, tid, wave, lane); } }
    else { const int v = u - 64, s = v >> 5, n = (v >> 1) & 15, e = v & 1;
        if (e == 0) lru_unit<0, 0>(s, n, 0, 32, PROJ, WG, in[11], in[12], in[14], in[16], in[17], HF, PCA, lds, tid, wave, lane);
        else        lru_unit<1, 0>(s, n, 0, 32, PROJ, WG, in[11], in[12], in[14], in[16], in[17], HBk, PCA, lds, tid, wave, lane); }
}

#define XB_TMO      128
#define XB_XCNT(j)  (256  + 64 * (j))
#define XB_XSUB(j)  (1280 + 64 * (j))
#define XB_XGEN(j)  (2304 + 64 * (j))
#define XB_TOP      3328
#define XB_TOPGEN   3392
#define XCD_BAR_WORDS 3456
#define XB_SPIN_CAP (1u << 18)

__device__ __forceinline__ unsigned xb_ld(unsigned* p)              { return __hip_atomic_load(p, __ATOMIC_RELAXED, __HIP_MEMORY_SCOPE_AGENT); }
__device__ __forceinline__ unsigned xb_add(unsigned* p, unsigned v) { return __hip_atomic_fetch_add(p, v, __ATOMIC_RELAXED, __HIP_MEMORY_SCOPE_AGENT); }
__device__ __forceinline__ unsigned xb_xcc_id() { return (unsigned)__builtin_amdgcn_s_getreg((3 << 11) | 20) & 0xFu; }
#define XB_SPIN(cond, bar) do { unsigned _sp = 0; while (cond) { __builtin_amdgcn_s_sleep(1); \
    if ((++_sp & 255u) == 0u) { if (xb_ld(&(bar)[XB_TMO])) break; if (_sp > XB_SPIN_CAP) { atomicAdd(&(bar)[XB_TMO], 1u); break; } } } } while (0)

struct XcdBarrier {
    unsigned* bar; unsigned x;
    volatile LAS unsigned* st;
};

__device__ __forceinline__ XcdBarrier xcd_barrier_post(unsigned* bar, volatile LAS unsigned* st) {
    XcdBarrier b; b.bar = bar; b.x = xb_xcc_id(); b.st = st;
    if (threadIdx.x == 0) (void)xb_add(&bar[XB_XCNT(b.x)], 1u);
    return b;
}
__device__ __forceinline__ void xcd_barrier_complete(unsigned* bar, unsigned x, unsigned& nloc, unsigned& nx) {
    const unsigned G = gridDim.x * gridDim.y * gridDim.z;
    unsigned sum, cnt, mine, sp = 0u;
    for (;;) {
        sum = 0u; cnt = 0u; mine = 0u;
#pragma unroll
        for (unsigned j = 0; j < 16; ++j) { const unsigned c = xb_ld(&bar[XB_XCNT(j)]); sum += c; cnt += (c > 0u) ? 1u : 0u; mine = (j == x) ? c : mine; }
        if (sum == G) break;
        __builtin_amdgcn_s_sleep(1);
        if ((++sp & 255u) == 0u) { if (xb_ld(&bar[XB_TMO])) break; if (sp > XB_SPIN_CAP) { atomicAdd(&bar[XB_TMO], 1u); break; } }
    }
    nloc = mine > 0u ? mine : 1u; nx = cnt > 0u ? cnt : 1u;
}

__device__ __forceinline__ void xcd_barrier(const XcdBarrier& b, bool wave0 = true) {
    asm volatile("s_waitcnt vmcnt(0)" ::: "memory");
    __syncthreads();
    unsigned bl_; asm volatile("v_mbcnt_lo_u32_b32 %0, -1, 0\n\tv_mbcnt_hi_u32_b32 %0, -1, %0" : "=&v"(bl_));
    if (wave0 && bl_ == 0u) {
        unsigned* bar = b.bar;
        __builtin_amdgcn_s_waitcnt(0);
        unsigned nloc = b.st[0], nx = b.st[1];
        if (nloc == 0u) { xcd_barrier_complete(bar, b.x, nloc, nx); b.st[0] = nloc; b.st[1] = nx; }
        const unsigned old = xb_add(&bar[XB_XSUB(b.x)], 1u);
        const unsigned gen = old / nloc;
        if (old + 1u == (gen + 1u) * nloc) {
            __builtin_amdgcn_fence(__ATOMIC_RELEASE, "agent");
            asm volatile("s_waitcnt vmcnt(0)" ::: "memory");
            const unsigned og = xb_add(&bar[XB_TOP], 1u);
            const unsigned tg = og / nx;
            if (og + 1u == (tg + 1u) * nx) xb_add(&bar[XB_TOPGEN], 1u);
            else XB_SPIN(xb_ld(&bar[XB_TOPGEN]) == tg, bar);
            __builtin_amdgcn_fence(__ATOMIC_ACQUIRE, "agent");
            xb_add(&bar[XB_XGEN(b.x)], 1u);
            asm volatile("s_waitcnt vmcnt(0)" ::: "memory");
        } else {
            XB_SPIN(xb_ld(&bar[XB_XGEN(b.x)]) == gen, bar);
            __builtin_amdgcn_fence(__ATOMIC_ACQUIRE, "agent");
            asm volatile("s_waitcnt vmcnt(0)" ::: "memory");
        }
    }
    __syncthreads();
}


constexpr int CI_UP = 2 * (D / 64) * (DFF / 32), CI_DN = (DFF / 64) * (D / 32), CI_IN = (D / 64) * (NIN / 32), CI_OUT = (D / 64) * (D / 32), CI_Q = (D / 64) * (XAW / 32), CI_O = (XAW / 64) * (D / 32), CI_G = 512;
constexpr int CI_TOTAL = CI_DN + CI_IN + CI_OUT + 3 * CI_Q + CI_O + CI_G + CI_UP + CI_DN;
constexpr int CI_P1 = CI_TOTAL - CI_DN, CI_P10 = CI_TOTAL;
constexpr int CONV_CHUNK = 128;
__device__ __forceinline__ void deferred_item(int g, const float* const* in, unsigned char* ws, LAS float* scr, int lane) {
    const float* W; int K, N, row_off = 0, up = 0; bf16* WT; const float* gk = nullptr;
    if (g < CI_DN) { W = in[7]; K = DFF; N = D; WT = (bf16*)(ws + WS_WDN1); }
    else if ((g -= CI_DN) < CI_OUT) { W = in[20]; K = D; N = D; WT = (bf16*)(ws + WS_WOUT); }
    else if ((g -= CI_OUT) < CI_IN) { W = in[9]; K = D; N = NIN; WT = (bf16*)(ws + WS_WIN); gk = in[8]; }
    else if ((g -= CI_IN) < CI_Q) { W = in[23]; K = D; N = XAW; WT = (bf16*)(ws + WS_WQ); gk = in[21]; }
    else if ((g -= CI_Q) < CI_Q) { W = in[24]; K = D; N = XAW; WT = (bf16*)(ws + WS_WKV); }
    else if ((g -= CI_Q) < CI_Q) { W = in[25]; K = D; N = XAW; WT = (bf16*)(ws + WS_WKV); row_off = XAW; }
    else if ((g -= CI_Q) < CI_O) { W = in[26]; K = XAW; N = D; WT = (bf16*)(ws + WS_WO); }
    else if ((g -= CI_O) < CI_G) { const int mat = g >> 3, sub = g & 7, gi = mat & 1, e = (mat >> 1) & 1, nn = mat >> 2;
        const float* Wsrc = (gi ? in[15] : in[13]) + ((size_t)(e * 16 + nn) << 14); const int k0 = (sub >> 2) * 64, n0 = (sub & 3) * 32;
        transpose_item(Wsrc, 128, 128, (bf16*)(ws + WS_WG) + ((size_t)(nn * 2 + e) * 256 + gi * 128 + n0) * 128, k0, n0, scr, lane); return; }
    else if ((g -= CI_G) < CI_UP) { const int which = g >= CI_UP / 2; if (which) g -= CI_UP / 2;
        const int nblk = DFF / 32, kb = g / nblk, nb = g % nblk, n0 = 32 * nb, k0 = 64 * kb, drow = 256 * (n0 >> 7) + (n0 & 127) + (which ? 128 : 0);
        transpose_item_f8(which ? in[29] : in[28], D, DFF, (char*)(ws + WS_WUP2) + ((size_t)((drow >> 8) * (D / 128) + (k0 >> 7)) << 15), k0, n0, drow & 255, true, 128.0f, in[27], scr, lane); return; }
    else { g -= CI_UP; W = in[30]; K = DFF; N = D; WT = (bf16*)(ws + WS_WDN2);
        const int nblk_ = D / 32, kb_ = g / nblk_, nb_ = g % nblk_, n0_ = 32 * nb_, k0_ = 64 * kb_;
        if (k0_ >= DN8_PN * 128) {
            transpose_item_f8(W, DFF, D, (char*)(ws + WS_WUP1) + ((size_t)((n0_ >> 8) * DN8_KT + ((k0_ - DN8_PN * 128) >> 7)) << 15), k0_, n0_, n0_ & 255, true, 128.0f, nullptr, scr, lane); return; } }
    const int nblk = N / 32, nkt = K / 64, kb = g / nblk, nb = g % nblk, n0 = 32 * nb;
    const int drow = up ? 256 * (n0 >> 7) + (n0 & 127) + (up == 2 ? 128 : 0) : row_off + n0;
    transpose_item_blk(W, K, N, (char*)WT + ((size_t)((drow >> 8) * nkt + kb) << 15), 64 * kb, n0, drow & 255, true, gk, scr, lane);
}
__device__ __forceinline__ void phase_prologue(const float* const* in, unsigned char* ws, LAS unsigned char* lds, pg8::ssq_t* ss0, int lane, int wave, int gw, int NGW) {
    bf16* W_G = (bf16*)(ws + WS_WG); bf16* W_Q = (bf16*)(ws + WS_WQ); bf16* W_KV = (bf16*)(ws + WS_WKV); bf16* W_O = (bf16*)(ws + WS_WO); bf16* MEMN = (bf16*)(ws + WS_MEMN);
    bf16* W_OUT = (bf16*)(ws + WS_WOUT); bf16* W_IN = (bf16*)(ws + WS_WIN); bf16* W_UP1 = (bf16*)(ws + WS_WUP1); bf16* W_DN1 = (bf16*)(ws + WS_WDN1);
    bf16* W_UP2 = (bf16*)(ws + WS_WUP2); bf16* W_DN2 = (bf16*)(ws + WS_WDN2); bf16* XN = (bf16*)(ws + WS_XN);
            for (int m = gw; m < MTOK; m += NGW) {
            const float* xr = (m < MP) ? in[0] + (size_t)m * D : in[1] + (size_t)(m - MP) * D;
            float s = 0.f;
#pragma unroll 4
            for (int j = 0; j < 16; ++j) { const f32x4 v = *(const f32x4*)(xr + (j * 64 + lane) * 4);
                s += (v[0] * v[0] + v[1] * v[1]) + (v[2] * v[2] + v[3] * v[3]);
                v2u o; o.x = pk2(v[0], v[1]); o.y = pk2(v[2], v[3]); *(v2u*)((char*)XN + pg8::blk_off(m, (j * 64 + lane) * 4, 64)) = o; }
            s = wave_sum(s); if (lane == 0) ss0[m] = pg8::ss_fix(s);
        }
        const float* gm = in[22];
        for (int m = gw; m < NMEM; m += NGW) {
            const float* xr = (m < 2048) ? in[2] + (size_t)m * D : in[3] + (size_t)(m - 2048) * D;
            f32x4 v[16]; float s = 0.f;
#pragma unroll
            for (int j = 0; j < 16; ++j) { v[j] = *(const f32x4*)(xr + (j * 64 + lane) * 4); s += (v[j][0] * v[j][0] + v[j][1] * v[j][1]) + (v[j][2] * v[j][2] + v[j][3] * v[j][3]); }
            s = wave_sum(s); const float rs = rsqrtf(s * (1.0f / D) + EPS);
#pragma unroll
            for (int j = 0; j < 16; ++j) { const f32x4 g = *(const f32x4*)(gm + (j * 64 + lane) * 4);
                v2u o; o.x = pk2(v[j][0] * rs * g[0], v[j][1] * rs * g[1]); o.y = pk2(v[j][2] * rs * g[2], v[j][3] * rs * g[3]); *(v2u*)((char*)MEMN + pg8::blk_off(m, (j * 64 + lane) * 4, 64)) = o; }
        }
        LAS float* scr = (LAS float*)(lds + RING_OFF + wave * 16384);
        transpose_up(in[5], in[6], W_UP1, in[4], scr, lane, gw, NGW);
        for (int g = CI_P10 + gw; g < CI_TOTAL; g += NGW) deferred_item(g, in, ws, scr, lane);
}
__device__ __forceinline__ void phase_mixer(const float* const* in, const bf16* PROJ, const bf16* UG, const bf16* W_G, bf16* HF, bf16* HBK, bf16* PCA, bf16* YA, unsigned* ctr, volatile LAS unsigned* MISC, LAS unsigned char* lds, int G, int bx, int tid, int wave, int lane, int mode = 3) {
        if (mode & 1) {
        for (int u = bx; u < 320; u += (u < 256 ? (bx >= 64 && bx < 128 ? 256 - 64 : 1024) : 1024)) lru_dispatch(u, UG, W_G, in, HF, HBK, PCA, lds, tid, wave, lane);
        }
        if (mode & 6)
        for (;;) {
            __syncthreads();
            if (tid == 0) MISC[0] = atomicAdd(ctr, 1u);
            __syncthreads();
            const int it = __builtin_amdgcn_readfirstlane((int)MISC[0]);
            if (it >= 3072) break;
            na_coop_task(it, PROJ, in[10], YA, lds, tid, wave, lane);
        }
}
__device__ __forceinline__ void phase_finalize(const float* const* in, const bf16* PROJ, const bf16* HF, const bf16* HBK, const bf16* PCA, const bf16* YA, bf16* Y, int lane, int gw, int NGW) {
        const float* ga = in[18]; const float* gl = in[19];
        for (int m = gw; m < MTOK; m += NGW) {
            float y[32]; float s = 0.f;
#pragma unroll
            for (int j = 0; j < 4; ++j) { const int c0 = (j * 64 + lane) * 8; float a[8], b[8], gt[8];
                unpack8(*(const v4u*)(HF + (size_t)m * LW + c0), a); unpack8(*(const v4u*)(HBK + (size_t)m * LW + c0), b); unpack8(*(const v4u*)(PROJ + (size_t)m * 4096 + 2048 + c0), gt);
                if (m >= MP) { const int t = m - MP; float pc[8], bd[8]; unpack8(*(const v4u*)(PCA + (size_t)t * LW + c0), pc);
                    if (t >= 4096) { unpack8(*(const v4u*)(HF + (size_t)(MP + 4095) * LW + c0), bd);
#pragma unroll
                        for (int k = 0; k < 8; ++k) a[k] += pc[k] * bd[k]; }
                    else { unpack8(*(const v4u*)(HBK + (size_t)(MP + 4096) * LW + c0), bd);
#pragma unroll
                        for (int k = 0; k < 8; ++k) b[k] += pc[k] * bd[k]; } }
#pragma unroll
                for (int k = 0; k < 8; ++k) { const float v = (a[k] + b[k]) * gelu_tanh(gt[k]); y[8 * j + k] = v; s += v * v; } }
            s = wave_sum(s); float rs = rsqrtf(s * (1.0f / LW) + EPS);
#pragma unroll
            for (int j = 0; j < 4; ++j) { const int c0 = (j * 64 + lane) * 8; const f32x4 g0 = *(const f32x4*)(gl + c0), g1 = *(const f32x4*)(gl + c0 + 4);
                v4u o; o.x = pk2(y[8 * j] * rs * g0[0], y[8 * j + 1] * rs * g0[1]); o.y = pk2(y[8 * j + 2] * rs * g0[2], y[8 * j + 3] * rs * g0[3]);
                o.z = pk2(y[8 * j + 4] * rs * g1[0], y[8 * j + 5] * rs * g1[1]); o.w = pk2(y[8 * j + 6] * rs * g1[2], y[8 * j + 7] * rs * g1[3]);
                *(v4u*)((char*)Y + pg8::blk_off(m, AW + c0, 64)) = o; }
            s = 0.f;
#pragma unroll
            for (int j = 0; j < 4; ++j) { const int c0 = (j * 64 + lane) * 8; float a[8]; unpack8(*(const v4u*)(YA + (size_t)m * AW + c0), a);
#pragma unroll
                for (int k = 0; k < 8; ++k) { y[8 * j + k] = a[k]; s += a[k] * a[k]; } }
            s = wave_sum(s); rs = rsqrtf(s * (1.0f / AW) + EPS);
#pragma unroll
            for (int j = 0; j < 4; ++j) { const int c0 = (j * 64 + lane) * 8; const f32x4 g0 = *(const f32x4*)(ga + c0), g1 = *(const f32x4*)(ga + c0 + 4);
                v4u o; o.x = pk2(y[8 * j] * rs * g0[0], y[8 * j + 1] * rs * g0[1]); o.y = pk2(y[8 * j + 2] * rs * g0[2], y[8 * j + 3] * rs * g0[3]);
                o.z = pk2(y[8 * j + 4] * rs * g1[0], y[8 * j + 5] * rs * g1[1]); o.w = pk2(y[8 * j + 6] * rs * g1[2], y[8 * j + 7] * rs * g1[3]);
                *(v4u*)((char*)Y + pg8::blk_off(m, c0, 64)) = o; }
        }
}
__device__ __forceinline__ void phase_xattn(const bf16* XQ, const bf16* KVM, bf16* XO, LAS unsigned char* lds, int wave, int lane, int gw, int NGW) {
        for (int t = blockIdx.x; t < (MTOK / 128) * 4; t += gridDim.x) { __syncthreads(); xa_coop_task(t, XQ, KVM, XO, lds, wave * 64 + lane, wave, lane); }
}

struct Args { const float* in[32]; float* out; unsigned char* ws; int ph_lo, ph_hi; };
static_assert(sizeof(Args) == 32 * 8 + 8 + 8 + 8, "Args has no padding");

__global__ void __launch_bounds__(NWAVES * 64, 2) mk_fwd(Args args) {
    extern __shared__ __attribute__((aligned(16))) unsigned char lds_raw[];
    LAS unsigned char* lds = (LAS unsigned char*)lds_raw;
    volatile LAS unsigned* MISC = (volatile LAS unsigned*)(lds + MISC_OFF);
    const int tid = threadIdx.x, lane = tid & 63, wave = __builtin_amdgcn_readfirstlane(tid >> 6);
    const int G = gridDim.x, bx = blockIdx.x;
    const int gw = bx * NWAVES + wave, NGW = G * NWAVES;
    unsigned char* ws = args.ws;
    unsigned* ctl = (unsigned*)(ws + WS_CTL);
    pg8::ssq_t* ss0 = (pg8::ssq_t*)(ctl + CW_SS); pg8::ssq_t* ss1 = ss0 + MTOK; pg8::ssq_t* ss2 = ss1 + MTOK; pg8::ssq_t* ss3 = ss2 + MTOK; pg8::ssq_t* ss4 = ss3 + MTOK;
    bf16* W_G = (bf16*)(ws + WS_WG); bf16* W_Q = (bf16*)(ws + WS_WQ); bf16* W_KV = (bf16*)(ws + WS_WKV); bf16* W_O = (bf16*)(ws + WS_WO); bf16* MEMN = (bf16*)(ws + WS_MEMN);
    bf16* W_OUT = (bf16*)(ws + WS_WOUT); bf16* W_IN = (bf16*)(ws + WS_WIN); bf16* W_UP1 = (bf16*)(ws + WS_WUP1); bf16* W_DN1 = (bf16*)(ws + WS_WDN1);
    bf16* W_UP2 = (bf16*)(ws + WS_WUP2); bf16* W_DN2 = (bf16*)(ws + WS_WDN2);
    bf16* XN = (bf16*)(ws + WS_XN); bf16* HBK = (bf16*)(ws + WS_HBK);
    bf16* PCA = (bf16*)args.out + (size_t)2 * MTOK * AW;
    bf16* YA = (bf16*)args.out; bf16* HF = (bf16*)args.out + (size_t)MTOK * AW;
    bf16* Y = (bf16*)(ws + WS_Y); bf16* HB = (bf16*)(ws + WS_HB); bf16* PROJ = (bf16*)(ws + WS_PROJ); bf16* UG = PROJ + (size_t)48 * MTOK * 128;
    bf16* XQ = (bf16*)(ws + WS_XQ); bf16* XO = (bf16*)(ws + WS_XO); bf16* KVM = (bf16*)(ws + WS_KVM);
    float* out = args.out;

    for (int i = tid; i < (LDS_BYTES - LDSCTL_OFF) / 4; i += NWAVES * 64) ((LAS unsigned*)(lds + LDSCTL_OFF))[i] = 0u;
    __syncthreads();
    if (tid == 0) { const unsigned long long xp_ = (unsigned long long)XN; MISC[20] = (unsigned)xp_; MISC[21] = (unsigned)(xp_ >> 32); }
    __syncthreads();
    const int lo = args.ph_lo, hi = args.ph_hi;
    XcdBarrier bar; bar.bar = ctl + CW_BAR; bar.x = 0; bar.st = nullptr;
    if (hi - lo > 1) bar = xcd_barrier_post(ctl + CW_BAR, MISC + 8);
#define IN(k) (lo <= (k) && (k) < hi)
#define LANE_NOW() ({ int l_; asm volatile("v_mbcnt_lo_u32_b32 %0, -1, 0\n\tv_mbcnt_hi_u32_b32 %0, -1, %0" : "=&v"(l_)); l_; })
#define SEAM(k) do { if (IN(k) && IN((k) + 1)) { xcd_barrier(bar, wave == 0); if (PROBE_MASK & 32768) xcd_barrier(bar, wave == 0); } } while (0)

    if (IN(0)) { phase_prologue(args.in, ws, lds, ss0, lane, wave, gw, NGW);
        if (PROBE_MASK & 1) { xcd_barrier(bar); phase_prologue(args.in, ws, lds, ss0, lane, wave, gw, NGW); } }
    SEAM(0);
    if (IN(1)) {
        pg8::Gemm g{XN, W_UP1, MTOK, NUP, D}; pg8::StaticOrder S; S.init(MTOK, NUP, G, bx);
        pg8::EpiSwiGLU E{HB, ss0, 1 << 30, 1.0f, nullptr};
        if (PROBE_MASK & 4096) { pg8::EpiTwice<pg8::EpiSwiGLU> ET{E}; pg8::gemm_phase<pg8::EpiTwice<pg8::EpiSwiGLU>, pg8::StaticOrder, PG8_ALIGN, PG8_SP2>(lds + RING_OFF, g, S, ET, wave); } else
        pg8::gemm_phase<pg8::EpiSwiGLU, pg8::StaticOrder, PG8_ALIGN, PG8_SP2>(lds + RING_OFF, g, S, E, wave);
        if (PROBE_MASK & 2) { xcd_barrier(bar); pg8::gemm_phase<pg8::EpiSwiGLU, pg8::StaticOrder, PG8_ALIGN, PG8_SP2>(lds + RING_OFF, g, S, E, wave); }
        const int lane = LANE_NOW(), tid = wave * 64 + lane;
        for (;;) {
            __syncthreads();
            if (tid == 0) MISC[0] = atomicAdd(ctl + CW_CONVCTR, 1u);
            __syncthreads();
            const int chunk = (int)MISC[0];
            if (chunk * CONV_CHUNK >= CI_P1) break;
            LAS float* scr = (LAS float*)(lds + RING_OFF + wave * 16384);
            for (int j = 0; j < CONV_CHUNK / NWAVES; ++j) { const int gi = chunk * CONV_CHUNK + wave * (CONV_CHUNK / NWAVES) + j; if (gi < CI_P1) deferred_item(gi, args.in, ws, scr, lane); }
        }
        if (PROBE_MASK & 65536) { xcd_barrier(bar);
            for (;;) {
                __syncthreads();
                if (tid == 0) MISC[0] = atomicAdd(ctl + CW_CONVCTR + 128, 1u);
                __syncthreads();
                const int chunk = (int)MISC[0];
                if (chunk * CONV_CHUNK >= CI_P1) break;
                LAS float* scr = (LAS float*)(lds + RING_OFF + wave * 16384);
                for (int j = 0; j < CONV_CHUNK / NWAVES; ++j) { const int gi = chunk * CONV_CHUNK + wave * (CONV_CHUNK / NWAVES) + j; if (gi < CI_P1) deferred_item(gi, args.in, ws, scr, lane); }
            } }
    }
    SEAM(1);
    if (IN(2)) {
        pg8::Gemm g{HB, W_DN1, MTOK, D, DFF}; pg8::StaticOrder S; S.init(MTOK, D, G, bx, WGM_DOWN, 1);
        pg8::EpiResid E{XN, ss1, nullptr, 0.5f};
        pg8::gemm_phase<pg8::EpiResid, pg8::StaticOrder, PG8_ALIGN, PG8_SP2>(lds + RING_OFF, g, S, E, wave);
        if (PROBE_MASK & 8192) { xcd_barrier(bar); pg8::Gemm gl{XN, W_UP1, MTOK, NUP, D}; pg8::StaticOrder Sl; Sl.init(MTOK, NUP, G, bx); pg8::EpiNull EN;
            pg8::gemm_phase<pg8::EpiNull, pg8::StaticOrder, PG8_ALIGN, PG8_SP2, PROBE_VAR>(lds + RING_OFF, gl, Sl, EN, wave); }
        if (PROBE_MASK & 4) { xcd_barrier(bar); pg8::EpiResid E2{XN, ss4 + MTOK, nullptr, 0.0f}; pg8::gemm_phase<pg8::EpiResid, pg8::StaticOrder, PG8_ALIGN, PG8_SP2>(lds + RING_OFF, g, S, E2, wave); }
    }
    SEAM(2);
    if (IN(3)) {
        pg8::Gemm g{XN, W_IN, MTOK, NIN, D}; pg8::StaticOrder S; S.init(MTOK, NIN, G, bx);
        pg8::EpiProj E{PROJ, UG, ss1, 0.08838834764831845f};
        pg8::gemm_phase<pg8::EpiProj, pg8::StaticOrder, PG8_ALIGN, PG8_SP2>(lds + RING_OFF, g, S, E, wave);
        if (PROBE_MASK & 8) { xcd_barrier(bar); pg8::gemm_phase<pg8::EpiProj, pg8::StaticOrder, PG8_ALIGN, PG8_SP2>(lds + RING_OFF, g, S, E, wave); }
    }
    SEAM(3);
    if (IN(4)) { const int lane = LANE_NOW(), tid = wave * 64 + lane; phase_mixer(args.in, PROJ, UG, W_G, HF, HBK, PCA, YA, ctl + CW_NACTR, MISC, lds, G, bx, tid, wave, lane);
        if (PROBE_MASK & 16) { xcd_barrier(bar); phase_mixer(args.in, PROJ, UG, W_G, HF, HBK, PCA, YA, ctl + CW_NACTR + 64, MISC, lds, G, bx, tid, wave, lane); }
        if (PROBE_MASK & 1024) { xcd_barrier(bar); phase_mixer(args.in, PROJ, UG, W_G, HF, HBK, PCA, YA, ctl + CW_NACTR + 64, MISC, lds, G, bx, tid, wave, lane, 1); }
        if (PROBE_MASK & 16384) { xcd_barrier(bar); phase_mixer(args.in, PROJ, UG, W_G, HF, HBK, PCA, YA, ctl + CW_NACTR + 64, MISC, lds, G, bx, tid, wave, lane, 4); }
        if (PROBE_MASK & 2048) { xcd_barrier(bar); phase_mixer(args.in, PROJ, UG, W_G, HF, HBK, PCA, YA, ctl + CW_NACTR + 64, MISC, lds, G, bx, tid, wave, lane, 2); } }
    SEAM(4);
    if (IN(5)) { const int lane = LANE_NOW(); phase_finalize(args.in, UG, HF, HBK, PCA, YA, Y, lane, gw, NGW);
        if (PROBE_MASK & 32) { xcd_barrier(bar); phase_finalize(args.in, UG, HF, HBK, PCA, YA, Y, lane, gw, NGW); } }
    SEAM(5);
    if (IN(6)) {
        pg8::Gemm g{Y, W_OUT, MTOK, D, D}; pg8::StaticOrder S; S.init(MTOK, D, G, bx);
        pg8::EpiResid E{XN, ss2, nullptr, 1.0f};
        pg8::gemm_phase<pg8::EpiResid, pg8::StaticOrder, PG8_ALIGN, PG8_SP2>(lds + RING_OFF, g, S, E, wave);
        if (PROBE_MASK & 64) { xcd_barrier(bar); pg8::EpiResid E2{XN, ss4 + MTOK, nullptr, 0.0f}; pg8::gemm_phase<pg8::EpiResid, pg8::StaticOrder, PG8_ALIGN, PG8_SP2>(lds + RING_OFF, g, S, E2, wave); }
    }
    SEAM(6);
    if (IN(7)) {
        if (bx < 192 || G < 228) {
            pg8::Gemm g{XN, W_Q, MTOK, XAW, D}; pg8::StaticOrder S; S.init(MTOK, XAW, G < 228 ? G : 192, bx);
            pg8::EpiScaleBf16 E{XQ, XAW, ss2, 0.08838834764831845f, XAW};
            pg8::gemm_phase<pg8::EpiScaleBf16, pg8::StaticOrder, PG8_ALIGN, PG8_SP2>(lds + RING_OFF, g, S, E, wave);
        }
        if ((bx >= 192 && bx < 228) || G < 228) {
            pg8::Gemm g{MEMN, W_KV, NMEM, 2 * XAW, D}; pg8::StaticOrder S; S.init(NMEM, 2 * XAW, G < 228 ? G : 36, G < 228 ? bx : bx - 192);
            pg8::EpiScaleBf16 E{KVM, 2 * XAW, nullptr, 1.0f, 0};
            pg8::gemm_phase<pg8::EpiScaleBf16, pg8::StaticOrder, PG8_ALIGN, PG8_SP2>(lds + RING_OFF, g, S, E, wave);
        }
    }
    SEAM(7);
    if (IN(8)) { const int lane = LANE_NOW(); phase_xattn(XQ, KVM, XO, lds, wave, lane, gw, NGW);
        if (PROBE_MASK & 256) { xcd_barrier(bar); phase_xattn(XQ, KVM, XO, lds, wave, lane, gw, NGW); } }
    SEAM(8);
    if (IN(9)) {
        pg8::Gemm g{XO, W_O, MTOK, D, XAW}; pg8::StaticOrder S; S.init(MTOK, D, G, bx);
        pg8::EpiResid E{XN, ss3, (char*)(ws + WS_Y), 1.0f};
        pg8::gemm_phase<pg8::EpiResid, pg8::StaticOrder, PG8_ALIGN, PG8_SP2>(lds + RING_OFF, g, S, E, wave);
        if (PROBE_MASK & 512) { xcd_barrier(bar); pg8::EpiResid E2{XN, ss4 + MTOK, nullptr, 0.0f}; pg8::gemm_phase<pg8::EpiResid, pg8::StaticOrder, PG8_ALIGN, PG8_SP2>(lds + RING_OFF, g, S, E2, wave); }
    }
    SEAM(9);
    if (IN(10)) {
        pg8::Gemm g{(const pg8::bf16_t*)(ws + WS_Y), W_UP2, MTOK, NUP, D}; pg8::StaticOrder S; S.init(MTOK, NUP, G, bx);
        pg8::EpiSwiGLU E{HB, ss3, DN8_PN, 1.0f / 128.0f, (char*)out};
        pg8::gemm_phase<pg8::EpiSwiGLU, pg8::StaticOrder, PG8_ALIGN, PG8_SP2, 0, true>(lds + RING_OFF, g, S, E, wave);
        const int lane = LANE_NOW(), tid = wave * 64 + lane;
        for (;;) {
            __syncthreads();
            if (tid == 0) MISC[0] = atomicAdd(ctl + CW_CONVCTR + 64, 1u);
            __syncthreads();
            const int chunk = (int)MISC[0];
            if (CI_P1 + chunk * CONV_CHUNK >= CI_P10) break;
            LAS float* scr = (LAS float*)(lds + RING_OFF + wave * 16384);
            for (int j = 0; j < CONV_CHUNK / NWAVES; ++j) { const int gi = CI_P1 + chunk * CONV_CHUNK + wave * (CONV_CHUNK / NWAVES) + j; if (gi < CI_P10) deferred_item(gi, args.in, ws, scr, lane); }
        }
    }
    SEAM(10);
    if (IN(11)) {
        pg8::StaticOrder S; S.init(MTOK, D, G, bx, 8, 1);
        pg8::Gemm2 g{HB, W_DN2, MTOK, D, DN8_PN * 128, DFF, (const pg8::bf16_t*)out, (const pg8::bf16_t*)(ws + WS_WUP1), DFF - DN8_PN * 128};
        pg8::EpiResid E{XN, ss4, nullptr, 0.5f};
        pg8::gemm_phase_tail8<pg8::EpiResid, pg8::StaticOrder>(lds + RING_OFF, g, S, E, wave);
    }
    SEAM(11);
    if (IN(12)) {
        const float* gf = args.in[31];
        int ln12; asm volatile("v_mbcnt_lo_u32_b32 %0, -1, 0\n\tv_mbcnt_hi_u32_b32 %0, -1, %0" : "=&v"(ln12));
        const int lane = ln12;
        const int gq = lane >> 3, rb = (lane >> 2) & 1, chk = lane & 3;
        for (int p = gw; p < MTOK / 2; p += NGW) {
            const int m = 2 * p + rb; const float rs = rsqrtf(pg8::ss_get(ss4 + m) * (1.0f / D) + EPS); float* orow = out + (size_t)m * D;
#pragma unroll 4
            for (int j = 0; j < 16; ++j) { const int c0 = (j * 8 + gq) * 32 + chk * 8; float a[8]; unpack8(*(const v4u*)((const char*)XN + pg8::blk_off(m, c0, 64)), a);
                const f32x4 g0 = *(const f32x4*)(gf + c0), g1 = *(const f32x4*)(gf + c0 + 4);
                *(f32x4*)(orow + c0) = (f32x4){a[0] * rs * g0[0], a[1] * rs * g0[1], a[2] * rs * g0[2], a[3] * rs * g0[3]};
                *(f32x4*)(orow + c0 + 4) = (f32x4){a[4] * rs * g1[0], a[5] * rs * g1[1], a[6] * rs * g1[2], a[7] * rs * g1[3]}; }
        }
    }
#undef IN
#undef LANE_NOW
#undef SEAM
}

extern "C" void kernel_launch(void* const* d_in, const int* in_sizes, int n_in, void* d_out, int out_size, void* d_ws, size_t ws_size, hipStream_t stream) {
    static int grid = 0;
    if (grid == 0) {
        if (n_in != 32 || in_sizes[0] != MP * D || in_sizes[1] != MS * D || out_size != MTOK * D || ws_size < WS_END) {
            fprintf(stderr, "kernel_launch: shape/workspace mismatch: n_in %d in0 %d in1 %d out %d ws %zu (need %zu); nothing launched\n", n_in, n_in > 0 ? in_sizes[0] : -1, n_in > 1 ? in_sizes[1] : -1, out_size, ws_size, (size_t)WS_END);
            grid = -1; return; }
        int dev = 0, cus = 0, per_cu = 0;
        if (hipGetDevice(&dev) != hipSuccess || hipDeviceGetAttribute(&cus, hipDeviceAttributeMultiprocessorCount, dev) != hipSuccess) { grid = -1; return; }
        if (hipFuncSetAttribute((const void*)mk_fwd, hipFuncAttributeMaxDynamicSharedMemorySize, LDS_BYTES) != hipSuccess) { fprintf(stderr, "kernel_launch: hipFuncSetAttribute failed\n"); grid = -1; return; }
        if (hipOccupancyMaxActiveBlocksPerMultiprocessor(&per_cu, (const void*)mk_fwd, NWAVES * 64, LDS_BYTES) != hipSuccess || per_cu < 1)
            fprintf(stderr, "kernel_launch: note: occupancy query reports %d workgroups per CU\n", per_cu);
        (void)hipGetLastError();
        grid = cus;
    }
    if (grid < 0) return;
    if (hipMemsetAsync((char*)d_ws + WS_CTL, 0, CTL_ZERO_BYTES, stream) != hipSuccess) return;
    Args a{};
    for (int i = 0; i < 32; ++i) a.in[i] = (const float*)d_in[i];
    a.out = (float*)d_out; a.ws = (unsigned char*)d_ws;
#if MK_N_LAUNCHES == 1
    a.ph_lo = 0; a.ph_hi = N_PHASES;
    hipLaunchKernelGGL(mk_fwd, dim3(grid), dim3(NWAVES * 64), LDS_BYTES, stream, a);
#else
    for (int p = 0; p < N_PHASES; ++p) { a.ph_lo = p; a.ph_hi = p + 1; hipLaunchKernelGGL(mk_fwd, dim3(grid), dim3(NWAVES * 64), LDS_BYTES, stream, a); }
#endif
    const hipError_t le = hipPeekAtLastError();
    if (le != hipSuccess) fprintf(stderr, "kernel_launch: launch failed: %s\n", hipGetErrorName(le));
}
```
